# Optimizing an MI355X kernel written in HIP

```python
import math, functools
import jax, jax.numpy as jnp
from jax import lax
import numpy as np

D_MODEL = 1024
BATCH = 8
SEQ = 2048
DEPTH = 2

CHUNK = 64
Q_BLOCK = 2 * CHUNK
HEAD_DIM = 64
N_HEADS = D_MODEL // HEAD_DIM
D_PLE = 256
D_FF = 256 * ((8 * D_MODEL // 3 + 255) // 256)
N_EXPERTS = 8
TOP_K = 2
D_FF_EXPERT = 7 * D_MODEL // 2
EXPERT_BLOCK = 256
RMS_EPS = 1e-6

kernel_name = 'yoco_fox_stickbreaking_moe_trunk'


def rmsnorm(x, g):
    xf = x.astype(jnp.float32)
    y = xf * lax.rsqrt(jnp.mean(xf * xf, axis=-1, keepdims=True) + RMS_EPS)
    return (y * g.astype(jnp.float32)).astype(x.dtype)


def split_heads(t):
    b, s, _ = t.shape
    return t.reshape(b, s, N_HEADS, HEAD_DIM).transpose(0, 2, 1, 3)


def to_query_blocks(t):
    b, h, s = t.shape[:3]
    nq = s // Q_BLOCK
    t = t.reshape((b, h, nq, Q_BLOCK) + t.shape[3:])
    return jnp.moveaxis(t, 2, 0)


def merge_query_blocks(o):
    nq, b, h, qb, d = o.shape
    return o.transpose(1, 0, 3, 2, 4).reshape(b, nq * qb, h * d)


def forgetting_attention(a, w_in, b_f, w_o):
    b, s, d_model = a.shape
    proj = a @ w_in
    q, k, v, f = jnp.split(proj, [d_model, 2 * d_model, 3 * d_model], axis=-1)
    log_f = jax.nn.log_sigmoid((f + b_f).astype(jnp.float32))
    c = jnp.cumsum(log_f, axis=1).transpose(0, 2, 1)
    q = split_heads(q) * (1.0 / math.sqrt(HEAD_DIM))
    k = split_heads(k)
    v = split_heads(v)
    kpos = jnp.arange(s)
    qpos = kpos.reshape(s // Q_BLOCK, Q_BLOCK)

    def block(args):
        qb, cb, qp = args
        logits = jnp.einsum('bhqd,bhkd->bhqk', qb, k).astype(jnp.float32)
        logits = logits + cb[..., :, None] - c[:, :, None, :]
        logits = jnp.where(kpos[None, :] <= qp[:, None], logits, -jnp.inf)
        probs = jax.nn.softmax(logits, axis=-1).astype(v.dtype)
        return jnp.einsum('bhqk,bhkd->bhqd', probs, v)

    o = lax.map(block, (to_query_blocks(q), to_query_blocks(c), qpos))
    return merge_query_blocks(o) @ w_o


def stick_breaking_attention(a, w_q, k, v, w_o):
    s = a.shape[1]
    q = split_heads(a @ w_q) * (1.0 / math.sqrt(HEAD_DIM))
    kpos = jnp.arange(s)
    qpos = kpos.reshape(s // Q_BLOCK, Q_BLOCK)

    def block(args):
        qb, qp = args
        z = jnp.einsum('bhqd,bhkd->bhqk', qb, k).astype(jnp.float32)
        mask = kpos[None, :] < qp[:, None]
        log_1mb = jnp.where(mask, jax.nn.log_sigmoid(-z), 0.0)
        later = lax.cumsum(log_1mb, axis=3, reverse=True) - log_1mb
        weights = jnp.where(mask, jnp.exp(jax.nn.log_sigmoid(z) + later), 0.0)
        return jnp.einsum('bhqk,bhkd->bhqd', weights.astype(v.dtype), v)

    o = lax.map(block, (to_query_blocks(q), qpos))
    return merge_query_blocks(o) @ w_o


def swiglu(h, w_gu, w_down):
    g, u = jnp.split(h @ w_gu, 2, axis=-1)
    return (jax.nn.silu(g) * u) @ w_down


def moe_swiglu(h, router_w, router_b, w_gu, w_down):
    b, s, d = h.shape
    t = b * s
    xt = h.reshape(t, d)
    logits = (xt @ router_w).astype(jnp.float32) + router_b.astype(jnp.float32)
    top_v, top_i = lax.top_k(logits, TOP_K)
    gates = jax.nn.softmax(top_v, axis=-1)
    n_assign = t * TOP_K
    flat_e = top_i.reshape(-1)
    flat_g = gates.reshape(-1)
    flat_tok = jnp.arange(n_assign) // TOP_K
    order = jnp.argsort(flat_e)
    sorted_e = flat_e[order]
    counts = jnp.bincount(flat_e, length=N_EXPERTS)
    padded = (counts + EXPERT_BLOCK - 1) // EXPERT_BLOCK * EXPERT_BLOCK
    start = jnp.cumsum(counts) - counts
    pstart = jnp.cumsum(padded) - padded
    dest = pstart[sorted_e] + jnp.arange(n_assign) - start[sorted_e]
    n_blocks = -(-n_assign // EXPERT_BLOCK) + N_EXPERTS
    n_rows = n_blocks * EXPERT_BLOCK
    row_tok = jnp.zeros((n_rows,), jnp.int32).at[dest].set(flat_tok[order])
    row_gate = jnp.zeros((n_rows,), jnp.float32).at[dest].set(flat_g[order])
    block_e = jnp.minimum(
        jnp.searchsorted(jnp.cumsum(padded), jnp.arange(n_blocks) * EXPERT_BLOCK, side='right'),
        N_EXPERTS - 1)
    xb = xt[row_tok].reshape(n_blocks, EXPERT_BLOCK, d)

    def expert_block(args):
        xe, e = args
        return swiglu(xe, w_gu[e], w_down[e])

    yb = lax.map(expert_block, (xb, block_e)).reshape(n_rows, d)
    out = jnp.zeros((t, d), h.dtype).at[row_tok].add(yb * row_gate[:, None].astype(yb.dtype))
    return out.reshape(b, s, d)


def setup_inputs(seed: int = 0) -> dict:
    key = jax.random.key(seed)
    ks = jax.random.split(key, 24)
    n_a = DEPTH // 2
    n_b = DEPTH - n_a
    n_dense = (DEPTH + 1) // 2
    n_moe = DEPTH // 2
    D, H, F, FE = D_MODEL, N_HEADS, D_FF, D_FF_EXPERT

    def nrm(k, shape, scale):
        return jax.random.normal(k, shape, jnp.float32) * scale

    return {
        'x': nrm(ks[0], (BATCH, SEQ, D), 1.0),
        'p': nrm(ks[1], (DEPTH, BATCH, SEQ, D_PLE), 1.0),
        'attn_norm': 1.0 + nrm(ks[2], (DEPTH, D), 0.02),
        'ffn_norm': 1.0 + nrm(ks[3], (DEPTH, D), 0.02),
        'w_in_a': nrm(ks[4], (n_a, D, 3 * D + H), D ** -0.5),
        'b_f': jax.random.uniform(ks[5], (n_a, H), jnp.float32, 2.0, 5.0),
        'w_o_a': nrm(ks[6], (n_a, D, D), D ** -0.5),
        'kv_norm': 1.0 + nrm(ks[7], (D,), 0.02),
        'w_kv': nrm(ks[8], (D, 2 * D), D ** -0.5),
        'w_q_b': nrm(ks[9], (n_b, D, D), D ** -0.5),
        'w_o_b': nrm(ks[10], (n_b, D, D), D ** -0.5),
        'w_gu_dense': nrm(ks[11], (n_dense, D, 2 * F), D ** -0.5),
        'w_down_dense': nrm(ks[12], (n_dense, F, D), F ** -0.5),
        'router_w': nrm(ks[13], (n_moe, D, N_EXPERTS), D ** -0.5),
        'router_b': nrm(ks[14], (n_moe, N_EXPERTS), 0.01),
        'w_gu_moe': nrm(ks[15], (n_moe, N_EXPERTS, D, 2 * FE), D ** -0.5),
        'w_down_moe': nrm(ks[16], (n_moe, N_EXPERTS, FE, D), FE ** -0.5),
        'w_ple_proj': nrm(ks[17], (DEPTH, D_PLE, D), D_PLE ** -0.5),
        'w_ple_gate': nrm(ks[18], (DEPTH, D, D), D ** -0.5),
        'final_norm': 1.0 + nrm(ks[19], (D,), 0.02),
    }


def reference(x, p, attn_norm, ffn_norm, w_in_a, b_f, w_o_a, kv_norm, w_kv, w_q_b, w_o_b,
              w_gu_dense, w_down_dense, router_w, router_b, w_gu_moe, w_down_moe,
              w_ple_proj, w_ple_gate, final_norm):
    n_a = DEPTH // 2
    h = x
    k_shared = None
    v_shared = None
    for i in range(DEPTH):
        a = rmsnorm(h, attn_norm[i])
        if i < n_a:
            h = h + forgetting_attention(a, w_in_a[i], b_f[i], w_o_a[i])
        else:
            j = i - n_a
            h = h + stick_breaking_attention(a, w_q_b[j], k_shared, v_shared, w_o_b[j])
        f = rmsnorm(h, ffn_norm[i])
        if i % 2 == 0:
            h = h + swiglu(f, w_gu_dense[i // 2], w_down_dense[i // 2])
        else:
            h = h + moe_swiglu(f, router_w[i // 2], router_b[i // 2], w_gu_moe[i // 2], w_down_moe[i // 2])
        h = h + (p[i] @ w_ple_proj[i]) * jax.nn.sigmoid(h @ w_ple_gate[i])
        if i == n_a - 1:
            kv = rmsnorm(h, kv_norm) @ w_kv
            k_s, v_s = jnp.split(kv, 2, axis=-1)
            k_shared = split_heads(k_s)
            v_shared = split_heads(v_s)
    return rmsnorm(h, final_norm)
```

```cpp
#include <hip/hip_runtime.h>
#include <hip/hip_bf16.h>
#include <cstdio>
#include <cstdint>

#define LAS __attribute__((address_space(3)))
#define GAS __attribute__((address_space(1)))
typedef unsigned short bf16_t;
typedef short bf16x8 __attribute__((ext_vector_type(8)));
typedef float f32x4 __attribute__((ext_vector_type(4)));
typedef float f32x2 __attribute__((ext_vector_type(2)));
typedef unsigned u32x4 __attribute__((ext_vector_type(4)));
typedef unsigned u32x2 __attribute__((ext_vector_type(2)));

#ifndef MK_N_LAUNCHES
#define MK_N_LAUNCHES 1
#endif
constexpr int NPH = 17;
constexpr int N_LAUNCHES = MK_N_LAUNCHES;

constexpr int NB = 8, SEQ = 2048, DM = 1024, NH = 16, HD = 64, MT = NB * SEQ, FD = 2816, FE = 3584, NE = 8, DP = 256;
constexpr int NW = 8;
constexpr float RMS_EPS = 1e-6f, LOG2E = 1.4426950408889634f, C2 = 0.125f * 1.4426950408889634f;
constexpr int MOE_ROWS = 2 * MT + NE * 256;

constexpr size_t MiB = 1u << 20, KiB = 1u << 10;
constexpr size_t WS_CTL = 0, CTL_ZERO_BYTES = 1 * MiB;
constexpr size_t WS_SMALL = 1 * MiB;
constexpr size_t WS_RS0 = WS_SMALL, WS_SLAB1 = WS_SMALL + 64 * KiB, WS_SLAB3 = WS_SMALL + 320 * KiB, WS_SLAB6 = WS_SMALL + 576 * KiB;
constexpr size_t WS_LOGF = WS_SMALL + 1024 * KiB, WS_CS = WS_SMALL + 2048 * KiB, WS_CNTWG = WS_SMALL + 3072 * KiB;
constexpr size_t WS_SELE = WS_SMALL + 3136 * KiB, WS_SELG = WS_SMALL + 3200 * KiB, WS_RR4 = WS_SMALL + 3264 * KiB, WS_TOKPOS = WS_SMALL + 3328 * KiB, WS_GROW = WS_SMALL + 3456 * KiB;
constexpr size_t WS_W_IN = 8 * MiB, WS_W_OA = 14 * MiB, WS_W_KVQ = 16 * MiB, WS_W_OB = 22 * MiB, WS_W_GUD = 24 * MiB, WS_W_DD = 35 * MiB, WS_W_PP = 41 * MiB, WS_W_PG = 42 * MiB;
constexpr size_t WS_W_GUM = 46 * MiB, WS_W_DM = 158 * MiB;
constexpr size_t WS_HBA = 214 * MiB, WS_HBB = 246 * MiB, WS_PB = 278 * MiB, WS_PP = 294 * MiB, WS_XGY = 358 * MiB;
constexpr size_t WS_ARENA = 426 * MiB, WS_Q = 426 * MiB, WS_K = 458 * MiB, WS_V = 490 * MiB, WS_O = 522 * MiB, WS_ACTD = 554 * MiB, WS_ACTM = WS_ARENA;
constexpr size_t WS_END = 664 * MiB;
static_assert(WS_ACTM + (size_t)MOE_ROWS * FE * 2 <= WS_END && WS_ACTD + (size_t)MT * FD * 2 <= WS_END && WS_XGY + (size_t)MOE_ROWS * DM * 2 <= WS_ARENA, "ws map");
static_assert(WS_W_GUM + (size_t)NE * 2 * FE * DM * 2 <= WS_W_DM && WS_W_DM + (size_t)NE * DM * FE * 2 <= WS_HBA && WS_GROW + (size_t)MOE_ROWS * 4 <= WS_W_IN, "ws map 2");
constexpr int CW_BAR = 4096;
static_assert(WS_V - WS_K == WS_K - WS_Q, "Q|K|V equally spaced");

constexpr int RING_BYTES = 133120;
constexpr int LDSCTL_OFF = RING_BYTES, MISC_OFF = LDSCTL_OFF + 320;
constexpr int LDS_BYTES = 147456;
static_assert(MISC_OFF + 1024 <= LDS_BYTES, "lds map");

typedef GAS unsigned gu32;
#define RLX_AGENT __ATOMIC_RELAXED, __HIP_MEMORY_SCOPE_AGENT
#define LDS_WAIT() asm volatile("s_waitcnt lgkmcnt(0)" ::: "memory")
#define VM_WAIT() asm volatile("s_waitcnt vmcnt(0)" ::: "memory")
__device__ __forceinline__ unsigned f2bf(float f) { unsigned u = __builtin_bit_cast(unsigned, f); return (u + 0x7fffu + ((u >> 16) & 1u)) >> 16; }
__device__ __forceinline__ unsigned pk2(float lo, float hi) { return f2bf(lo) | (f2bf(hi) << 16); }
__device__ __forceinline__ float bflo(unsigned w) { return __builtin_bit_cast(float, w << 16); }
__device__ __forceinline__ float bfhi(unsigned w) { return __builtin_bit_cast(float, w & 0xffff0000u); }
__device__ __forceinline__ float wave_sum(float v) {
#pragma unroll
    for (int o = 1; o < 64; o <<= 1) v += __shfl_xor(v, o);
    return v;
}
__device__ __forceinline__ int opaque_zero() { int z; asm volatile("v_mov_b32 %0, 0" : "=v"(z)); return z; }

#define XB_TMO      128
#define XB_XCNT(j)  (256  + 64 * (j))
#define XB_XSUB(j)  (1280 + 64 * (j))
#define XB_XGEN(j)  (2304 + 64 * (j))
#define XB_TOP      3328
#define XB_TOPGEN   3392
#define XCD_BAR_WORDS 3456
#define XB_SPIN_CAP (1u << 20)
__device__ __forceinline__ unsigned xb_ld(unsigned* p)              { return __hip_atomic_load(p, __ATOMIC_RELAXED, __HIP_MEMORY_SCOPE_AGENT); }
__device__ __forceinline__ unsigned xb_add(unsigned* p, unsigned v) { return __hip_atomic_fetch_add(p, v, __ATOMIC_RELAXED, __HIP_MEMORY_SCOPE_AGENT); }
__device__ __forceinline__ unsigned xb_xcc_id() { return (unsigned)__builtin_amdgcn_s_getreg((3 << 11) | 20) & 0xFu; }
#define XB_SPIN(cond, bar) do { unsigned _sp = 0; while (cond) { __builtin_amdgcn_s_sleep(1); \
    if ((++_sp & 255u) == 0u) { if (xb_ld(&(bar)[XB_TMO])) break; if (_sp > XB_SPIN_CAP) { atomicAdd(&(bar)[XB_TMO], 1u); break; } } } } while (0)
struct XcdBarrier { unsigned* bar; unsigned x; volatile LAS unsigned* st; };
__device__ __forceinline__ XcdBarrier xcd_barrier_post(unsigned* bar, volatile LAS unsigned* st) {
    XcdBarrier b; b.bar = bar; b.x = xb_xcc_id(); b.st = st;
    if (threadIdx.x == 0) (void)xb_add(&bar[XB_XCNT(b.x)], 1u);
    return b;
}
__device__ __forceinline__ void xcd_barrier_complete(unsigned* bar, unsigned x, unsigned& nloc, unsigned& nx) {
    const unsigned G = gridDim.x * gridDim.y * gridDim.z;
    unsigned sum, cnt, mine, sp = 0u;
    for (;;) {
        sum = 0u; cnt = 0u; mine = 0u;
#pragma unroll
        for (unsigned j = 0; j < 16; ++j) { const unsigned c = xb_ld(&bar[XB_XCNT(j)]); sum += c; cnt += (c > 0u) ? 1u : 0u; mine = (j == x) ? c : mine; }
        if (sum == G) break;
        __builtin_amdgcn_s_sleep(1);
        if ((++sp & 255u) == 0u) { if (xb_ld(&bar[XB_TMO])) break; if (sp > XB_SPIN_CAP) { atomicAdd(&bar[XB_TMO], 1u); break; } }
    }
    nloc = mine > 0u ? mine : 1u; nx = cnt > 0u ? cnt : 1u;
}
__device__ __forceinline__ void xcd_barrier(const XcdBarrier& b) {
    asm volatile("s_waitcnt vmcnt(0)" ::: "memory");
    __syncthreads();
    if (threadIdx.x == 0) {
        unsigned* bar = b.bar;
        __builtin_amdgcn_s_waitcnt(0);
        unsigned nloc = b.st[0], nx = b.st[1];
        if (nloc == 0u) { xcd_barrier_complete(bar, b.x, nloc, nx); b.st[0] = nloc; b.st[1] = nx; }
        const unsigned old = xb_add(&bar[XB_XSUB(b.x)], 1u);
        const unsigned gen = old / nloc;
        if (old + 1u == (gen + 1u) * nloc) {
            __builtin_amdgcn_fence(__ATOMIC_RELEASE, "agent");
            asm volatile("s_waitcnt vmcnt(0)" ::: "memory");
            const unsigned og = xb_add(&bar[XB_TOP], 1u);
            const unsigned tg = og / nx;
            if (og + 1u == (tg + 1u) * nx) xb_add(&bar[XB_TOPGEN], 1u);
            else XB_SPIN(xb_ld(&bar[XB_TOPGEN]) == tg, bar);
            __builtin_amdgcn_fence(__ATOMIC_ACQUIRE, "agent");
            xb_add(&bar[XB_XGEN(b.x)], 1u);
            asm volatile("s_waitcnt vmcnt(0)" ::: "memory");
        } else {
            XB_SPIN(xb_ld(&bar[XB_XGEN(b.x)]) == gen, bar);
            __builtin_amdgcn_fence(__ATOMIC_ACQUIRE, "agent");
            asm volatile("s_waitcnt vmcnt(0)" ::: "memory");
        }
    }
    __syncthreads();
}

namespace pg8 {
constexpr int BM = 256, BK = 64, HALF = 128, NXCD = 8, WGM = 8;
__host__ __device__ __forceinline__ int perm32(int rho) { const int n = rho >> 4, i = rho & 15; return 8 * (i >> 2) + 4 * n + (i & 3); }
struct Unit { int arow, brow, orow, ocol; };
struct Gemm { const bf16_t* A; const bf16_t* Bt; int K; };

__device__ __forceinline__ bool order_map(long L, int nM, int nN, int& pm, int& pn) {
    const int nwg = nM * nN; if (L >= nwg) return false;
    int wgid = (int)L; { const int q = nwg / NXCD, r = nwg % NXCD, xcd = wgid % NXCD, off = wgid / NXCD; wgid = (xcd < r ? xcd * (q + 1) : r * (q + 1) + (xcd - r) * q) + off; }
    const int nig = WGM * nN, gid = wgid / nig, fm = gid * WGM, gsz = (nM - fm) < WGM ? (nM - fm) : WGM;
    pm = fm + ((wgid % nig) % gsz); pn = (wgid % nig) / gsz; return true;
}
struct StaticOrder {
    int nM, nN, G, c;
    __device__ void init(int M, int N, int G_, int c_) { nM = M / BM; nN = N / BM; G = G_; c = c_; }
    __device__ __forceinline__ bool next(int i, Unit& u) const {
        int pm, pn; if (!order_map((long)i * G + c, nM, nN, pm, pn)) return false;
        u.arow = pm * BM; u.brow = pn * BM; u.orow = pm * BM; u.ocol = pn; return true;
    }
};
struct MoeOrder {
    int mtp[NE + 1]; int nN, brows, G, c;
    __device__ __forceinline__ bool next(int i, Unit& u) const {
        int pm, pn; if (!order_map((long)i * G + c, mtp[NE], nN, pm, pn)) return false;
        int e = 0;
#pragma unroll
        for (int j = 1; j < NE; ++j) e += (pm >= mtp[j]) ? 1 : 0;
        u.arow = pm * BM; u.orow = pm * BM; u.brow = e * brows + pn * BM; u.ocol = pn; return true;
    }
};

struct RowScale {
    const float* p; int mode;
    __device__ __forceinline__ float get(int row) const {
        if (mode == 0) return p[row];
        if (mode == 1) { const f32x4 q = *(const f32x4*)(p + 4 * (size_t)row); return __builtin_amdgcn_rsqf(((q[0] + q[1]) + (q[2] + q[3])) * (1.0f / DM) + RMS_EPS); }
        return 1.0f;
    }
};
struct EpiQKV {
    static constexpr bool PERM = true, AFTER_DRAIN = false;
    bf16_t* base; size_t stride; int rot; RowScale R;
    __device__ __forceinline__ void operator()(const f32x4 (&acc)[2][4][2], int ai, const Unit& u, int wr, int wc, int fr, int fq) const {
        int d = (u.ocol >> 2) + rot; d = d >= 3 ? d - 3 : d; bf16_t* ob = base + (size_t)d * stride; const float sc = d == 0 ? C2 : 1.0f;
        const int col0 = (u.ocol & 3) * BM + wc * 32 + 8 * fq;
#pragma unroll
            for (int m = 0; m < 4; ++m) { const int row = u.orow + ai * HALF + wr * 64 + m * 16 + fr; const float rr = R.get(row) * sc; bf16_t* rowp = ob + (size_t)row * DM + col0;
#pragma unroll
                for (int bj = 0; bj < 2; ++bj) { const f32x4 v0 = acc[bj][m][0] * rr, v1 = acc[bj][m][1] * rr;
                    u32x4 w; w.x = pk2(v0[0], v0[1]); w.y = pk2(v0[2], v0[3]); w.z = pk2(v1[0], v1[1]); w.w = pk2(v1[2], v1[3]);
                    *(u32x4*)(rowp + bj * HALF) = w; } }
    }
};
struct EpiBf16 {
    static constexpr bool PERM = true, AFTER_DRAIN = false;
    bf16_t* O; int ldo;
    __device__ __forceinline__ void operator()(const f32x4 (&acc)[2][4][2], int ai, const Unit& u, int wr, int wc, int fr, int fq) const {
        const int col0 = u.ocol * BM + wc * 32 + 8 * fq;
#pragma unroll
            for (int m = 0; m < 4; ++m) { const int row = u.orow + ai * HALF + wr * 64 + m * 16 + fr; bf16_t* rowp = O + (size_t)row * ldo + col0;
#pragma unroll
                for (int bj = 0; bj < 2; ++bj) { const f32x4 v0 = acc[bj][m][0], v1 = acc[bj][m][1];
                    u32x4 w; w.x = pk2(v0[0], v0[1]); w.y = pk2(v0[2], v0[3]); w.z = pk2(v1[0], v1[1]); w.w = pk2(v1[2], v1[3]);
                    *(u32x4*)(rowp + bj * HALF) = w; } }
    }
};
struct EpiSwiGLU {
    static constexpr bool PERM = true, AFTER_DRAIN = false;
    bf16_t* O; int ldo; RowScale R;
    __device__ __forceinline__ void operator()(const f32x4 (&acc)[2][4][2], int ai, const Unit& u, int wr, int wc, int fr, int fq) const {
        const int col0 = u.ocol * HALF + wc * 32 + 8 * fq;
#pragma unroll
            for (int m = 0; m < 4; ++m) { const int row = u.orow + ai * HALF + wr * 64 + m * 16 + fr; const float rr = R.get(row); float o[8];
#pragma unroll
                for (int n = 0; n < 2; ++n)
#pragma unroll
                    for (int j = 0; j < 4; ++j) { const float g = acc[0][m][n][j] * rr, uu = acc[1][m][n][j] * rr;
                        o[n * 4 + j] = g * __builtin_amdgcn_rcpf(1.0f + __builtin_amdgcn_exp2f(-g * LOG2E)) * uu; }
                u32x4 w; w.x = pk2(o[0], o[1]); w.y = pk2(o[2], o[3]); w.z = pk2(o[4], o[5]); w.w = pk2(o[6], o[7]);
                *(u32x4*)(O + (size_t)row * ldo + col0) = w; asm volatile("" ::: "memory"); }
    }
};
struct EpiMoeDown {
    static constexpr bool PERM = true, AFTER_DRAIN = false;
    bf16_t* O; const float* gate;
    __device__ __forceinline__ void operator()(const f32x4 (&acc)[2][4][2], int ai, const Unit& u, int wr, int wc, int fr, int fq) const {
        const int col0 = u.ocol * BM + wc * 32 + 8 * fq;
#pragma unroll
            for (int m = 0; m < 4; ++m) { const int row = u.orow + ai * HALF + wr * 64 + m * 16 + fr; const float gt = gate[row]; bf16_t* rowp = O + (size_t)row * DM + col0;
#pragma unroll
                for (int bj = 0; bj < 2; ++bj) { const f32x4 v0 = acc[bj][m][0] * gt, v1 = acc[bj][m][1] * gt;
                    u32x4 w; w.x = pk2(v0[0], v0[1]); w.y = pk2(v0[2], v0[3]); w.z = pk2(v1[0], v1[1]); w.w = pk2(v1[2], v1[3]);
                    *(u32x4*)(rowp + bj * HALF) = w; } }
    }
};
__device__ __forceinline__ void row_sumsq_to_slab(const f32x4 (&v)[2][4][2], int ai, const Unit& u, int wr, int wc, int fr, int fq, LAS unsigned char* lds, float* slab) {
    LAS float* P = (LAS float*)lds;
#pragma unroll
    for (int m = 0; m < 4; ++m) { float s = 0.f;
#pragma unroll
        for (int bj = 0; bj < 2; ++bj)
#pragma unroll
            for (int n = 0; n < 2; ++n) { const f32x4 x = v[bj][m][n]; s += (x[0] * x[0] + x[1] * x[1]) + (x[2] * x[2] + x[3] * x[3]); }
        s += __shfl_xor(s, 16); s += __shfl_xor(s, 32);
        if (fq == 0) P[(wr * 64 + m * 16 + fr) * 4 + wc] = s; }
    __syncthreads();
    const int t = threadIdx.x;
    if (t < HALF) slab[(size_t)(u.orow + ai * HALF + t) * 4 + u.ocol] = (P[t * 4 + 0] + P[t * 4 + 1]) + (P[t * 4 + 2] + P[t * 4 + 3]);
    __syncthreads();
}
struct EpiResid {
    static constexpr bool PERM = false, AFTER_DRAIN = true;
    const float* base; float* out; bf16_t* hb; float* slab;
    __device__ __forceinline__ void fused(f32x4 (&acc)[2][4][2], int ai, const Unit& u, int wr, int wc, int fr, int fq, LAS unsigned char* lds) const {
        const int col0 = u.ocol * BM + wc * 32 + 4 * fq;
#pragma unroll
            for (int m = 0; m < 4; ++m) { const size_t off = (size_t)(u.orow + ai * HALF + wr * 64 + m * 16 + fr) * DM + col0;
#pragma unroll
                for (int bj = 0; bj < 2; ++bj)
#pragma unroll
                    for (int n = 0; n < 2; ++n) { const size_t o2 = off + bj * HALF + n * 16; const f32x4 v = *(const f32x4*)(base + o2) + acc[bj][m][n]; acc[bj][m][n] = v;
                        *(f32x4*)(out + o2) = v; if (hb) { u32x2 w; w.x = pk2(v[0], v[1]); w.y = pk2(v[2], v[3]); *(u32x2*)(hb + o2) = w; } }
                asm volatile("" ::: "memory"); }
        if (slab) row_sumsq_to_slab(acc, ai, u, wr, wc, fr, fq, lds, slab);
    }
};
struct EpiPLE {
    static constexpr bool PERM = false, AFTER_DRAIN = true;
    float* h; const bf16_t* pp; bf16_t* hb; float* slab;
    __device__ __forceinline__ void fused(f32x4 (&acc)[2][4][2], int ai, const Unit& u, int wr, int wc, int fr, int fq, LAS unsigned char* lds) const {
        const int col0 = u.ocol * BM + wc * 32 + 4 * fq;
#pragma unroll
            for (int m = 0; m < 4; ++m) { const size_t off = (size_t)(u.orow + ai * HALF + wr * 64 + m * 16 + fr) * DM + col0;
#pragma unroll
                for (int bj = 0; bj < 2; ++bj)
#pragma unroll
                    for (int n = 0; n < 2; ++n) { const size_t o2 = off + bj * HALF + n * 16; const f32x4 a = acc[bj][m][n]; const u32x2 pw = *(const u32x2*)(pp + o2);
                        f32x4 v = *(const f32x4*)(h + o2);
                        v[0] += bflo(pw.x) * __builtin_amdgcn_rcpf(1.0f + __builtin_amdgcn_exp2f(-a[0] * LOG2E));
                        v[1] += bfhi(pw.x) * __builtin_amdgcn_rcpf(1.0f + __builtin_amdgcn_exp2f(-a[1] * LOG2E));
                        v[2] += bflo(pw.y) * __builtin_amdgcn_rcpf(1.0f + __builtin_amdgcn_exp2f(-a[2] * LOG2E));
                        v[3] += bfhi(pw.y) * __builtin_amdgcn_rcpf(1.0f + __builtin_amdgcn_exp2f(-a[3] * LOG2E));
                        acc[bj][m][n] = v; *(f32x4*)(h + o2) = v; if (hb) { u32x2 w; w.x = pk2(v[0], v[1]); w.y = pk2(v[2], v[3]); *(u32x2*)(hb + o2) = w; } }
                asm volatile("" ::: "memory"); }
        if (slab) row_sumsq_to_slab(acc, ai, u, wr, wc, fr, fq, lds, slab);
    }
};

template <class Epi, class Sched>
__device__ __forceinline__ void gemm_simple(LAS unsigned char* lds, const Gemm g, const Sched& S, const Epi& E) {
    const int tid = threadIdx.x, wid = __builtin_amdgcn_readfirstlane(tid >> 6), lane = tid & 63, wr = wid >> 2, wc = wid & 3, fr = lane & 15, fq = lane >> 4;
    const int K = g.K, nt = K / BK;
    Unit u;
    for (int i = 0; S.next(i, u); ++i) {
        const int br0 = Epi::PERM ? perm32(fr) : fr, br1 = Epi::PERM ? perm32(16 + fr) : 16 + fr;
        const bf16_t* Bb = g.Bt + (size_t)(u.brow + wc * 32) * K + fq * 8;
#pragma unroll 1
        for (int ai = 0; ai < 2; ++ai) {
            f32x4 acc[2][4][2];
#pragma unroll
            for (int b = 0; b < 2; ++b)
#pragma unroll
                for (int m = 0; m < 4; ++m)
#pragma unroll
                    for (int n = 0; n < 2; ++n) acc[b][m][n] = (f32x4){0.f, 0.f, 0.f, 0.f};
            const bf16_t* Ab = g.A + (size_t)(u.arow + ai * HALF + wr * 64 + fr) * K + fq * 8;
#pragma unroll 1
            for (int t = 0; t < nt; ++t) {
                bf16x8 Af[4][2];
#pragma unroll
                for (int m = 0; m < 4; ++m)
#pragma unroll
                    for (int k = 0; k < 2; ++k) Af[m][k] = *(const bf16x8*)(Ab + (size_t)(m * 16) * K + t * BK + k * 32);
#pragma unroll
                for (int bj = 0; bj < 2; ++bj) {
                    bf16x8 Bf[2][2];
#pragma unroll
                    for (int k = 0; k < 2; ++k) { Bf[0][k] = *(const bf16x8*)(Bb + (size_t)(bj * HALF + br0) * K + t * BK + k * 32); Bf[1][k] = *(const bf16x8*)(Bb + (size_t)(bj * HALF + br1) * K + t * BK + k * 32); }
#pragma unroll
                    for (int m = 0; m < 4; ++m)
#pragma unroll
                        for (int n = 0; n < 2; ++n)
#pragma unroll
                            for (int k = 0; k < 2; ++k) acc[bj][m][n] = __builtin_amdgcn_mfma_f32_16x16x32_bf16(Bf[n][k], Af[m][k], acc[bj][m][n], 0, 0, 0);
                }
            }
            if constexpr (Epi::AFTER_DRAIN) { __syncthreads(); E.fused(acc, ai, u, wr, wc, fr, fq, lds); }
            else E(acc, ai, u, wr, wc, fr, fq);
        }
    }
}

constexpr int HTB = HALF * BK * 2  , STAGE_BYTES = 8 * HTB;
__host__ __device__ __forceinline__ int lds_byte(int r, int c) { const int st = (r >> 4) * 2 + (c >> 5), rr = r & 15, cc = c & 31, ob = rr * 64 + cc * 2; return st * 1024 + (ob ^ (((ob >> 9) & 1) << 5)); }
__host__ __device__ __forceinline__ void stage_rc(int b, int& R, int& C) { const int st = b / 1024, sb = b % 1024, swz = sb ^ (((sb >> 9) & 1) << 5); R = (st >> 1) * 16 + swz / 64; C = (st & 1) * 32 + (swz % 64) / 2; }
template <class Epi, class Sched, bool ALIGN_EPI>
__device__ __forceinline__ void gemm_fast(LAS unsigned char* lds, const Gemm g, const Sched& S, const Epi& E) {
    const int tid = threadIdx.x, wid = __builtin_amdgcn_readfirstlane(tid >> 6), lane = tid & 63, wr = wid >> 2, wc = wid & 3, fr = lane & 15, fq = lane >> 4;
    int K_ = g.K; asm volatile("" : "+s"(K_));
    const int K = K_, nt = K / BK;
    unsigned voffA[2], voffB[2];
#pragma unroll
    for (int i = 0; i < 2; ++i) { int R, C; stage_rc(tid * 16 + i * 8192, R, C); const int Rb = Epi::PERM ? ((R & ~31) + perm32(R & 31)) : R;
        voffA[i] = (unsigned)(R * K + C) * 2u; voffB[i] = (unsigned)(Rb * K + C) * 2u; }
    const size_t kstep = (size_t)(BK * 2);
    const size_t hstep = (size_t)HALF * K * 2;
    const size_t rstep = (size_t)K * 2;
    const unsigned ldsw = (unsigned)wid * 1024u;
    const int aoff = lds_byte(wr * 64 + fr, fq * 8), boff = lds_byte(wc * 32 + fr, fq * 8);
#define PG8_SA(b, h) (((b) * 2 + (h)) * HTB)
#define PG8_SB(b, h) ((4 + (b) * 2 + (h)) * HTB)
#define PG8_STAGE(bufoff, gbase, voff) do { _Pragma("unroll") for (int _i = 0; _i < 2; ++_i) \
        __builtin_amdgcn_global_load_lds((const unsigned*)((const char*)(gbase) + (voff)[_i]), (LAS unsigned*)(lds + (bufoff) + ldsw + _i * 8192), 16, 0, 0); } while (0)
#define PG8_LDA(dst, b, h) do { _Pragma("unroll") for (int m = 0; m < 4; ++m) _Pragma("unroll") for (int k = 0; k < 2; ++k) dst[m][k] = *(const LAS bf16x8*)(lds + PG8_SA(b, h) + aoff + m * 2048 + k * 1024); } while (0)
#define PG8_LDB(dst, b, h) do { _Pragma("unroll") for (int n = 0; n < 2; ++n) _Pragma("unroll") for (int k = 0; k < 2; ++k) dst[n][k] = *(const LAS bf16x8*)(lds + PG8_SB(b, h) + boff + n * 2048 + k * 1024); } while (0)
#define PG8_MMA(ai, bj, At, Bt) do { __builtin_amdgcn_s_setprio(1); _Pragma("unroll") for (int m = 0; m < 4; ++m) _Pragma("unroll") for (int n = 0; n < 2; ++n) _Pragma("unroll") for (int k = 0; k < 2; ++k) \
        acc[ai][bj][m][n] = __builtin_amdgcn_mfma_f32_16x16x32_bf16(Bt[n][k], At[m][k], acc[ai][bj][m][n], 0, 0, 0); __builtin_amdgcn_s_setprio(0); } while (0)
#define PG8_WAIT_V(n) asm volatile("s_waitcnt vmcnt(" #n ")" ::: "memory")
#define PG8_WAIT_L(n) asm volatile("s_waitcnt lgkmcnt(" #n ")" ::: "memory")
#define PG8_BAR __builtin_amdgcn_s_barrier()
#define PG8_SCHED __builtin_amdgcn_sched_barrier(0)
    Unit cur, nxt; int ui = 0;
    if (!S.next(0, cur)) return;
    f32x4 acc[2][2][4][2];
#pragma unroll
    for (int a = 0; a < 2; ++a)
#pragma unroll
        for (int b = 0; b < 2; ++b)
#pragma unroll
            for (int m = 0; m < 4; ++m)
#pragma unroll
                for (int n = 0; n < 2; ++n) acc[a][b][m][n] = (f32x4){0.f, 0.f, 0.f, 0.f};
    bf16x8 At[4][2], B0[2][2], B1[2][2];
    const char* cA = (const char*)g.A + (size_t)cur.arow * rstep; const char* cB = (const char*)g.Bt + (size_t)cur.brow * rstep;
    PG8_STAGE(PG8_SB(0, 0), cB, voffB); PG8_STAGE(PG8_SB(0, 1), cB + hstep, voffB); PG8_STAGE(PG8_SA(0, 0), cA, voffA); PG8_STAGE(PG8_SA(0, 1), cA + hstep, voffA);
    if (wr == 1) PG8_BAR;
    PG8_WAIT_V(2); PG8_BAR;
    PG8_STAGE(PG8_SB(1, 0), cB + kstep, voffB); PG8_STAGE(PG8_SA(1, 0), cA + kstep, voffA); PG8_STAGE(PG8_SB(1, 1), cB + hstep + kstep, voffB);
    PG8_WAIT_V(6); PG8_BAR;
    for (;;) {
        const bool has_next = S.next(ui + 1, nxt);
        const char* nA = has_next ? (const char*)g.A + (size_t)nxt.arow * rstep : cA; const char* nB = has_next ? (const char*)g.Bt + (size_t)nxt.brow * rstep : cB;
        for (int t = 0; t < nt; t += 2) {
            const bool last = (t == nt - 2);
            const char* a1 = cA + (size_t)(t + 1) * kstep;
            const char* a2 = last ? nA : cA + (size_t)(t + 2) * kstep; const char* b2 = last ? nB : cB + (size_t)(t + 2) * kstep;
            const char* a3 = a2 + kstep; const char* b3 = b2 + kstep;
            PG8_LDB(B0, 0, 0); PG8_LDB(B1, 0, 1); PG8_SCHED; PG8_LDA(At, 0, 0); PG8_STAGE(PG8_SA(1, 1), a1 + hstep, voffA);
            PG8_WAIT_V(8); PG8_WAIT_L(0); PG8_BAR; PG8_MMA(0, 0, At, B0); PG8_MMA(0, 1, At, B1); PG8_BAR; PG8_SCHED;
            PG8_LDA(At, 0, 1); PG8_STAGE(PG8_SB(0, 0), b2, voffB); PG8_STAGE(PG8_SB(0, 1), b2 + hstep, voffB); PG8_STAGE(PG8_SA(0, 0), a2, voffA);
            PG8_WAIT_V(8); PG8_WAIT_L(0); PG8_BAR; PG8_MMA(1, 0, At, B0); PG8_MMA(1, 1, At, B1); PG8_BAR; PG8_SCHED;
            PG8_LDB(B0, 1, 0); PG8_LDB(B1, 1, 1); PG8_SCHED; PG8_LDA(At, 1, 0); PG8_STAGE(PG8_SA(0, 1), a2 + hstep, voffA);
            PG8_WAIT_V(8); PG8_WAIT_L(0); PG8_BAR; PG8_MMA(0, 0, At, B0); PG8_MMA(0, 1, At, B1); PG8_BAR; PG8_SCHED;
            PG8_LDA(At, 1, 1); PG8_STAGE(PG8_SB(1, 0), b3, voffB); PG8_STAGE(PG8_SB(1, 1), b3 + hstep, voffB); PG8_STAGE(PG8_SA(1, 0), a3, voffA);
            PG8_WAIT_V(8); PG8_WAIT_L(0); PG8_BAR; PG8_MMA(1, 0, At, B0); PG8_MMA(1, 1, At, B1); PG8_BAR; PG8_SCHED;
        }
        if constexpr (ALIGN_EPI) { if (wr == 0) PG8_BAR; }
        if constexpr (!Epi::AFTER_DRAIN) { E(acc[0], 0, cur, wr, wc, fr, fq); E(acc[1], 1, cur, wr, wc, fr, fq); }
        if (!has_next) break;
#pragma unroll
        for (int a = 0; a < 2; ++a)
#pragma unroll
            for (int b = 0; b < 2; ++b)
#pragma unroll
                for (int m = 0; m < 4; ++m)
#pragma unroll
                    for (int n = 0; n < 2; ++n) acc[a][b][m][n] = (f32x4){0.f, 0.f, 0.f, 0.f};
        cur = nxt; cA = nA; cB = nB; ++ui;
        if constexpr (ALIGN_EPI) { if (wr == 1) PG8_BAR; }
    }
    PG8_WAIT_V(0);
    if constexpr (!ALIGN_EPI) { if (wr == 0) PG8_BAR; }
    PG8_BAR;
    if constexpr (Epi::AFTER_DRAIN) { E.fused(acc[0], 0, cur, wr, wc, fr, fq, lds); E.fused(acc[1], 1, cur, wr, wc, fr, fq, lds); }
#undef PG8_SA
#undef PG8_SB
#undef PG8_STAGE
#undef PG8_LDA
#undef PG8_LDB
#undef PG8_MMA
#undef PG8_WAIT_V
#undef PG8_WAIT_L
#undef PG8_BAR
#undef PG8_SCHED
}
template <class Epi, class Sched>
__device__ __forceinline__ void gemm_phase(LAS unsigned char* lds, const Gemm g, const Sched& S, const Epi& E) {
#if defined(SIMPLE_GEMM)
    gemm_simple(lds, g, S, E);
#else
    gemm_fast<Epi, Sched, !Epi::AFTER_DRAIN>(lds, g, S, E);
    __syncthreads();
#endif
}
}

namespace fox_body {
using bf16=__hip_bfloat16;
using bf16x8=__attribute__((ext_vector_type(8)))short;
using s16x4=__attribute__((ext_vector_type(4)))short;
using f32x16=__attribute__((ext_vector_type(16)))float;
using u32x4=__attribute__((ext_vector_type(4)))unsigned;
using f32x4v=__attribute__((ext_vector_type(4)))float;
constexpr int BATCH=8,NHEAD=16,SEQ=2048,D=64,DM=NHEAD*D;
constexpr int NW=8,QBLK=32,QB=QBLK*NW,KVBLK=64,NQB=SEQ/QB;
constexpr int ATTN_PITCH=DM, ATTN_UNIT_ROWS=QB;
__device__ __forceinline__ int crow(int r,int hi){return (r&3)+8*(r>>2)+4*hi;}
#define SBAR() __builtin_amdgcn_sched_barrier(0)
__device__ __forceinline__ void cmask(f32x16&p0,f32x16&p1,int jb,int qrel,int hi){
  const float NEG=-INFINITY; int kb=64*jb+4*hi;
  #pragma unroll
  for(int r=0;r<16;++r){int kv=kb+(r&3)+8*(r>>2); if(kv>qrel)p0[r]=NEG; if(kv+32>qrel)p1[r]=NEG;}
}

constexpr int NSLOT=3, SLOTB=8192;
constexpr int LDS_K=0, LDS_V=NSLOT*SLOTB, LDS_WS=2*NSLOT*SLOTB, LDS_OST=LDS_WS+NW*64*4, LDS_CS=LDS_OST+NW*4096, LDS_BYTES=LDS_CS+SEQ*4;
constexpr float C2=0.125f*1.4426950408889634f;
__device__ __forceinline__ void glds16(const void*gsrc,unsigned lds_dst){unsigned keep;
  asm volatile("s_mov_b32 %0, m0\n\ts_mov_b32 m0, %2\n\ts_nop 0\n\tglobal_load_lds_dwordx4 %1, off\n\ts_mov_b32 m0, %0":"=&s"(keep):"v"(gsrc),"s"(lds_dst):"memory");}
__device__ __forceinline__ float max3f(float a,float b,float c){float r;asm("v_max3_f32 %0, %1, %2, %3":"=v"(r):"v"(a),"v"(b),"v"(c));return r;}
__device__ __forceinline__ float max2f(float a,float b){float r;asm("v_max_f32_e32 %0, %1, %2":"=v"(r):"v"(a),"v"(b));return r;}
__device__ __forceinline__ float fadd_s(float a,float b){float r;asm("v_add_f32_e32 %0, %1, %2":"=v"(r):"v"(a),"v"(b));return r;}
__device__ __forceinline__ float fsub_s(float a,float b){float r;asm("v_sub_f32_e32 %0, %1, %2":"=v"(r):"v"(a),"v"(b));return r;}
typedef float f32x2_t __attribute__((ext_vector_type(2))); typedef __bf16 bf16x2_t __attribute__((ext_vector_type(2)));
__device__ __forceinline__ unsigned cvtpk_s(float lo,float hi){f32x2_t v={lo,hi};bf16x2_t b=__builtin_convertvector(v,bf16x2_t);return __builtin_bit_cast(unsigned,b);}
#define WAIT_BAR(N) asm volatile("s_waitcnt vmcnt(" #N ") lgkmcnt(0)\n\ts_barrier":::"memory")

__device__ __forceinline__ void qkt(f32x16&p0,f32x16&p1,const char*Kslot,const bf16x8*qr,const f32x16&negm,int r32,int hi){
  const char*kb=Kslot+hi*1024+r32*16;
  #pragma unroll
  for(int d0=0;d0<4;++d0){
    const bf16x8 b0=*reinterpret_cast<const bf16x8*>(kb+d0*2048);
    const bf16x8 b1=*reinterpret_cast<const bf16x8*>(kb+d0*2048+512);
    if(d0==0){p0=__builtin_amdgcn_mfma_f32_32x32x16_bf16(b0,qr[0],negm,0,0,0);p1=__builtin_amdgcn_mfma_f32_32x32x16_bf16(b1,qr[0],negm,0,0,0);}
    else{p0=__builtin_amdgcn_mfma_f32_32x32x16_bf16(b0,qr[d0],p0,0,0,0);p1=__builtin_amdgcn_mfma_f32_32x32x16_bf16(b1,qr[d0],p1,0,0,0);}}
}
typedef __attribute__((address_space(3))) const char* lds_cptr;
typedef short v4i16_t __attribute__((ext_vector_type(4)));
__device__ __forceinline__ void kload8(bf16x8*kf,lds_cptr kp){
  kf[0]=*(const __attribute__((address_space(3))) bf16x8*)(kp);      kf[1]=*(const __attribute__((address_space(3))) bf16x8*)(kp+512);
  kf[2]=*(const __attribute__((address_space(3))) bf16x8*)(kp+2048); kf[3]=*(const __attribute__((address_space(3))) bf16x8*)(kp+2560);
  kf[4]=*(const __attribute__((address_space(3))) bf16x8*)(kp+4096); kf[5]=*(const __attribute__((address_space(3))) bf16x8*)(kp+4608);
  kf[6]=*(const __attribute__((address_space(3))) bf16x8*)(kp+6144); kf[7]=*(const __attribute__((address_space(3))) bf16x8*)(kp+6656);
}
__device__ __forceinline__ void kload2(bf16x8*kf,lds_cptr kp,int j){ kf[2*j]=*(const __attribute__((address_space(3))) bf16x8*)(kp+j*2048); kf[2*j+1]=*(const __attribute__((address_space(3))) bf16x8*)(kp+j*2048+512); }
__device__ __forceinline__ s16x4 vtr(lds_cptr p){ return __builtin_bit_cast(s16x4,__builtin_amdgcn_ds_read_tr16_b64_v4i16((__attribute__((address_space(3))) v4i16_t*)p)); }
__device__ __forceinline__ float rowmax(const f32x16&p0,const f32x16&p1){
  float a=max3f(p0[0],p0[1],p1[0]),b=max3f(p0[2],p0[3],p1[1]);a=max3f(a,p1[2],p1[3]);
  #pragma unroll
  for(int r=4;r<16;r+=4){a=max3f(a,p0[r],p0[r+1]);b=max3f(b,p0[r+2],p0[r+3]);a=max3f(a,p1[r],p1[r+1]);b=max3f(b,p1[r+2],p1[r+3]);}
  const float m=max2f(a,b);
  auto rr=__builtin_amdgcn_permlane32_swap(__float_as_uint(m),__float_as_uint(m),false,false);
  return max2f(__uint_as_float(rr[0]),__uint_as_float(rr[1]));
}
__device__ __forceinline__ void pv(f32x16*o,int vb,bf16x8 pa0,bf16x8 pa1,bf16x8 pa2,bf16x8 pa3){
  #pragma unroll
  for(int d0=0;d0<2;++d0){s16x4 lo[4],hi[4];
    #pragma unroll
    for(int ks=0;ks<4;++ks){
      asm volatile("ds_read_b64_tr_b16 %0,%1 offset:%c2":"=&v"(lo[ks]):"v"(vb),"i"(d0*4096+ks*1024):"memory");
      asm volatile("ds_read_b64_tr_b16 %0,%1 offset:%c2":"=&v"(hi[ks]):"v"(vb),"i"(d0*4096+ks*1024+512):"memory");}
    asm volatile("s_waitcnt lgkmcnt(0)":::"memory");SBAR();
    #define PK(k) (bf16x8){lo[k][0],lo[k][1],lo[k][2],lo[k][3],hi[k][0],hi[k][1],hi[k][2],hi[k][3]}
    o[d0]=__builtin_amdgcn_mfma_f32_32x32x16_bf16(pa0,PK(0),o[d0],0,0,0);
    o[d0]=__builtin_amdgcn_mfma_f32_32x32x16_bf16(pa1,PK(1),o[d0],0,0,0);
    o[d0]=__builtin_amdgcn_mfma_f32_32x32x16_bf16(pa2,PK(2),o[d0],0,0,0);
    o[d0]=__builtin_amdgcn_mfma_f32_32x32x16_bf16(pa3,PK(3),o[d0],0,0,0);
    #undef PK
  }
}

#ifndef ATTN_STORE16
#define ATTN_STORE16(p,v) (*(u32x4*)(p)=(v))
#endif
template<int THRL> __device__ __forceinline__ void attn_unit(int b,int h,int qb,const bf16*Q,const bf16*__restrict__ K,const bf16*__restrict__ V,bf16*O,char*shm){
  const int tid=threadIdx.x,lane=tid&63,r32=lane&31,hi=lane>>5; const int wid=__builtin_amdgcn_readfirstlane(tid>>6);
  const long rowbase=(long)b*SEQ; const int q0=qb*QB;
  const bf16*Qw=Q+(rowbase+q0+wid*QBLK)*DM+h*D;
  const bf16*Kh=K+rowbase*DM+h*D,*Vh=V+rowbase*DM+h*D;
  const unsigned lds0=(unsigned)(uintptr_t)shm;
  float*wsf=(float*)(shm+LDS_WS)+wid*64;
  const bf16*ksrc=Kh+(long)lane*DM+wid*8;
  const bf16*vsrc=Vh+(long)(16*(wid&3)+(lane>>2))*DM+(wid>>2)*32+(lane&3)*8;
  const unsigned kdst=lds0+LDS_K+wid*1024, vdst=lds0+LDS_V+wid*1024;
  #define DMA_K(t,slot) glds16(ksrc+(long)(t)*KVBLK*DM,(unsigned)__builtin_amdgcn_readfirstlane(kdst+(slot)))
  #define DMA_V(t,slot) glds16(vsrc+(long)(t)*KVBLK*DM,(unsigned)__builtin_amdgcn_readfirstlane(vdst+(slot)))
  const int vb0=(int)(lds0+LDS_V)+((lane>>4)&1)*32+(lane&3)*8+(4*hi+((lane&15)>>2))*64;
  const char*Kbase=shm+LDS_K; bf16x8 kf[8];
  const lds_cptr shm3=(lds_cptr)shm; const lds_cptr kp0=shm3+LDS_K+hi*1024+r32*16; const lds_cptr vp0=shm3+LDS_V+((lane>>4)&1)*32+(lane&3)*8+(4*hi+((lane&15)>>2))*64;
  const int NT=(q0+QB)/KVBLK;
  DMA_K(0,0);DMA_V(0,0);DMA_K(1,SLOTB);
  __attribute__((address_space(3))) float*csl=(__attribute__((address_space(3))) float*)(uintptr_t)(unsigned)(uintptr_t)(shm+LDS_CS);
  const float ctq=csl[q0+wid*QBLK+r32];
  bf16x8 qr[4];
  #pragma unroll
  for(int d0=0;d0<4;++d0)qr[d0]=*reinterpret_cast<const bf16x8*>(&Qw[(long)r32*DM+d0*16+hi*8]);
  float mhat=-ctq,l_reg=0.f;f32x16 o[2];o[0]=f32x16{};o[1]=f32x16{};f32x16 negm;
  #pragma unroll
  for(int r=0;r<16;++r)negm[r]=ctq;
  asm volatile("":"+v"(negm));
  const int qrel=wid*QBLK+r32;
  #define CMASK(P0,P1,t) do{int jb_=(t)-(NT-4); if(jb_>=0)cmask(P0,P1,jb_,qrel,hi);}while(0)
  #define CSUB(P0,P1,t) do{ const __attribute__((address_space(3))) float*cp_=csl+(t)*KVBLK+4*hi; _Pragma("unroll") for(int g_=0;g_<4;g_+=2){ const f32x4v a_=*(const __attribute__((address_space(3))) f32x4v*)(cp_+8*g_), c_=*(const __attribute__((address_space(3))) f32x4v*)(cp_+8*g_+8); \
      _Pragma("unroll") for(int j_=0;j_<4;++j_){P0[4*g_+j_]-=a_[j_];P0[4*g_+4+j_]-=c_[j_];} SBAR(); } \
    _Pragma("unroll") for(int g_=0;g_<4;g_+=2){ const f32x4v b_=*(const __attribute__((address_space(3))) f32x4v*)(cp_+32+8*g_), d_=*(const __attribute__((address_space(3))) f32x4v*)(cp_+40+8*g_); \
      _Pragma("unroll") for(int j_=0;j_<4;++j_){P1[4*g_+j_]-=b_[j_];P1[4*g_+4+j_]-=d_[j_];} SBAR(); } }while(0)
  bool resc=false;
  #define START(P0,P1) do{ const float rm=rowmax(P0,P1); resc=false; \
    { const float dl=rm; mhat=fadd_s(mhat,dl); \
      _Pragma("unroll") for(int r=0;r<16;++r){P0[r]=fsub_s(P0[r],dl);P1[r]=fsub_s(P1[r],dl);} \
      _Pragma("unroll") for(int r=0;r<16;++r)negm[r]=-mhat; asm volatile("":"+v"(negm)); } \
    _Pragma("unroll") for(int r=0;r<16;++r)P0[r]=__builtin_amdgcn_exp2f(P0[r]); }while(0)
  #define RESC() do{ if(resc){ asm volatile("s_waitcnt lgkmcnt(0)":::"memory"); \
      _Pragma("unroll") for(int d_=0;d_<2;++d_) _Pragma("unroll") for(int r=0;r<16;++r)o[d_][r]*=wsf[crow(r,hi)]; } }while(0)
  f32x16 pA0,pA1,pB0,pB1;
  int sl_prev=0,sl_cur=0,sl_next=SLOTB;
  #define ROT() do{sl_prev=sl_cur;sl_cur=sl_next;sl_next=(sl_next==(NSLOT-1)*SLOTB)?0:sl_next+SLOTB;}while(0)
  DMA_K(2,2*SLOTB);
  WAIT_BAR(3);
  qkt(pA0,pA1,Kbase,qr,negm,r32,hi);asm volatile("s_nop 15\n\ts_nop 7":"+v"(pA0),"+v"(pA1));CSUB(pA0,pA1,0);CMASK(pA0,pA1,0);
  START(pA0,pA1);
  _Pragma("unroll") for(int r=0;r<16;++r)pA1[r]=__builtin_amdgcn_exp2f(pA1[r]);
  WAIT_BAR(0);
  DMA_K(3,0);DMA_V(1,SLOTB);
  ROT();
  kload8(kf,kp0+sl_cur);
  WAIT_BAR(2);
  s16x4 vlo[8],vhi[8]; u32x4 pw0,pw1,pw2,pw3;
  #define PKW(P,B) cvtpk_s(P[B],P[B+1])
  #define PAF(k) __builtin_bit_cast(bf16x8,pw##k)
  #define VFR(i) (bf16x8){vlo[i][0],vlo[i][1],vlo[i][2],vlo[i][3],vhi[i][0],vhi[i][1],vhi[i][2],vhi[i][3]}
  #define PIN(x) asm volatile("":"+v"(x))
  #define MX3(a,b,c) __builtin_fmaxf(__builtin_fmaxf((a),(b)),(c))
  #define GAPA(MF,A0,A1,A2,A3,W0,W1,PW) do{ MF; sacc+=A0; sacc+=A1; sacc+=A2; sacc+=A3; PIN(sacc); W0; W1; PIN(PW); SBAR(); }while(0)
  #define EX(v) __builtin_amdgcn_exp2f(v)
  #define GAPB(MF,X,B) do{ MF; X[B]=EX(X[B]); X[B+1]=EX(X[B+1]); X[B+2]=EX(X[B+2]); X[B+3]=EX(X[B+3]); PIN(X); SBAR(); }while(0)
  #define VRD(i) do{ vlo[i]=vtr(vp_+(((i)>>2)*4096+((i)&3)*1024)); vhi[i]=vtr(vp_+(((i)>>2)*4096+((i)&3)*1024+512)); }while(0)
  #define KRD(G,j) do{ if(G){ kload2(kf,kp0+sl_next,j); SBAR(); } }while(0)
  #define STEP(C0,C1,P0,P1,t,GK,GV,GL) do{ SBAR(); \
    const lds_cptr vp_=vp0+sl_prev; \
    VRD(0); SBAR(); float sacc=(P0[0]+P0[1]); \
    GAPA(C0=__builtin_amdgcn_mfma_f32_32x32x16_bf16(kf[0],qr[0],negm,0,0,0), P0[2],P0[3],P0[4],P0[5],     pw0[0]=PKW(P0,0), pw0[1]=PKW(P0,2), pw0); \
    VRD(4); SBAR(); GAPA(C1=__builtin_amdgcn_mfma_f32_32x32x16_bf16(kf[1],qr[0],negm,0,0,0), P0[6],P0[7],P0[8],P0[9],     pw0[2]=PKW(P0,4), pw0[3]=PKW(P0,6), pw0); \
    VRD(1); SBAR(); GAPA(C0=__builtin_amdgcn_mfma_f32_32x32x16_bf16(kf[2],qr[1],C0,0,0,0),   P0[10],P0[11],P0[12],P0[13], pw1[0]=PKW(P0,8), pw1[1]=PKW(P0,10), pw1); \
    VRD(5); SBAR(); GAPA(C1=__builtin_amdgcn_mfma_f32_32x32x16_bf16(kf[3],qr[1],C1,0,0,0),   P0[14],P0[15],P1[0],P1[1],   pw1[2]=PKW(P0,12),pw1[3]=PKW(P0,14), pw1); \
    VRD(2); SBAR(); GAPA(C0=__builtin_amdgcn_mfma_f32_32x32x16_bf16(kf[4],qr[2],C0,0,0,0),   P1[2],P1[3],P1[4],P1[5],     pw2[0]=PKW(P1,0), pw2[1]=PKW(P1,2), pw2); \
    VRD(6); SBAR(); GAPA(C1=__builtin_amdgcn_mfma_f32_32x32x16_bf16(kf[5],qr[2],C1,0,0,0),   P1[6],P1[7],P1[8],P1[9],     pw2[2]=PKW(P1,4), pw2[3]=PKW(P1,6), pw2); \
    VRD(3); SBAR(); GAPA(C0=__builtin_amdgcn_mfma_f32_32x32x16_bf16(kf[6],qr[3],C0,0,0,0),   P1[10],P1[11],P1[12],P1[13], pw3[0]=PKW(P1,8), pw3[1]=PKW(P1,10), pw3); \
    VRD(7); SBAR(); GAPA(C1=__builtin_amdgcn_mfma_f32_32x32x16_bf16(kf[7],qr[3],C1,0,0,0),   P1[14],P1[15],0.f,0.f,       pw3[2]=PKW(P1,12),pw3[3]=PKW(P1,14), pw3); \
    l_reg+=sacc; \
    if(GK){DMA_K((t)+3,sl_cur);} if(GV){DMA_V((t)+1,sl_next);} \
    SBAR(); CSUB(C0,C1,t); CMASK(C0,C1,t); \
    { float a=MX3(C0[0],C0[1],C1[0]),b=MX3(C0[2],C0[3],C1[1]); a=MX3(a,C1[2],C1[3]); \
      _Pragma("unroll") for(int r=4;r<16;r+=4){a=MX3(a,C0[r],C0[r+1]);b=MX3(b,C0[r+2],C0[r+3]);a=MX3(a,C1[r],C1[r+1]);b=MX3(b,C1[r+2],C1[r+3]);} \
      float rm=__builtin_fmaxf(a,b); { auto rr=__builtin_amdgcn_permlane32_swap(__float_as_uint(rm),__float_as_uint(rm),false,false); rm=__builtin_fmaxf(__uint_as_float(rr[0]),__uint_as_float(rr[1])); } \
      resc=false; \
      if(__builtin_expect(__any(rm>(float)THRL),0)){ const float dl=__builtin_fmaxf(rm,0.f); mhat+=dl; \
        _Pragma("unroll") for(int r=0;r<16;++r){C0[r]-=dl;C1[r]-=dl;} \
        _Pragma("unroll") for(int r=0;r<16;++r)negm[r]=-mhat; asm volatile("":"+v"(negm)); \
        const float f=__builtin_amdgcn_exp2f(-dl); l_reg*=f; if(hi==0)wsf[r32]=f; resc=true; } } \
    SBAR(); \
    GAPB(o[0]=__builtin_amdgcn_mfma_f32_32x32x16_bf16(PAF(0),VFR(0),o[0],0,0,0), C0,0); \
    GAPB(o[1]=__builtin_amdgcn_mfma_f32_32x32x16_bf16(PAF(0),VFR(4),o[1],0,0,0), C0,4); \
    KRD(GL,0); GAPB(o[0]=__builtin_amdgcn_mfma_f32_32x32x16_bf16(PAF(1),VFR(1),o[0],0,0,0), C0,8); \
    KRD(GL,1); GAPB(o[1]=__builtin_amdgcn_mfma_f32_32x32x16_bf16(PAF(1),VFR(5),o[1],0,0,0), C0,12); \
    KRD(GL,2); GAPB(o[0]=__builtin_amdgcn_mfma_f32_32x32x16_bf16(PAF(2),VFR(2),o[0],0,0,0), C1,0); \
    KRD(GL,3); GAPB(o[1]=__builtin_amdgcn_mfma_f32_32x32x16_bf16(PAF(2),VFR(6),o[1],0,0,0), C1,4); \
    GAPB(o[0]=__builtin_amdgcn_mfma_f32_32x32x16_bf16(PAF(3),VFR(3),o[0],0,0,0), C1,8); \
    GAPB(o[1]=__builtin_amdgcn_mfma_f32_32x32x16_bf16(PAF(3),VFR(7),o[1],0,0,0), C1,12); \
    }while(0)
  int t=1;
  #undef CMASK
  #define CMASK(P0,P1,t) do{}while(0)
  for(;t+5<NT;t+=2){
    STEP(pB0,pB1,pA0,pA1,t,true,true,true);     WAIT_BAR(2); RESC(); ROT();
    STEP(pA0,pA1,pB0,pB1,t+1,true,true,true);   WAIT_BAR(2); RESC(); ROT();
  }
  #undef CMASK
  #define CMASK(P0,P1,t) do{int jb_=(t)-(NT-4); if(jb_>=0)cmask(P0,P1,jb_,qrel,hi);}while(0)
  #define ENDW(tt) do{ if((tt)+3<NT){WAIT_BAR(2);} else if((tt)+2<NT){WAIT_BAR(1);} else {WAIT_BAR(0);} }while(0)
  for(;t+1<NT;t+=2){
    STEP(pB0,pB1,pA0,pA1,t,(t+3<NT),(t+1<NT),(t+1<NT));       ENDW(t);   RESC(); ROT();
    STEP(pA0,pA1,pB0,pB1,t+1,(t+4<NT),(t+2<NT),(t+2<NT));     ENDW(t+1); RESC(); ROT();
  }
  STEP(pB0,pB1,pA0,pA1,NT-1,false,false,false); RESC();
  { float sacc=pB0[0]+pB0[1]; _Pragma("unroll") for(int r=2;r<16;++r)sacc+=pB0[r]; _Pragma("unroll") for(int r=0;r<16;++r)sacc+=pB1[r]; l_reg+=sacc;
    pw0=(u32x4){PKW(pB0,0),PKW(pB0,2),PKW(pB0,4),PKW(pB0,6)};pw1=(u32x4){PKW(pB0,8),PKW(pB0,10),PKW(pB0,12),PKW(pB0,14)};pw2=(u32x4){PKW(pB1,0),PKW(pB1,2),PKW(pB1,4),PKW(pB1,6)};pw3=(u32x4){PKW(pB1,8),PKW(pB1,10),PKW(pB1,12),PKW(pB1,14)};
    SBAR(); pv(o,vb0+sl_cur,PAF(0),PAF(1),PAF(2),PAF(3)); }
  #undef PKW
  #undef PAF
  #undef VFR
  #undef PIN
  #undef MX3
  #undef GAPA
  #undef GAPB
  #undef EX
  #undef VRD
  #undef KRD
  #undef STEP
  #undef ENDW
  {auto rr=__builtin_amdgcn_permlane32_swap(__float_as_uint(l_reg),__float_as_uint(l_reg),false,false);l_reg=__uint_as_float(rr[0])+__uint_as_float(rr[1]);}
  if(hi==0)wsf[32+r32]=l_reg;asm volatile("s_waitcnt lgkmcnt(0)":::"memory");
  float rli[16];
  #pragma unroll
  for(int r=0;r<16;++r)rli[r]=__builtin_amdgcn_rcpf(wsf[32+crow(r,hi)]);
  bf16*Ow=O+(rowbase+q0+wid*QBLK)*DM+h*D;
  { bf16*stg=(bf16*)(shm+LDS_OST)+wid*2048;
    #pragma unroll
    for(int r=0;r<16;++r){const int orow=crow(r,hi);
      #pragma unroll
      for(int d0=0;d0<2;++d0)stg[orow*64+d0*32+r32]=__float2bfloat16(o[d0][r]*rli[r]);}
    asm volatile("s_waitcnt lgkmcnt(0)":::"memory");
    #pragma unroll
    for(int i=0;i<4;++i){const int row=i*8+(lane>>3),ch=lane&7; const u32x4 v=*(const u32x4*)(stg+row*64+ch*8); ATTN_STORE16(Ow+(long)row*DM+ch*8,v);} }
  asm volatile("s_waitcnt lgkmcnt(0)\n\ts_barrier":::"memory");
  #undef DMA_K
  #undef DMA_V
  #undef CMASK
  #undef CSUB
  #undef START
  #undef RESC
  #undef ROT
}
constexpr int ATTN_LDS_BYTES=LDS_BYTES;
struct AttnTensors { const bf16* Q; const bf16* K; const bf16* V; bf16* O; const float* CS; };
struct AttnUnit { int bh; int qb; };
struct StaticOrder {
  int vcu;
  __device__ __forceinline__ explicit StaticOrder(int grid,int block):vcu((block%8)*(grid/8)+block/8){}
  __device__ __forceinline__ bool next(int i,AttnUnit&u)const{ if(i>=4)return false; const int s=vcu&1; u.bh=vcu>>1; u.qb=(i==0)?s:(i==1)?7-s:(i==2)?3-s:4+s; return true; }
};
template<class Sched,int THRL=8> __device__ __forceinline__ void attn_phase(char*lds,const AttnTensors&T,const Sched&S){
  AttnUnit u;
  {
    const int tid=threadIdx.x, bh=S.vcu>>1, b=bh/NHEAD, h=bh%NHEAD;
    __attribute__((address_space(3))) float*csl=(__attribute__((address_space(3))) float*)(uintptr_t)(unsigned)(uintptr_t)(lds+LDS_CS);
    __attribute__((address_space(3))) float*sc=(__attribute__((address_space(3))) float*)(uintptr_t)(unsigned)(uintptr_t)(lds+LDS_WS);
    float v[4],run=0.f;
    #pragma unroll
    for(int i=0;i<4;++i){run+=T.CS[(long)(b*SEQ+4*tid+i)*NHEAD+h];v[i]=run;}
    sc[tid]=run;__syncthreads();
    for(int o=1;o<NW*64;o<<=1){const float a=(tid>=o)?sc[tid-o]:0.f;__syncthreads();sc[tid]+=a;__syncthreads();}
    const float excl=sc[tid]-run;
    #pragma unroll
    for(int i=0;i<4;++i)csl[4*tid+i]=(excl+v[i])*1.4426950408889634f;
    __syncthreads(); }
  for(int i=0;S.next(i,u);++i){ attn_unit<THRL>(u.bh/NHEAD,u.bh%NHEAD,u.qb,T.Q,T.K,T.V,T.O,lds); }
}

constexpr int SB_K=0, SB_V=2*SLOTB, SB_FLAG=4*SLOTB, SB_OST=SB_FLAG+256, SB_BYTES=SB_OST+NW*4096;
__device__ __forceinline__ void sb_unit(int b,int h,int qb,const bf16*Q,const bf16*__restrict__ K,const bf16*__restrict__ V,bf16*O,char*shm){
  const int tid=threadIdx.x,lane=tid&63,r32=lane&31,hi=lane>>5; const int wid=__builtin_amdgcn_readfirstlane(tid>>6);
  const long rowbase=(long)b*SEQ; const int q0=qb*QB;
  const bf16*Qw=Q+(rowbase+q0+wid*QBLK)*DM+h*D;
  const bf16*Kh=K+rowbase*DM+h*D,*Vh=V+rowbase*DM+h*D;
  const unsigned lds0=(unsigned)(uintptr_t)shm;
  const bf16*ksrc=Kh+(long)lane*DM+wid*8;
  const bf16*vsrc=Vh+(long)(16*(wid&3)+(lane>>2))*DM+(wid>>2)*32+(lane&3)*8;
  const unsigned kdst=lds0+SB_K+wid*1024, vdst=lds0+SB_V+wid*1024;
  #define DMA_K(t,slot) glds16(ksrc+(long)(t)*KVBLK*DM,(unsigned)__builtin_amdgcn_readfirstlane(kdst+(slot)))
  #define DMA_V(t,slot) glds16(vsrc+(long)(t)*KVBLK*DM,(unsigned)__builtin_amdgcn_readfirstlane(vdst+(slot)))
  const int vb0=(int)(lds0+SB_V)+((lane>>4)&1)*32+(lane&3)*8+(4*hi+((lane&15)>>2))*64;
  typedef __attribute__((address_space(3))) unsigned lds_u32;
  lds_u32* flag=(lds_u32*)(uintptr_t)(lds0+SB_FLAG);
  const int NT=(q0+QB)/KVBLK;
  DMA_K(NT-1,0);DMA_V(NT-1,0);
  bf16x8 qr[4];
  #pragma unroll
  for(int d0=0;d0<4;++d0)qr[d0]=*reinterpret_cast<const bf16x8*>(&Qw[(long)r32*DM+d0*16+hi*8]);
  f32x16 o[2];o[0]=f32x16{};o[1]=f32x16{};
  float rinv=1.0f; const int qrel=wid*QBLK+r32;
  for(int i=0;i<NT;++i){
    const int t=NT-1-i, slot=(i&1)*SLOTB;
    asm volatile("s_waitcnt vmcnt(0) lgkmcnt(0)\n\ts_barrier":::"memory");
    if(i>0){ const u32x4 f0=*(const __attribute__((address_space(3))) u32x4*)(flag+((i-1)&1)*8), f1=*(const __attribute__((address_space(3))) u32x4*)(flag+((i-1)&1)*8+4);
      if((f0.x&f0.y&f0.z&f0.w&f1.x&f1.y&f1.z&f1.w)!=0u)break; }
    if(i+1<NT){DMA_K(t-1,SLOTB-slot);DMA_V(t-1,SLOTB-slot);}
    f32x16 p0,p1; { f32x16 zc=f32x16{}; qkt(p0,p1,shm+SB_K+slot,qr,zc,r32,hi); }
    f32x16 c0,c1;
    #pragma unroll
    for(int r=0;r<16;++r){p0[r]=__builtin_amdgcn_exp2f(p0[r]);p1[r]=__builtin_amdgcn_exp2f(p1[r]);}
    { const int jb=t-(NT-4); if(jb>=0){ const int kb=64*jb+4*hi;
      #pragma unroll
      for(int r=0;r<16;++r){const int kv=kb+(r&3)+8*(r>>2); if(kv>=qrel)p0[r]=0.f; if(kv+32>=qrel)p1[r]=0.f;} } }
    #pragma unroll
    for(int r=0;r<16;++r){c0[r]=__builtin_amdgcn_rcpf(1.0f+p0[r]);c1[r]=__builtin_amdgcn_rcpf(1.0f+p1[r]);}
    #pragma unroll
    for(int g=0;g<4;++g){ c0[4*g+2]*=c0[4*g+3];c0[4*g+1]*=c0[4*g+2];c0[4*g]*=c0[4*g+1]; c1[4*g+2]*=c1[4*g+3];c1[4*g+1]*=c1[4*g+2];c1[4*g]*=c1[4*g+1]; }
    float tl[8],th[8],X[8];
    #pragma unroll
    for(int g=0;g<8;++g){ const float T=(g<4)?c0[4*g]:c1[4*(g-4)]; auto rr=__builtin_amdgcn_permlane32_swap(__float_as_uint(T),__float_as_uint(T),false,false); tl[g]=__uint_as_float(rr[0]); th[g]=__uint_as_float(rr[1]); }
    X[7]=1.0f;
    #pragma unroll
    for(int g=6;g>=0;--g)X[g]=X[g+1]*(tl[g+1]*th[g+1]);
    #pragma unroll
    for(int g=0;g<8;++g){ const float F=rinv*X[g]*(hi?1.0f:th[g]);
      #pragma unroll
      for(int j=0;j<4;++j){ if(g<4)p0[4*g+j]=p0[4*g+j]*c0[4*g+j]*F; else p1[4*(g-4)+j]=p1[4*(g-4)+j]*c1[4*(g-4)+j]*F; } }
    rinv=rinv*X[0]*(tl[0]*th[0]);
    { const bool dn=__all(rinv<8.6736174e-19f); if(lane==0)flag[(i&1)*8+wid]=dn?1u:0u; }
    u32x4 pw0,pw1,pw2,pw3;
    pw0=(u32x4){cvtpk_s(p0[0],p0[1]),cvtpk_s(p0[2],p0[3]),cvtpk_s(p0[4],p0[5]),cvtpk_s(p0[6],p0[7])};
    pw1=(u32x4){cvtpk_s(p0[8],p0[9]),cvtpk_s(p0[10],p0[11]),cvtpk_s(p0[12],p0[13]),cvtpk_s(p0[14],p0[15])};
    pw2=(u32x4){cvtpk_s(p1[0],p1[1]),cvtpk_s(p1[2],p1[3]),cvtpk_s(p1[4],p1[5]),cvtpk_s(p1[6],p1[7])};
    pw3=(u32x4){cvtpk_s(p1[8],p1[9]),cvtpk_s(p1[10],p1[11]),cvtpk_s(p1[12],p1[13]),cvtpk_s(p1[14],p1[15])};
    SBAR(); pv(o,vb0+slot,__builtin_bit_cast(bf16x8,pw0),__builtin_bit_cast(bf16x8,pw1),__builtin_bit_cast(bf16x8,pw2),__builtin_bit_cast(bf16x8,pw3));
  }
  bf16*Ow=O+(rowbase+q0+wid*QBLK)*DM+h*D;
  { bf16*stg=(bf16*)(shm+SB_OST)+wid*2048;
    #pragma unroll
    for(int r=0;r<16;++r){const int orow=crow(r,hi);
      #pragma unroll
      for(int d0=0;d0<2;++d0)stg[orow*64+d0*32+r32]=__float2bfloat16(o[d0][r]);}
    asm volatile("s_waitcnt lgkmcnt(0)":::"memory");
    #pragma unroll
    for(int i=0;i<4;++i){const int row=i*8+(lane>>3),ch=lane&7; const u32x4 v=*(const u32x4*)(stg+row*64+ch*8); *(u32x4*)(Ow+(long)row*DM+ch*8)=v;} }
  asm volatile("s_waitcnt vmcnt(0) lgkmcnt(0)\n\ts_barrier":::"memory");
  #undef DMA_K
  #undef DMA_V
}
template<class Sched> __device__ __forceinline__ void sb_phase(char*lds,const AttnTensors&T,const Sched&S){
  AttnUnit u;
  for(int i=0;S.next(i,u);++i){ sb_unit(u.bh/NHEAD,u.bh%NHEAD,u.qb,T.Q,T.K,T.V,T.O,lds); }
}
#undef SBAR
#undef WAIT_BAR
}
struct Args { const float* in[20]; float* out; unsigned char* ws; int ph_lo, ph_hi, li, pad; };

struct ConvDesc { const float* src; const float* gain; bf16_t* dst; int ldn, K; };
__device__ __forceinline__ void conv_load(const ConvDesc& d, f32x4 (&v)[16], f32x4 (&g)[2], int lane) {
#pragma unroll
    for (int i = 0; i < 16; ++i) v[i] = *(const GAS f32x4*)(d.src + (size_t)(4 * i + (lane >> 4)) * d.ldn + (lane & 15) * 4);
    if (d.gain) { g[0] = *(const GAS f32x4*)(d.gain + 8 * (lane & 7)); g[1] = *(const GAS f32x4*)(d.gain + 8 * (lane & 7) + 4); }
    else { g[0] = (f32x4){1.f, 1.f, 1.f, 1.f}; g[1] = g[0]; }
}
__device__ __forceinline__ void conv_store(const ConvDesc& d, const f32x4 (&v)[16], const f32x4 (&g)[2], LAS float* scr, int lane) {
#pragma unroll
    for (int i = 0; i < 16; ++i) { LAS float* s = scr + (4 * i + (lane >> 4)) * 65 + (lane & 15) * 4; s[0] = v[i][0]; s[1] = v[i][1]; s[2] = v[i][2]; s[3] = v[i][3]; }
    const int c = lane & 7;
    LDS_WAIT(); asm volatile("" ::: "memory");
#pragma unroll
    for (int j = 0; j < 8; ++j) { const int n = (lane >> 3) + 8 * j; const LAS float* s = scr + (8 * c) * 65 + n;
        u32x4 o; o.x = pk2(s[0 * 65] * g[0][0], s[1 * 65] * g[0][1]); o.y = pk2(s[2 * 65] * g[0][2], s[3 * 65] * g[0][3]); o.z = pk2(s[4 * 65] * g[1][0], s[5 * 65] * g[1][1]); o.w = pk2(s[6 * 65] * g[1][2], s[7 * 65] * g[1][3]);
        *(GAS u32x4*)(d.dst + (size_t)n * d.K + 8 * c) = o; }
    LDS_WAIT(); asm volatile("" ::: "memory");
}
__device__ __forceinline__ int gu_dest(int n0, int FH) { const int up = n0 >= FH ? 1 : 0, j = n0 - up * FH; return 256 * (j >> 7) + 128 * up + (j & 127); }

__device__ __forceinline__ void moe_prefix(const int* cntwg, int wg, volatile LAS int* L, int wave, int lane) {
    __syncthreads();
    { int tot = 0, pre = 0;
      for (int w = lane; w < 256; w += 64) { const int c = __hip_atomic_load(cntwg + w * 8 + wave, RLX_AGENT); tot += c; if (w < wg) pre += c; }
#pragma unroll
      for (int o = 1; o < 64; o <<= 1) { tot += __shfl_xor(tot, o); pre += __shfl_xor(pre, o); }
      if (lane == 0) { L[16 + wave] = tot; L[32 + wave] = pre; } }
    __syncthreads();
    if (threadIdx.x == 0) { int a = 0; L[0] = 0; for (int e = 0; e < NE; ++e) { a += (L[16 + e] + 255) >> 8; L[e + 1] = a; } }
    __syncthreads();
}

__device__ __forceinline__ const float* inp_ptr(int i) {
    typedef __attribute__((address_space(4))) const unsigned long long* kap_t;
    kap_t p = (kap_t)__builtin_amdgcn_kernarg_segment_ptr();
    asm volatile("" : "+s"(p));
    return (const float*)(const GAS float*)(uintptr_t)p[i];
}
constexpr int CI_IN = 16 * 48, CI_SQ = 16 * 16, CI_KV = 16 * 32, CI_GUD = 16 * 88, CI_DD = 44 * 16, CI_GUM1 = 16 * 112, CI_DM1 = 56 * 16, CI_PP1 = 4 * 16;
constexpr int CONV_NITEMS = CI_IN + CI_SQ + CI_KV + CI_SQ + CI_SQ + CI_GUD + CI_DD + NE * CI_GUM1 + NE * CI_DM1 + 2 * CI_PP1 + 2 * CI_SQ;
__device__ __forceinline__ ConvDesc conv_mk(const float* W, int ldn, int K, const float* gain, bf16_t* WT, int k0, int n0, int nd0) {
    ConvDesc d; d.src = W + (size_t)k0 * ldn + n0; d.gain = gain ? gain + k0 : nullptr; d.dst = WT + (size_t)nd0 * K + k0; d.ldn = ldn; d.K = K; return d;
}
__device__ __forceinline__ ConvDesc conv_decode(int it, unsigned char* ws) {
    int r = it;
    if (r < CI_IN) return conv_mk(inp_ptr(4), 3 * DM + NH, DM, inp_ptr(2), (bf16_t*)(ws + WS_W_IN), 64 * (r / 48), 64 * (r % 48), 64 * (r % 48)); r -= CI_IN;
    if (r < CI_SQ) return conv_mk(inp_ptr(6), DM, DM, nullptr, (bf16_t*)(ws + WS_W_OA), 64 * (r / 16), 64 * (r % 16), 64 * (r % 16)); r -= CI_SQ;
    if (r < CI_KV) return conv_mk(inp_ptr(8), 2 * DM, DM, inp_ptr(7), (bf16_t*)(ws + WS_W_KVQ), 64 * (r / 32), 64 * (r % 32), 64 * (r % 32)); r -= CI_KV;
    if (r < CI_SQ) return conv_mk(inp_ptr(9), DM, DM, inp_ptr(2) + DM, (bf16_t*)(ws + WS_W_KVQ), 64 * (r / 16), 64 * (r % 16), 2 * DM + 64 * (r % 16)); r -= CI_SQ;
    if (r < CI_SQ) return conv_mk(inp_ptr(10), DM, DM, nullptr, (bf16_t*)(ws + WS_W_OB), 64 * (r / 16), 64 * (r % 16), 64 * (r % 16)); r -= CI_SQ;
    if (r < CI_GUD) { const int n0 = 64 * (r % 88); return conv_mk(inp_ptr(11), 2 * FD, DM, inp_ptr(3), (bf16_t*)(ws + WS_W_GUD), 64 * (r / 88), n0, gu_dest(n0, FD)); } r -= CI_GUD;
    if (r < CI_DD) return conv_mk(inp_ptr(12), DM, FD, nullptr, (bf16_t*)(ws + WS_W_DD), 64 * (r / 16), 64 * (r % 16), 64 * (r % 16)); r -= CI_DD;
    if (r < NE * CI_GUM1) { const int e = r / CI_GUM1, q = r % CI_GUM1, n0 = 64 * (q % 112);
        return conv_mk(inp_ptr(15) + (size_t)e * DM * 2 * FE, 2 * FE, DM, inp_ptr(3) + DM, (bf16_t*)(ws + WS_W_GUM) + (size_t)e * 2 * FE * DM, 64 * (q / 112), n0, gu_dest(n0, FE)); } r -= NE * CI_GUM1;
    if (r < NE * CI_DM1) { const int e = r / CI_DM1, q = r % CI_DM1;
        return conv_mk(inp_ptr(16) + (size_t)e * FE * DM, DM, FE, nullptr, (bf16_t*)(ws + WS_W_DM) + (size_t)e * DM * FE, 64 * (q / 16), 64 * (q % 16), 64 * (q % 16)); } r -= NE * CI_DM1;
    if (r < 2 * CI_PP1) { const int e = r / CI_PP1, q = r % CI_PP1;
        return conv_mk(inp_ptr(17) + (size_t)e * DP * DM, DM, DP, nullptr, (bf16_t*)(ws + WS_W_PP) + (size_t)e * DM * DP, 64 * (q / 16), 64 * (q % 16), 64 * (q % 16)); } r -= 2 * CI_PP1;
    { const int e = r / CI_SQ, q = r % CI_SQ;
        return conv_mk(inp_ptr(18) + (size_t)e * DM * DM, DM, DM, nullptr, (bf16_t*)(ws + WS_W_PG) + (size_t)e * DM * DM, 64 * (q / 16), 64 * (q % 16), 64 * (q % 16)); }
}
__global__ void __launch_bounds__(NW * 64, 2) fwd_kernel(Args args) {
    extern __shared__ __attribute__((aligned(16))) unsigned char lds_raw[];
    LAS unsigned char* lds = (LAS unsigned char*)lds_raw;
    volatile LAS unsigned* MISC = (volatile LAS unsigned*)(lds + MISC_OFF);
    const int tid = threadIdx.x, lane = tid & 63, wave = __builtin_amdgcn_readfirstlane(tid >> 6);
    const int G = gridDim.x, bx = blockIdx.x;
    const int vcu = (G % 8 == 0) ? (bx % 8) * (G / 8) + bx / 8 : bx;
    const int gw = vcu * NW + wave, NGW = G * NW;
    unsigned char* ws = args.ws;
    gu32* ctl = (gu32*)(ws + WS_CTL);
    float* const hres = args.out;
#define INP(i) inp_ptr(i)
#define in_x INP(0)
#define p_in INP(1)
#define attn_norm INP(2)
#define ffn_norm INP(3)
#define w_in_a INP(4)
#define b_f INP(5)
#define w_o_a INP(6)
#define kv_norm INP(7)
#define w_kv INP(8)
#define w_q_b INP(9)
#define w_o_b INP(10)
#define w_gu_dense INP(11)
#define w_down_dense INP(12)
#define router_w INP(13)
#define router_b INP(14)
#define w_gu_moe INP(15)
#define w_down_moe INP(16)
#define w_ple_proj INP(17)
#define w_ple_gate INP(18)
#define final_norm INP(19)
#define rs0 ((float*)(ws + WS_RS0))
#define slab1 ((float*)(ws + WS_SLAB1))
#define slab3 ((float*)(ws + WS_SLAB3))
#define slab6 ((float*)(ws + WS_SLAB6))
#define logf_ ((float*)(ws + WS_LOGF))
#define cs ((float*)(ws + WS_CS))
#define cntwg ((int*)(ws + WS_CNTWG))
#define selE ((int*)(ws + WS_SELE))
#define selG ((float*)(ws + WS_SELG))
#define rr4 ((float*)(ws + WS_RR4))
#define tokpos ((int*)(ws + WS_TOKPOS))
#define grow ((float*)(ws + WS_GROW))
#define W_IN ((bf16_t*)(ws + WS_W_IN))
#define W_OA ((bf16_t*)(ws + WS_W_OA))
#define W_KVQ ((bf16_t*)(ws + WS_W_KVQ))
#define W_OB ((bf16_t*)(ws + WS_W_OB))
#define W_GUD ((bf16_t*)(ws + WS_W_GUD))
#define W_DD ((bf16_t*)(ws + WS_W_DD))
#define W_PP ((bf16_t*)(ws + WS_W_PP))
#define W_PG ((bf16_t*)(ws + WS_W_PG))
#define W_GUM ((bf16_t*)(ws + WS_W_GUM))
#define W_DM ((bf16_t*)(ws + WS_W_DM))
#define HBA ((bf16_t*)(ws + WS_HBA))
#define HBB ((bf16_t*)(ws + WS_HBB))
#define PB ((bf16_t*)(ws + WS_PB))
#define PP ((bf16_t*)(ws + WS_PP))
#define XG ((bf16_t*)(ws + WS_XGY))
#define YB ((bf16_t*)(ws + WS_XGY))
#define QB ((bf16_t*)(ws + WS_Q))
#define KB ((bf16_t*)(ws + WS_K))
#define VB ((bf16_t*)(ws + WS_V))
#define OB ((bf16_t*)(ws + WS_O))
#define ACTD ((bf16_t*)(ws + WS_ACTD))
#define ACTM ((bf16_t*)(ws + WS_ACTM))

    for (int u = tid; u < (LDS_BYTES - LDSCTL_OFF) / 4; u += NW * 64) ((LAS unsigned*)(lds + LDSCTL_OFF))[u] = 0u;
    __syncthreads();
    XcdBarrier bar; bar.bar = (unsigned*)(ctl + CW_BAR) + args.li * XCD_BAR_WORDS; bar.x = 0; bar.st = nullptr;
    if (N_LAUNCHES != NPH) bar = xcd_barrier_post((unsigned*)(ctl + CW_BAR) + args.li * XCD_BAR_WORDS, MISC + 8);
    const int lo = args.ph_lo, hi = args.ph_hi;
#ifndef PHASE_MASK
#define PHASE_MASK 0x1ffff
#endif
#define IN(k) ((((PHASE_MASK) >> (k)) & 1) && lo <= (k) && (k) < hi)
#define SEAM(k) do { if (IN(k) && IN((k) + 1)) xcd_barrier(bar); } while (0)

    if (IN(0)) {
        const int p0parts = args.pad;
        if (p0parts & 1) {
            LAS float* wfg = (LAS float*)lds;
            { const float* an_ = attn_norm; const float* wi_ = w_in_a;
              float tmp[32];
#pragma unroll
              for (int u = 0; u < 32; ++u) { const int i = tid + u * (NW * 64), k = i >> 4, h = i & 15; tmp[u] = an_[k] * wi_[(size_t)k * (3 * DM + NH) + 3 * DM + h]; }
#pragma unroll
              for (int u = 0; u < 32; ++u) { const int i = tid + u * (NW * 64), k = i >> 4, h = i & 15;
                wfg[((((((k >> 8) * 4 + (k & 3)) * 4 + (h >> 2)) * 64) + ((k & 255) >> 2)) << 2) + (h & 3)] = tmp[u]; } }
            const float* xin_ = in_x; const float* bf_ = b_f;
            __syncthreads();
            f32x4 vn[4];
            if (gw < MT) { const GAS f32x4* xr = (const GAS f32x4*)(xin_ + (size_t)gw * DM) + lane;
#pragma unroll
                for (int j = 0; j < 4; ++j) vn[j] = xr[64 * j]; }
            for (int m = gw; m < MT; m += NGW) {
                f32x4 v[4]; float s = 0.f;
#pragma unroll
                for (int j = 0; j < 4; ++j) v[j] = vn[j];
                if (m + NGW < MT) { const GAS f32x4* xr = (const GAS f32x4*)(xin_ + (size_t)(m + NGW) * DM) + lane;
#pragma unroll
                    for (int j = 0; j < 4; ++j) vn[j] = xr[64 * j]; }
#pragma unroll
                for (int j = 0; j < 4; ++j) s += (v[j][0] * v[j][0] + v[j][1] * v[j][1]) + (v[j][2] * v[j][2] + v[j][3] * v[j][3]);
                const float r = 1.0f / sqrtf(wave_sum(s) * (1.0f / DM) + RMS_EPS);
                GAS unsigned long long* o8 = (GAS unsigned long long*)(HBA + (size_t)m * DM) + lane;
#pragma unroll
                for (int j = 0; j < 4; ++j) o8[64 * j] = (unsigned long long)pk2(v[j][0], v[j][1]) | ((unsigned long long)pk2(v[j][2], v[j][3]) << 32);
                float fa[16];
#pragma unroll
                for (int h = 0; h < 16; ++h) fa[h] = 0.f;
#pragma unroll
                for (int j = 0; j < 4; ++j) {
#pragma unroll
                    for (int i = 0; i < 4; ++i) { const LAS f32x4* wp = (const LAS f32x4*)wfg + ((j * 4 + i) * 4) * 64 + lane; const float xv = v[j][i];
#pragma unroll
                        for (int q = 0; q < 4; ++q) { const f32x4 w4 = wp[q * 64]; fa[4 * q + 0] += xv * w4[0]; fa[4 * q + 1] += xv * w4[1]; fa[4 * q + 2] += xv * w4[2]; fa[4 * q + 3] += xv * w4[3]; } }
                    asm volatile("" ::: "memory"); }
#pragma unroll
                for (int h = 0; h < 16; ++h) fa[h] = wave_sum(fa[h]);
                if (lane == 0) rs0[m] = r;
                if (lane < 16) { float fv = 0.f;
#pragma unroll
                    for (int h = 0; h < 16; ++h) fv = (lane == h) ? fa[h] : fv;
                    const float z = fv * r + bf_[lane];
                    logf_[(size_t)m * NH + lane] = fminf(z, 0.f) - log1pf(expf(-fabsf(z))); }
            }
            __syncthreads();
        }
        const float* pin_ = p_in;
        if (p0parts & 1) {
            const size_t nth = (size_t)NGW * 64, i0 = (size_t)gw * 64 + lane, tot = (size_t)2 * MT * DP / 4;
            for (size_t ib = i0; ib < tot; ib += 8 * nth) { f32x4 v[8];
#pragma unroll
                for (int u = 0; u < 8; ++u) if (ib + u * nth < tot) v[u] = ((const GAS f32x4*)pin_)[ib + u * nth];
#pragma unroll
                for (int u = 0; u < 8; ++u) if (ib + u * nth < tot) { u32x2 w; w.x = pk2(v[u][0], v[u][1]); w.y = pk2(v[u][2], v[u][3]); ((GAS u32x2*)PB)[ib + u * nth] = w; } }
        }
        LAS float* scr = (LAS float*)(lds + wave * 16640);
        if (p0parts & 2) {
            ConvDesc dA, dB; f32x4 vA[16], vB[16], gA[2], gB[2];
            int it = gw;
            if (it < CONV_NITEMS) { dA = conv_decode(it, ws); conv_load(dA, vA, gA, lane); }
            while (it < CONV_NITEMS) {
                const bool hb = it + NGW < CONV_NITEMS;
                if (hb) { dB = conv_decode(it + NGW, ws); conv_load(dB, vB, gB, lane); }
                conv_store(dA, vA, gA, scr, lane);
                if (!hb) break;
                const bool ha = it + 2 * NGW < CONV_NITEMS;
                if (ha) { dA = conv_decode(it + 2 * NGW, ws); conv_load(dA, vA, gA, lane); }
                conv_store(dB, vB, gB, scr, lane);
                it += 2 * NGW;
                if (!ha) break;
            }
        }
    }
    SEAM(0);

    if (IN(1)) {
        pg8::Gemm g{HBA, W_IN, DM}; pg8::StaticOrder S; S.init(MT, 3 * DM, G, bx);
        pg8::EpiQKV E{QB, (size_t)(WS_K - WS_Q) / 2, 0, pg8::RowScale{rs0, 0}};
        pg8::gemm_phase(lds, g, S, E);
    }
    SEAM(1);

    if (IN(2)) {
#if !defined(NAIVE_FOX)
        static_assert(fox_body::LDS_BYTES <= RING_BYTES, "attention scratch vs LDS ring");
        const fox_body::AttnTensors AT{(const fox_body::bf16*)QB, (const fox_body::bf16*)KB, (const fox_body::bf16*)VB, (fox_body::bf16*)OB, logf_};
        const fox_body::StaticOrder S(G, bx);
        fox_body::attn_phase<fox_body::StaticOrder>((char*)lds_raw, AT, S);
        __syncthreads();
    }
#else
        const int zero = opaque_zero();
        for (int j = 0; j < 2; ++j) {
            const int it = gw + j * NGW; if (it >= NB * NH * 32) break;
            const int bh = it & 127, qq = it >> 7, qb = (j == 0) ? qq : 31 - (qq - 16);
            const int b = bh >> 4, h = bh & 15, t = qb * 64 + lane; const size_t row = (size_t)b * SEQ + t;
            float q[64], o[64];
            { const u32x4* qp = (const u32x4*)(QB + row * DM + h * HD);
#pragma unroll
              for (int c = 0; c < 8; ++c) { const u32x4 w = qp[c]; q[8 * c + 0] = bflo(w.x); q[8 * c + 1] = bfhi(w.x); q[8 * c + 2] = bflo(w.y); q[8 * c + 3] = bfhi(w.y); q[8 * c + 4] = bflo(w.z); q[8 * c + 5] = bfhi(w.z); q[8 * c + 6] = bflo(w.w); q[8 * c + 7] = bfhi(w.w); } }
#pragma unroll
            for (int d = 0; d < 64; ++d) o[d] = 0.f;
            const float* csb = cs + (size_t)bh * SEQ; const float ct = csb[t];
            float mx = -1e30f, l = 0.f;
            const int smax = qb * 64 + 63;
            for (int s = 0; s <= smax; ++s) {
                const size_t kro = ((size_t)b * SEQ + s) * DM + h * HD + zero;
                const u32x4* kp = (const u32x4*)(KB + kro); float dot = 0.f;
#pragma unroll
                for (int c = 0; c < 8; ++c) { const u32x4 w = kp[c]; dot += q[8 * c + 0] * bflo(w.x) + q[8 * c + 1] * bfhi(w.x) + q[8 * c + 2] * bflo(w.y) + q[8 * c + 3] * bfhi(w.y) + q[8 * c + 4] * bflo(w.z) + q[8 * c + 5] * bfhi(w.z) + q[8 * c + 6] * bflo(w.w) + q[8 * c + 7] * bfhi(w.w); }
                const float scv = dot + ct - csb[s + zero];
                if (s <= t) {
                    const float mn = fmaxf(mx, scv), a = __builtin_amdgcn_exp2f(mx - mn), pw = __builtin_amdgcn_exp2f(scv - mn);
                    l = l * a + pw; mx = mn;
                    const u32x4* vp = (const u32x4*)(VB + kro);
#pragma unroll
                    for (int c = 0; c < 8; ++c) { const u32x4 w = vp[c];
                        o[8 * c + 0] = o[8 * c + 0] * a + pw * bflo(w.x); o[8 * c + 1] = o[8 * c + 1] * a + pw * bfhi(w.x); o[8 * c + 2] = o[8 * c + 2] * a + pw * bflo(w.y); o[8 * c + 3] = o[8 * c + 3] * a + pw * bfhi(w.y);
                        o[8 * c + 4] = o[8 * c + 4] * a + pw * bflo(w.z); o[8 * c + 5] = o[8 * c + 5] * a + pw * bfhi(w.z); o[8 * c + 6] = o[8 * c + 6] * a + pw * bflo(w.w); o[8 * c + 7] = o[8 * c + 7] * a + pw * bfhi(w.w); }
                }
            }
            const float il = 1.0f / l; u32x4* op = (u32x4*)(OB + row * DM + h * HD);
#pragma unroll
            for (int c = 0; c < 8; ++c) { u32x4 w; w.x = pk2(o[8 * c + 0] * il, o[8 * c + 1] * il); w.y = pk2(o[8 * c + 2] * il, o[8 * c + 3] * il); w.z = pk2(o[8 * c + 4] * il, o[8 * c + 5] * il); w.w = pk2(o[8 * c + 6] * il, o[8 * c + 7] * il); op[c] = w; }
        }
    }
#endif
    SEAM(2);

    if (IN(3)) {
        pg8::Gemm g{OB, W_OA, DM}; pg8::StaticOrder S; S.init(MT, DM, G, bx);
        pg8::EpiResid E{in_x, hres, HBA, slab1};
        pg8::gemm_phase(lds, g, S, E);
    }
    SEAM(3);

    if (IN(4)) {
        { pg8::Gemm g{HBA, W_GUD, DM}; pg8::StaticOrder S; S.init(MT, 2 * FD, G, bx);
          pg8::EpiSwiGLU E{ACTD, FD, pg8::RowScale{slab1, 1}};
          pg8::gemm_phase(lds, g, S, E); }
        {
          pg8::MoeOrder S; S.mtp[0] = 0; S.mtp[1] = MT / 256;
#pragma unroll
          for (int e = 2; e <= NE; ++e) S.mtp[e] = 2 * MT / 256;
          S.nN = DM / 256; S.brows = DM; S.G = G / 2; S.c = bx >= G / 2 ? bx - G / 2 : (1 << 28);
          pg8::Gemm g{PB, W_PP, DP}; pg8::EpiBf16 E{PP, DM};
          pg8::gemm_phase(lds, g, S, E); }
    }
    SEAM(4);

    if (IN(5)) {
        pg8::Gemm g{ACTD, W_DD, FD}; pg8::StaticOrder S; S.init(MT, DM, G, bx);
        pg8::EpiResid E{hres, hres, HBA, nullptr};
        pg8::gemm_phase(lds, g, S, E);
    }
    SEAM(5);

    if (IN(6)) {
        pg8::Gemm g{HBA, W_PG, DM}; pg8::StaticOrder S; S.init(MT, DM, G, bx);
        pg8::EpiPLE E{hres, PP, HBB, slab3};
        pg8::gemm_phase(lds, g, S, E);
    }
    SEAM(6);

    if (IN(7)) {
        pg8::Gemm g{HBB, W_KVQ, DM}; pg8::StaticOrder S; S.init(MT, 3 * DM, G, bx);
        pg8::EpiQKV E{QB, (size_t)(WS_K - WS_Q) / 2, 1, pg8::RowScale{slab3, 1}};
        pg8::gemm_phase(lds, g, S, E);
    }
    SEAM(7);

    if (IN(8)) {
#if !defined(NAIVE_SB)
        static_assert(fox_body::SB_BYTES <= RING_BYTES, "attention scratch vs LDS ring");
        const fox_body::AttnTensors AT{(const fox_body::bf16*)QB, (const fox_body::bf16*)KB, (const fox_body::bf16*)VB, (fox_body::bf16*)OB, nullptr};
        const fox_body::StaticOrder S(G, bx);
        fox_body::sb_phase<fox_body::StaticOrder>((char*)lds_raw, AT, S);
        __syncthreads();
    }
#else
        const int zero = opaque_zero();
        for (int j = 0; j < 2; ++j) {
            const int it = gw + j * NGW; if (it >= NB * NH * 32) break;
            const int bh = it & 127, qq = it >> 7, qb = (j == 0) ? qq : 31 - (qq - 16);
            const int b = bh >> 4, h = bh & 15, t = qb * 64 + lane; const size_t row = (size_t)b * SEQ + t;
            float q[64], o[64];
            { const u32x4* qp = (const u32x4*)(QB + row * DM + h * HD);
#pragma unroll
              for (int c = 0; c < 8; ++c) { const u32x4 w = qp[c]; q[8 * c + 0] = bflo(w.x); q[8 * c + 1] = bfhi(w.x); q[8 * c + 2] = bflo(w.y); q[8 * c + 3] = bfhi(w.y); q[8 * c + 4] = bflo(w.z); q[8 * c + 5] = bfhi(w.z); q[8 * c + 6] = bflo(w.w); q[8 * c + 7] = bfhi(w.w); } }
#pragma unroll
            for (int d = 0; d < 64; ++d) o[d] = 0.f;
            float rem = 1.0f;
            for (int s = qb * 64 + 62; s >= 0; --s) {
                const size_t kro = ((size_t)b * SEQ + s) * DM + h * HD + zero;
                const u32x4* kp = (const u32x4*)(KB + kro); float dot = 0.f;
#pragma unroll
                for (int c = 0; c < 8; ++c) { const u32x4 w = kp[c]; dot += q[8 * c + 0] * bflo(w.x) + q[8 * c + 1] * bfhi(w.x) + q[8 * c + 2] * bflo(w.y) + q[8 * c + 3] * bfhi(w.y) + q[8 * c + 4] * bflo(w.z) + q[8 * c + 5] * bfhi(w.z) + q[8 * c + 6] * bflo(w.w) + q[8 * c + 7] * bfhi(w.w); }
                if (s < t) {
                    const float uu = __builtin_amdgcn_exp2f(dot), inv = 1.0f / (1.0f + uu), a = uu * inv * rem; rem *= inv;
                    const u32x4* vp = (const u32x4*)(VB + kro);
#pragma unroll
                    for (int c = 0; c < 8; ++c) { const u32x4 w = vp[c];
                        o[8 * c + 0] += a * bflo(w.x); o[8 * c + 1] += a * bfhi(w.x); o[8 * c + 2] += a * bflo(w.y); o[8 * c + 3] += a * bfhi(w.y);
                        o[8 * c + 4] += a * bflo(w.z); o[8 * c + 5] += a * bfhi(w.z); o[8 * c + 6] += a * bflo(w.w); o[8 * c + 7] += a * bfhi(w.w); }
                }
            }
            u32x4* op = (u32x4*)(OB + row * DM + h * HD);
#pragma unroll
            for (int c = 0; c < 8; ++c) { u32x4 w; w.x = pk2(o[8 * c + 0], o[8 * c + 1]); w.y = pk2(o[8 * c + 2], o[8 * c + 3]); w.z = pk2(o[8 * c + 4], o[8 * c + 5]); w.w = pk2(o[8 * c + 6], o[8 * c + 7]); op[c] = w; }
        }
    }
#endif
    SEAM(8);

    if (IN(9)) {
        pg8::Gemm g{OB, W_OB, DM}; pg8::StaticOrder S; S.init(MT, DM, G, bx);
        pg8::EpiResid E{hres, hres, nullptr, nullptr};
        pg8::gemm_phase(lds, g, S, E);
    }
    SEAM(9);

    if (IN(10)) {
        LAS float* wrg = (LAS float*)lds;
        LAS int* lsel = (LAS int*)(lds + 32768);
        { const float* fn_ = ffn_norm; const float* rw_ = router_w;
          float tmp[16];
#pragma unroll
          for (int u = 0; u < 16; ++u) { const int i = tid + u * (NW * 64); tmp[u] = fn_[DM + (i >> 3)] * rw_[i]; }
#pragma unroll
          for (int u = 0; u < 16; ++u) { const int i = tid + u * (NW * 64), k = i >> 3, e = i & 7;
              wrg[((((((k >> 8) * 4 + (k & 3)) * 2 + (e >> 2)) * 64) + ((k & 255) >> 2)) << 2) + (e & 3)] = tmp[u]; } }
        const float* rb_ = router_b;
        __syncthreads();
        f32x4 vn[4];
        { const GAS f32x4* hr = (const GAS f32x4*)(hres + (size_t)(vcu * 64 + wave * 8) * DM) + lane;
#pragma unroll
          for (int q = 0; q < 4; ++q) vn[q] = hr[64 * q]; }
        for (int j = 0; j < 8; ++j) {
            const int rl = wave * 8 + j, row = vcu * 64 + rl;
            f32x4 v[4]; float s = 0.f;
#pragma unroll
            for (int q = 0; q < 4; ++q) v[q] = vn[q];
            if (j < 7) { const GAS f32x4* hr = (const GAS f32x4*)(hres + (size_t)(row + 1) * DM) + lane;
#pragma unroll
                for (int q = 0; q < 4; ++q) vn[q] = hr[64 * q]; }
#pragma unroll
            for (int q = 0; q < 4; ++q) s += (v[q][0] * v[q][0] + v[q][1] * v[q][1]) + (v[q][2] * v[q][2] + v[q][3] * v[q][3]);
            const float r = 1.0f / sqrtf(wave_sum(s) * (1.0f / DM) + RMS_EPS);
            float la[8];
#pragma unroll
            for (int e = 0; e < 8; ++e) la[e] = 0.f;
#pragma unroll
            for (int q = 0; q < 4; ++q)
#pragma unroll
                for (int i = 0; i < 4; ++i) { const LAS f32x4* wp = (const LAS f32x4*)wrg + ((q * 4 + i) * 2) * 64 + lane; const float xv = v[q][i]; const f32x4 w0 = wp[0], w1 = wp[64];
                    la[0] += xv * w0[0]; la[1] += xv * w0[1]; la[2] += xv * w0[2]; la[3] += xv * w0[3]; la[4] += xv * w1[0]; la[5] += xv * w1[1]; la[6] += xv * w1[2]; la[7] += xv * w1[3]; }
#pragma unroll
            for (int e = 0; e < 8; ++e) la[e] = wave_sum(la[e]) * r + rb_[e];
            int e1 = 0; float v1 = la[0];
#pragma unroll
            for (int e = 1; e < 8; ++e) if (la[e] > v1) { v1 = la[e]; e1 = e; }
            int e2 = -1; float v2 = -3.0e38f;
#pragma unroll
            for (int e = 0; e < 8; ++e) if (e != e1 && la[e] > v2) { v2 = la[e]; e2 = e; }
            if (lane == 0) { const float g1 = 1.0f / (1.0f + expf(v2 - v1)); lsel[rl] = e1 | (e2 << 8); selE[row] = e1 | (e2 << 8); selG[row] = g1; rr4[row] = r; }
        }
        __syncthreads();
        if (tid < NE) { int c = 0; for (int i = 0; i < 64; ++i) { const int se = lsel[i]; c += ((se & 255) == tid) + ((se >> 8) == tid); } __hip_atomic_store(cntwg + vcu * 8 + tid, c, RLX_AGENT); }
        __syncthreads();
    }
    SEAM(10);

    if (IN(11)) {
        volatile LAS int* L = (volatile LAS int*)(lds + 65536);
        LAS int* lsel = (LAS int*)(lds + 32768); LAS int* lpos = (LAS int*)(lds + 33024);
        moe_prefix(cntwg, vcu, L, wave, lane);
        if (tid < 64) lsel[tid] = selE[vcu * 64 + tid];
        __syncthreads();
        if (tid < 128) { const int i = tid >> 1, k = tid & 1; const int se = lsel[i]; const int e = k ? (se >> 8) : (se & 255); int rank = 0;
            for (int i2 = 0; i2 <= i; ++i2) { const int s2 = lsel[i2]; if ((s2 & 255) == e && (i2 < i || k == 1)) ++rank; if ((s2 >> 8) == e && i2 < i) ++rank; }
            const int pos = 256 * L[e] + L[32 + e] + rank; lpos[tid] = pos; tokpos[(vcu * 64 + i) * 2 + k] = pos;
            const float g1 = selG[vcu * 64 + i]; grow[pos] = k ? 1.0f - g1 : g1; }
        __syncthreads();
#pragma unroll 1
        for (int jb = 0; jb < 8; jb += 4) {
            f32x4 v[4][4]; float rq[4];
#pragma unroll
            for (int j = 0; j < 4; ++j) { const int row = vcu * 64 + wave * 8 + jb + j; rq[j] = rr4[row]; const GAS f32x4* hr = (const GAS f32x4*)(hres + (size_t)row * DM) + lane;
#pragma unroll
                for (int q = 0; q < 4; ++q) v[j][q] = hr[64 * q]; }
#pragma unroll
            for (int j = 0; j < 4; ++j) { const int rl = wave * 8 + jb + j;
                GAS unsigned long long* d0 = (GAS unsigned long long*)(XG + (size_t)lpos[rl * 2] * DM) + lane; GAS unsigned long long* d1 = (GAS unsigned long long*)(XG + (size_t)lpos[rl * 2 + 1] * DM) + lane;
#pragma unroll
                for (int q = 0; q < 4; ++q) { const f32x4 x4 = v[j][q] * rq[j]; const unsigned long long w = (unsigned long long)pk2(x4[0], x4[1]) | ((unsigned long long)pk2(x4[2], x4[3]) << 32); d0[64 * q] = w; d1[64 * q] = w; } }
        }
        __syncthreads();
    }
    SEAM(11);

    if (IN(12)) {
        volatile LAS int* L = (volatile LAS int*)(lds + 65536);
        moe_prefix(cntwg, vcu, L, wave, lane);
        pg8::MoeOrder S; for (int e = 0; e <= NE; ++e) S.mtp[e] = L[e]; S.nN = 2 * FE / 256; S.brows = 2 * FE; S.G = G; S.c = bx;
        __syncthreads();
        pg8::Gemm g{XG, W_GUM, DM};
        pg8::EpiSwiGLU E{ACTM, FE, pg8::RowScale{nullptr, 2}};
        pg8::gemm_phase(lds, g, S, E);
    }
    SEAM(12);

    if (IN(13)) {
        volatile LAS int* L = (volatile LAS int*)(lds + 65536);
        moe_prefix(cntwg, vcu, L, wave, lane);
        pg8::MoeOrder S; for (int e = 0; e <= NE; ++e) S.mtp[e] = L[e]; S.nN = DM / 256; S.brows = DM; S.G = G; S.c = bx;
        __syncthreads();
        pg8::Gemm g{ACTM, W_DM, FE};
        pg8::EpiMoeDown E{YB, grow};
        pg8::gemm_phase(lds, g, S, E);
    }
    SEAM(13);

    if (IN(14)) {
        {
            const int* tp_ = tokpos;
            int pc0 = 0, pc1 = 0, pn0 = 0, pn1 = 0;
            if (gw < MT) { pc0 = tp_[2 * gw]; pc1 = tp_[2 * gw + 1]; }
            if (gw + NGW < MT) { pn0 = tp_[2 * (gw + NGW)]; pn1 = tp_[2 * (gw + NGW) + 1]; }
            f32x4 hv[4]; u32x2 ya[4], yb[4];
            if (gw < MT) { const GAS f32x4* hr = (const GAS f32x4*)(hres + (size_t)gw * DM) + lane; const GAS u32x2* y0 = (const GAS u32x2*)(YB + (size_t)pc0 * DM) + lane; const GAS u32x2* y1 = (const GAS u32x2*)(YB + (size_t)pc1 * DM) + lane;
#pragma unroll
                for (int q = 0; q < 4; ++q) { hv[q] = hr[64 * q]; ya[q] = y0[64 * q]; yb[q] = y1[64 * q]; } }
            for (int m = gw; m < MT; m += NGW) {
                f32x4 v[4]; u32x2 a[4], b[4];
#pragma unroll
                for (int q = 0; q < 4; ++q) { v[q] = hv[q]; a[q] = ya[q]; b[q] = yb[q]; }
                const int mn = m + NGW, mnn = m + 2 * NGW;
                if (mn < MT) { const GAS f32x4* hr = (const GAS f32x4*)(hres + (size_t)mn * DM) + lane; const GAS u32x2* y0 = (const GAS u32x2*)(YB + (size_t)pn0 * DM) + lane; const GAS u32x2* y1 = (const GAS u32x2*)(YB + (size_t)pn1 * DM) + lane;
#pragma unroll
                    for (int q = 0; q < 4; ++q) { hv[q] = hr[64 * q]; ya[q] = y0[64 * q]; yb[q] = y1[64 * q]; } }
                if (mnn < MT) { pn0 = tp_[2 * mnn]; pn1 = tp_[2 * mnn + 1]; }
                GAS f32x4* ho = (GAS f32x4*)(hres + (size_t)m * DM) + lane; GAS u32x2* hb = (GAS u32x2*)(HBA + (size_t)m * DM) + lane;
#pragma unroll
                for (int q = 0; q < 4; ++q) { f32x4 x4 = v[q];
                    x4[0] += bflo(a[q].x) + bflo(b[q].x); x4[1] += bfhi(a[q].x) + bfhi(b[q].x); x4[2] += bflo(a[q].y) + bflo(b[q].y); x4[3] += bfhi(a[q].y) + bfhi(b[q].y);
                    ho[64 * q] = x4; u32x2 w; w.x = pk2(x4[0], x4[1]); w.y = pk2(x4[2], x4[3]); hb[64 * q] = w; }
            }
        }
    }
    SEAM(14);

    if (IN(15)) {
        pg8::Gemm g{HBA, W_PG + (size_t)DM * DM, DM}; pg8::StaticOrder S; S.init(MT, DM, G, bx);
        pg8::EpiPLE E{hres, PP + (size_t)MT * DM, nullptr, slab6};
        pg8::gemm_phase(lds, g, S, E);
    }
    SEAM(15);

    if (IN(16)) {
        f32x4 gn[4];
        { const float* fnm_ = final_norm;
#pragma unroll
        for (int q = 0; q < 4; ++q) gn[q] = ((const GAS f32x4*)fnm_)[lane + 64 * q]; }
        {
            f32x4 vn[4], sqn;
            if (gw < MT) { const GAS f32x4* hr = (const GAS f32x4*)(hres + (size_t)gw * DM) + lane; sqn = *(const GAS f32x4*)(slab6 + 4 * (size_t)gw);
#pragma unroll
                for (int q = 0; q < 4; ++q) vn[q] = hr[64 * q]; }
            for (int m = gw; m < MT; m += NGW) {
                f32x4 v[4]; const f32x4 sq = sqn;
#pragma unroll
                for (int q = 0; q < 4; ++q) v[q] = vn[q];
                if (m + NGW < MT) { const GAS f32x4* hr = (const GAS f32x4*)(hres + (size_t)(m + NGW) * DM) + lane; sqn = *(const GAS f32x4*)(slab6 + 4 * (size_t)(m + NGW));
#pragma unroll
                    for (int q = 0; q < 4; ++q) vn[q] = hr[64 * q]; }
                const float r = __builtin_amdgcn_rsqf(((sq[0] + sq[1]) + (sq[2] + sq[3])) * (1.0f / DM) + RMS_EPS);
                GAS f32x4* ho = (GAS f32x4*)(hres + (size_t)m * DM) + lane;
#pragma unroll
                for (int q = 0; q < 4; ++q) ho[64 * q] = v[q] * r * gn[q];
            }
        }
    }
#undef IN
#undef SEAM
}

extern "C" void kernel_launch(void* const* d_in, const int* in_sizes, int n_in, void* d_out, int out_size, void* d_ws, size_t ws_size, hipStream_t stream) {
    static int grid = 0;
    if (grid == 0) {
        if (n_in != 20 || in_sizes[0] != MT * DM || out_size != MT * DM || ws_size < WS_END) { fprintf(stderr, "kernel_launch: unexpected shapes (n_in %d, in0 %d, out %d, ws %zu < %zu)\n", n_in, n_in > 0 ? in_sizes[0] : -1, out_size, ws_size, (size_t)WS_END); grid = -1; return; }
        int dev = 0, cus = 0, per_cu = 0;
        if (hipGetDevice(&dev) != hipSuccess || hipDeviceGetAttribute(&cus, hipDeviceAttributeMultiprocessorCount, dev) != hipSuccess) { grid = -1; return; }
        if (hipFuncSetAttribute((const void*)fwd_kernel, hipFuncAttributeMaxDynamicSharedMemorySize, LDS_BYTES) != hipSuccess) { fprintf(stderr, "kernel_launch: hipFuncSetAttribute failed\n"); grid = -1; return; }
        if (hipOccupancyMaxActiveBlocksPerMultiprocessor(&per_cu, (const void*)fwd_kernel, NW * 64, LDS_BYTES) != hipSuccess || per_cu < 1) { fprintf(stderr, "kernel_launch: occupancy query says %d blocks per CU\n", per_cu); per_cu = 1; }
        (void)hipGetLastError();
        grid = cus;
        if (grid != 256) fprintf(stderr, "kernel_launch: %d CUs; this kernel is written for 256\n", grid);
    }
    if (grid < 0) return;
    if (hipMemsetAsync((char*)d_ws + WS_CTL, 0, CTL_ZERO_BYTES, stream) != hipSuccess) return;
    Args a{};
    for (int i = 0; i < 20; ++i) a.in[i] = (const float*)d_in[i];
    a.out = (float*)d_out; a.ws = (unsigned char*)d_ws; a.pad = 3;
#if defined(PROBE_REP_LO)
    a.ph_lo = 0; a.ph_hi = PROBE_REP_HI + 1; a.li = 0; hipLaunchKernelGGL(fwd_kernel, dim3(grid), dim3(NW * 64), LDS_BYTES, stream, a);
#if defined(PROBE_P0PARTS)
    a.pad = PROBE_P0PARTS;
#endif
    a.ph_lo = PROBE_REP_LO; a.ph_hi = NPH; a.li = 1; hipLaunchKernelGGL(fwd_kernel, dim3(grid), dim3(NW * 64), LDS_BYTES, stream, a);
#else
    for (int li = 0; li < N_LAUNCHES; ++li) {
        a.ph_lo = (N_LAUNCHES == NPH) ? li : 0; a.ph_hi = (N_LAUNCHES == NPH) ? li + 1 : NPH; a.li = (N_LAUNCHES == NPH) ? 0 : li;
        hipLaunchKernelGGL(fwd_kernel, dim3(grid), dim3(NW * 64), LDS_BYTES, stream, a);
    }
#endif
}
```

```cpp
#include <hip/hip_runtime.h>
#include <hip/hip_bf16.h>
#include <cstdio>
#include <cstdint>

#define LAS __attribute__((address_space(3)))
#define GAS __attribute__((address_space(1)))
typedef unsigned short bf16_t;
typedef short bf16x8 __attribute__((ext_vector_type(8)));
typedef float f32x4 __attribute__((ext_vector_type(4)));
typedef float f32x2 __attribute__((ext_vector_type(2)));
typedef unsigned u32x4 __attribute__((ext_vector_type(4)));
typedef unsigned u32x2 __attribute__((ext_vector_type(2)));

#ifndef MK_N_LAUNCHES
#define MK_N_LAUNCHES 1
#endif
constexpr int NPH = 17;
constexpr int N_LAUNCHES = MK_N_LAUNCHES;

constexpr int NB = 8, SEQ = 2048, DM = 1024, NH = 16, HD = 64, MT = NB * SEQ, FD = 2816, FE = 3584, NE = 8, DP = 256;
constexpr int NW = 8;
constexpr float RMS_EPS = 1e-6f, LOG2E = 1.4426950408889634f, C2 = 0.125f * 1.4426950408889634f;
constexpr int MOE_ROWS = 2 * MT + NE * 256;

constexpr size_t MiB = 1u << 20, KiB = 1u << 10;
constexpr size_t WS_CTL = 0, CTL_ZERO_BYTES = 1 * MiB;
constexpr size_t WS_SMALL = 1 * MiB;
constexpr size_t WS_RS0 = WS_SMALL, WS_SLAB1 = WS_SMALL + 64 * KiB, WS_SLAB3 = WS_SMALL + 320 * KiB, WS_SLAB6 = WS_SMALL + 576 * KiB;
constexpr size_t WS_LOGF = WS_SMALL + 1024 * KiB, WS_CS = WS_SMALL + 2048 * KiB, WS_CNTWG = WS_SMALL + 3072 * KiB;
constexpr size_t WS_SELE = WS_SMALL + 3136 * KiB, WS_SELG = WS_SMALL + 3200 * KiB, WS_RR4 = WS_SMALL + 3264 * KiB, WS_TOKPOS = WS_SMALL + 3328 * KiB, WS_GROW = WS_SMALL + 3456 * KiB;
constexpr size_t WS_W_IN = 8 * MiB, WS_W_OA = 14 * MiB, WS_W_KVQ = 16 * MiB, WS_W_OB = 22 * MiB, WS_W_GUD = 24 * MiB, WS_W_DD = 35 * MiB, WS_W_PP = 41 * MiB, WS_W_PG = 42 * MiB;
constexpr size_t WS_W_GUM = 46 * MiB, WS_W_DM = 158 * MiB;
constexpr size_t WS_HBA = 214 * MiB, WS_HBB = 246 * MiB, WS_PB = 278 * MiB, WS_PP = 294 * MiB, WS_XGY = 358 * MiB;
constexpr size_t WS_ARENA = 426 * MiB, WS_Q = 426 * MiB, WS_K = 458 * MiB, WS_V = 490 * MiB, WS_O = 522 * MiB, WS_ACTD = 554 * MiB, WS_ACTM = WS_ARENA;
constexpr size_t WS_END = 664 * MiB;
static_assert(WS_ACTM + (size_t)MOE_ROWS * FE * 2 <= WS_END && WS_ACTD + (size_t)MT * FD * 2 <= WS_END && WS_XGY + (size_t)MOE_ROWS * DM * 2 <= WS_ARENA, "ws map");
static_assert(WS_W_GUM + (size_t)NE * 2 * FE * DM * 2 <= WS_W_DM && WS_W_DM + (size_t)NE * DM * FE * 2 <= WS_HBA && WS_GROW + (size_t)MOE_ROWS * 4 <= WS_W_IN, "ws map 2");
constexpr int CW_BAR = 4096;
static_assert(WS_V - WS_K == WS_K - WS_Q, "Q|K|V equally spaced");

constexpr int RING_BYTES = 133120;
constexpr int LDSCTL_OFF = RING_BYTES, MISC_OFF = LDSCTL_OFF + 320;
constexpr int LDS_BYTES = 147456;
static_assert(MISC_OFF + 1024 <= LDS_BYTES, "lds map");

typedef GAS unsigned gu32;
#define RLX_AGENT __ATOMIC_RELAXED, __HIP_MEMORY_SCOPE_AGENT
#define LDS_WAIT() asm volatile("s_waitcnt lgkmcnt(0)" ::: "memory")
#define VM_WAIT() asm volatile("s_waitcnt vmcnt(0)" ::: "memory")
__device__ __forceinline__ unsigned f2bf(float f) { unsigned u = __builtin_bit_cast(unsigned, f); return (u + 0x7fffu + ((u >> 16) & 1u)) >> 16; }
typedef __bf16 bf16x2_t __attribute__((ext_vector_type(2)));
__device__ __forceinline__ unsigned pk2(float lo, float hi) { const f32x2 v = {lo, hi}; return __builtin_bit_cast(unsigned, __builtin_convertvector(v, bf16x2_t)); }
__device__ __forceinline__ float bflo(unsigned w) { return __builtin_bit_cast(float, w << 16); }
__device__ __forceinline__ float bfhi(unsigned w) { return __builtin_bit_cast(float, w & 0xffff0000u); }
__device__ __forceinline__ float wave_sum(float v) {
#pragma unroll
    for (int o = 1; o < 64; o <<= 1) v += __shfl_xor(v, o);
    return v;
}
__device__ __forceinline__ int opaque_zero() { int z; asm volatile("v_mov_b32 %0, 0" : "=v"(z)); return z; }

#define XB_TMO      128
#define XB_XCNT(j)  (256  + 64 * (j))
#define XB_XSUB(j)  (1280 + 64 * (j))
#define XB_XGEN(j)  (2304 + 64 * (j))
#define XB_TOP      3328
#define XB_TOPGEN   3392
#define XCD_BAR_WORDS 3456
#define XB_SPIN_CAP (1u << 20)
__device__ __forceinline__ unsigned xb_ld(unsigned* p)              { return __hip_atomic_load(p, __ATOMIC_RELAXED, __HIP_MEMORY_SCOPE_AGENT); }
__device__ __forceinline__ unsigned xb_add(unsigned* p, unsigned v) { return __hip_atomic_fetch_add(p, v, __ATOMIC_RELAXED, __HIP_MEMORY_SCOPE_AGENT); }
__device__ __forceinline__ unsigned xb_xcc_id() { return (unsigned)__builtin_amdgcn_s_getreg((3 << 11) | 20) & 0xFu; }
#define XB_SPIN(cond, bar) do { unsigned _sp = 0; while (cond) { __builtin_amdgcn_s_sleep(1); \
    if ((++_sp & 255u) == 0u) { if (xb_ld(&(bar)[XB_TMO])) break; if (_sp > XB_SPIN_CAP) { atomicAdd(&(bar)[XB_TMO], 1u); break; } } } } while (0)
struct XcdBarrier { unsigned* bar; unsigned x; volatile LAS unsigned* st; };
__device__ __forceinline__ XcdBarrier xcd_barrier_post(unsigned* bar, volatile LAS unsigned* st) {
    XcdBarrier b; b.bar = bar; b.x = xb_xcc_id(); b.st = st;
    if (threadIdx.x == 0) (void)xb_add(&bar[XB_XCNT(b.x)], 1u);
    return b;
}
__device__ __forceinline__ void xcd_barrier_complete(unsigned* bar, unsigned x, unsigned& nloc, unsigned& nx) {
    const unsigned G = gridDim.x * gridDim.y * gridDim.z;
    unsigned sum, cnt, mine, sp = 0u;
    for (;;) {
        sum = 0u; cnt = 0u; mine = 0u;
#pragma unroll
        for (unsigned j = 0; j < 16; ++j) { const unsigned c = xb_ld(&bar[XB_XCNT(j)]); sum += c; cnt += (c > 0u) ? 1u : 0u; mine = (j == x) ? c : mine; }
        if (sum == G) break;
        __builtin_amdgcn_s_sleep(1);
        if ((++sp & 255u) == 0u) { if (xb_ld(&bar[XB_TMO])) break; if (sp > XB_SPIN_CAP) { atomicAdd(&bar[XB_TMO], 1u); break; } }
    }
    nloc = mine > 0u ? mine : 1u; nx = cnt > 0u ? cnt : 1u;
}
__device__ __forceinline__ void xcd_barrier(const XcdBarrier& b) {
    asm volatile("s_waitcnt vmcnt(0)" ::: "memory");
    __syncthreads();
    if (threadIdx.x == 0) {
        unsigned* bar = b.bar;
        __builtin_amdgcn_s_waitcnt(0);
        unsigned nloc = b.st[0], nx = b.st[1];
        if (nloc == 0u) { xcd_barrier_complete(bar, b.x, nloc, nx); b.st[0] = nloc; b.st[1] = nx; }
        const unsigned old = xb_add(&bar[XB_XSUB(b.x)], 1u);
        const unsigned gen = old / nloc;
        if (old + 1u == (gen + 1u) * nloc) {
            __builtin_amdgcn_fence(__ATOMIC_RELEASE, "agent");
            asm volatile("s_waitcnt vmcnt(0)" ::: "memory");
            const unsigned og = xb_add(&bar[XB_TOP], 1u);
            const unsigned tg = og / nx;
            if (og + 1u == (tg + 1u) * nx) xb_add(&bar[XB_TOPGEN], 1u);
            else XB_SPIN(xb_ld(&bar[XB_TOPGEN]) == tg, bar);
            __builtin_amdgcn_fence(__ATOMIC_ACQUIRE, "agent");
            xb_add(&bar[XB_XGEN(b.x)], 1u);
            asm volatile("s_waitcnt vmcnt(0)" ::: "memory");
        } else {
            XB_SPIN(xb_ld(&bar[XB_XGEN(b.x)]) == gen, bar);
            __builtin_amdgcn_fence(__ATOMIC_ACQUIRE, "agent");
            asm volatile("s_waitcnt vmcnt(0)" ::: "memory");
        }
    }
    __syncthreads();
}

namespace pg8 {
constexpr int BM = 256, BK = 64, HALF = 128, NXCD = 8, WGM = 8;
__host__ __device__ __forceinline__ int perm32(int rho) { const int n = rho >> 4, i = rho & 15; return 8 * (i >> 2) + 4 * n + (i & 3); }
struct Unit { int arow, brow, orow, ocol; };
struct Gemm { const bf16_t* A; const bf16_t* Bt; int K; };

__device__ __forceinline__ bool order_map(long L, int nM, int nN, int& pm, int& pn) {
    const int nwg = nM * nN; if (L >= nwg) return false;
    int wgid = (int)L; { const int q = nwg / NXCD, r = nwg % NXCD, xcd = wgid % NXCD, off = wgid / NXCD; wgid = (xcd < r ? xcd * (q + 1) : r * (q + 1) + (xcd - r) * q) + off; }
    const int nig = WGM * nN, gid = wgid / nig, fm = gid * WGM, gsz = (nM - fm) < WGM ? (nM - fm) : WGM;
    pm = fm + ((wgid % nig) % gsz); pn = (wgid % nig) / gsz; return true;
}
struct StaticOrder {
    int nM, nN, G, c;
    __device__ void init(int M, int N, int G_, int c_) { nM = M / BM; nN = N / BM; G = G_; c = c_; }
    __device__ __forceinline__ bool next(int i, Unit& u) const {
        int pm, pn; if (!order_map((long)i * G + c, nM, nN, pm, pn)) return false;
        u.arow = pm * BM; u.brow = pn * BM; u.orow = pm * BM; u.ocol = pn; return true;
    }
};
struct MoeOrder {
    int mtp[NE + 1]; int nN, brows, G, c;
    __device__ __forceinline__ bool next(int i, Unit& u) const {
        int pm, pn; if (!order_map((long)i * G + c, mtp[NE], nN, pm, pn)) return false;
        int e = 0;
#pragma unroll
        for (int j = 1; j < NE; ++j) e += (pm >= mtp[j]) ? 1 : 0;
        u.arow = pm * BM; u.orow = pm * BM; u.brow = e * brows + pn * BM; u.ocol = pn; return true;
    }
};

struct RowScale {
    const float* p; int mode;
    __device__ __forceinline__ float get(int row) const {
        if (mode == 0) return p[row];
        if (mode == 1) { const f32x4 q = *(const f32x4*)(p + 4 * (size_t)row); return __builtin_amdgcn_rsqf(((q[0] + q[1]) + (q[2] + q[3])) * (1.0f / DM) + RMS_EPS); }
        return 1.0f;
    }
};
struct EpiQKV {
    static constexpr bool PERM = true, AFTER_DRAIN = false;
    bf16_t* base; size_t stride; int rot; RowScale R;
    __device__ __forceinline__ void operator()(const f32x4 (&acc)[2][4][2], int ai, const Unit& u, int wr, int wc, int fr, int fq) const {
        int d = (u.ocol >> 2) + rot; d = d >= 3 ? d - 3 : d; bf16_t* ob = base + (size_t)d * stride; const float sc = d == 0 ? C2 : 1.0f;
        const int col0 = (u.ocol & 3) * BM + wc * 32 + 8 * fq;
#pragma unroll
            for (int m = 0; m < 4; ++m) { const int row = u.orow + ai * HALF + wr * 64 + m * 16 + fr; const float rr = R.get(row) * sc; bf16_t* rowp = ob + (size_t)row * DM + col0;
#pragma unroll
                for (int bj = 0; bj < 2; ++bj) { const f32x4 v0 = acc[bj][m][0] * rr, v1 = acc[bj][m][1] * rr;
                    u32x4 w; w.x = pk2(v0[0], v0[1]); w.y = pk2(v0[2], v0[3]); w.z = pk2(v1[0], v1[1]); w.w = pk2(v1[2], v1[3]);
                    *(u32x4*)(rowp + bj * HALF) = w; } }
    }
};
struct EpiBf16 {
    static constexpr bool PERM = true, AFTER_DRAIN = false;
    bf16_t* O; int ldo;
    __device__ __forceinline__ void operator()(const f32x4 (&acc)[2][4][2], int ai, const Unit& u, int wr, int wc, int fr, int fq) const {
        const int col0 = u.ocol * BM + wc * 32 + 8 * fq;
#pragma unroll
            for (int m = 0; m < 4; ++m) { const int row = u.orow + ai * HALF + wr * 64 + m * 16 + fr; bf16_t* rowp = O + (size_t)row * ldo + col0;
#pragma unroll
                for (int bj = 0; bj < 2; ++bj) { const f32x4 v0 = acc[bj][m][0], v1 = acc[bj][m][1];
                    u32x4 w; w.x = pk2(v0[0], v0[1]); w.y = pk2(v0[2], v0[3]); w.z = pk2(v1[0], v1[1]); w.w = pk2(v1[2], v1[3]);
                    *(u32x4*)(rowp + bj * HALF) = w; } }
    }
};
struct EpiSwiGLU {
    static constexpr bool PERM = true, AFTER_DRAIN = false;
    bf16_t* O; int ldo; RowScale R;
    __device__ __forceinline__ void operator()(const f32x4 (&acc)[2][4][2], int ai, const Unit& u, int wr, int wc, int fr, int fq) const {
        const int col0 = u.ocol * HALF + wc * 32 + 8 * fq;
#pragma unroll
            for (int m = 0; m < 4; ++m) { const int row = u.orow + ai * HALF + wr * 64 + m * 16 + fr; const float rr = R.get(row); float o[8];
#pragma unroll
                for (int n = 0; n < 2; ++n)
#pragma unroll
                    for (int j = 0; j < 4; ++j) { const float g = acc[0][m][n][j] * rr, uu = acc[1][m][n][j] * rr;
                        o[n * 4 + j] = g * __builtin_amdgcn_rcpf(1.0f + __builtin_amdgcn_exp2f(-g * LOG2E)) * uu; }
                u32x4 w; w.x = pk2(o[0], o[1]); w.y = pk2(o[2], o[3]); w.z = pk2(o[4], o[5]); w.w = pk2(o[6], o[7]);
                *(u32x4*)(O + (size_t)row * ldo + col0) = w; asm volatile("" ::: "memory"); }
    }
};
struct EpiMoeDown {
    static constexpr bool PERM = true, AFTER_DRAIN = false;
    bf16_t* O; const float* gate;
    __device__ __forceinline__ void operator()(const f32x4 (&acc)[2][4][2], int ai, const Unit& u, int wr, int wc, int fr, int fq) const {
        const int col0 = u.ocol * BM + wc * 32 + 8 * fq;
#pragma unroll
            for (int m = 0; m < 4; ++m) { const int row = u.orow + ai * HALF + wr * 64 + m * 16 + fr; const float gt = gate[row]; bf16_t* rowp = O + (size_t)row * DM + col0;
#pragma unroll
                for (int bj = 0; bj < 2; ++bj) { const f32x4 v0 = acc[bj][m][0] * gt, v1 = acc[bj][m][1] * gt;
                    u32x4 w; w.x = pk2(v0[0], v0[1]); w.y = pk2(v0[2], v0[3]); w.z = pk2(v1[0], v1[1]); w.w = pk2(v1[2], v1[3]);
                    *(u32x4*)(rowp + bj * HALF) = w; } }
    }
};
__device__ __forceinline__ void row_sumsq_to_slab(const f32x4 (&v)[2][4][2], int ai, const Unit& u, int wr, int wc, int fr, int fq, LAS unsigned char* lds, float* slab) {
    LAS float* P = (LAS float*)lds;
#pragma unroll
    for (int m = 0; m < 4; ++m) { float s = 0.f;
#pragma unroll
        for (int bj = 0; bj < 2; ++bj)
#pragma unroll
            for (int n = 0; n < 2; ++n) { const f32x4 x = v[bj][m][n]; s += (x[0] * x[0] + x[1] * x[1]) + (x[2] * x[2] + x[3] * x[3]); }
        s += __shfl_xor(s, 16); s += __shfl_xor(s, 32);
        if (fq == 0) P[(wr * 64 + m * 16 + fr) * 4 + wc] = s; }
    __syncthreads();
    const int t = threadIdx.x;
    if (t < HALF) slab[(size_t)(u.orow + ai * HALF + t) * 4 + u.ocol] = (P[t * 4 + 0] + P[t * 4 + 1]) + (P[t * 4 + 2] + P[t * 4 + 3]);
    __syncthreads();
}
struct EpiResid {
    static constexpr bool PERM = false, AFTER_DRAIN = true;
    const float* base; float* out; bf16_t* hb; float* slab;
    __device__ __forceinline__ void fused(f32x4 (&acc)[2][4][2], int ai, const Unit& u, int wr, int wc, int fr, int fq, LAS unsigned char* lds) const {
        const int col0 = u.ocol * BM + wc * 32 + 4 * fq;
#pragma unroll
            for (int m = 0; m < 4; ++m) { const size_t off = (size_t)(u.orow + ai * HALF + wr * 64 + m * 16 + fr) * DM + col0;
#pragma unroll
                for (int bj = 0; bj < 2; ++bj)
#pragma unroll
                    for (int n = 0; n < 2; ++n) { const size_t o2 = off + bj * HALF + n * 16; const f32x4 v = *(const f32x4*)(base + o2) + acc[bj][m][n]; acc[bj][m][n] = v;
                        *(f32x4*)(out + o2) = v; if (hb) { u32x2 w; w.x = pk2(v[0], v[1]); w.y = pk2(v[2], v[3]); *(u32x2*)(hb + o2) = w; } }
                asm volatile("" ::: "memory"); }
        if (slab) row_sumsq_to_slab(acc, ai, u, wr, wc, fr, fq, lds, slab);
    }
};
struct EpiPLE {
    static constexpr bool PERM = false, AFTER_DRAIN = true;
    float* h; const bf16_t* pp; bf16_t* hb; float* slab;
    __device__ __forceinline__ void fused(f32x4 (&acc)[2][4][2], int ai, const Unit& u, int wr, int wc, int fr, int fq, LAS unsigned char* lds) const {
        const int col0 = u.ocol * BM + wc * 32 + 4 * fq;
#pragma unroll
            for (int m = 0; m < 4; ++m) { const size_t off = (size_t)(u.orow + ai * HALF + wr * 64 + m * 16 + fr) * DM + col0;
#pragma unroll
                for (int bj = 0; bj < 2; ++bj)
#pragma unroll
                    for (int n = 0; n < 2; ++n) { const size_t o2 = off + bj * HALF + n * 16; const f32x4 a = acc[bj][m][n]; const u32x2 pw = *(const u32x2*)(pp + o2);
                        f32x4 v = *(const f32x4*)(h + o2);
                        v[0] += bflo(pw.x) * __builtin_amdgcn_rcpf(1.0f + __builtin_amdgcn_exp2f(-a[0] * LOG2E));
                        v[1] += bfhi(pw.x) * __builtin_amdgcn_rcpf(1.0f + __builtin_amdgcn_exp2f(-a[1] * LOG2E));
                        v[2] += bflo(pw.y) * __builtin_amdgcn_rcpf(1.0f + __builtin_amdgcn_exp2f(-a[2] * LOG2E));
                        v[3] += bfhi(pw.y) * __builtin_amdgcn_rcpf(1.0f + __builtin_amdgcn_exp2f(-a[3] * LOG2E));
                        acc[bj][m][n] = v; *(f32x4*)(h + o2) = v; if (hb) { u32x2 w; w.x = pk2(v[0], v[1]); w.y = pk2(v[2], v[3]); *(u32x2*)(hb + o2) = w; } }
                asm volatile("" ::: "memory"); }
        if (slab) row_sumsq_to_slab(acc, ai, u, wr, wc, fr, fq, lds, slab);
    }
};

template <class Epi, class Sched>
__device__ __forceinline__ void gemm_simple(LAS unsigned char* lds, const Gemm g, const Sched& S, const Epi& E) {
    const int tid = threadIdx.x, wid = __builtin_amdgcn_readfirstlane(tid >> 6), lane = tid & 63, wr = wid >> 2, wc = wid & 3, fr = lane & 15, fq = lane >> 4;
    const int K = g.K, nt = K / BK;
    Unit u;
    for (int i = 0; S.next(i, u); ++i) {
        const int br0 = Epi::PERM ? perm32(fr) : fr, br1 = Epi::PERM ? perm32(16 + fr) : 16 + fr;
        const bf16_t* Bb = g.Bt + (size_t)(u.brow + wc * 32) * K + fq * 8;
#pragma unroll 1
        for (int ai = 0; ai < 2; ++ai) {
            f32x4 acc[2][4][2];
#pragma unroll
            for (int b = 0; b < 2; ++b)
#pragma unroll
                for (int m = 0; m < 4; ++m)
#pragma unroll
                    for (int n = 0; n < 2; ++n) acc[b][m][n] = (f32x4){0.f, 0.f, 0.f, 0.f};
            const bf16_t* Ab = g.A + (size_t)(u.arow + ai * HALF + wr * 64 + fr) * K + fq * 8;
#pragma unroll 1
            for (int t = 0; t < nt; ++t) {
                bf16x8 Af[4][2];
#pragma unroll
                for (int m = 0; m < 4; ++m)
#pragma unroll
                    for (int k = 0; k < 2; ++k) Af[m][k] = *(const bf16x8*)(Ab + (size_t)(m * 16) * K + t * BK + k * 32);
#pragma unroll
                for (int bj = 0; bj < 2; ++bj) {
                    bf16x8 Bf[2][2];
#pragma unroll
                    for (int k = 0; k < 2; ++k) { Bf[0][k] = *(const bf16x8*)(Bb + (size_t)(bj * HALF + br0) * K + t * BK + k * 32); Bf[1][k] = *(const bf16x8*)(Bb + (size_t)(bj * HALF + br1) * K + t * BK + k * 32); }
#pragma unroll
                    for (int m = 0; m < 4; ++m)
#pragma unroll
                        for (int n = 0; n < 2; ++n)
#pragma unroll
                            for (int k = 0; k < 2; ++k) acc[bj][m][n] = __builtin_amdgcn_mfma_f32_16x16x32_bf16(Bf[n][k], Af[m][k], acc[bj][m][n], 0, 0, 0);
                }
            }
            if constexpr (Epi::AFTER_DRAIN) { __syncthreads(); E.fused(acc, ai, u, wr, wc, fr, fq, lds); }
            else E(acc, ai, u, wr, wc, fr, fq);
        }
    }
}

constexpr int HTB = HALF * BK * 2  , STAGE_BYTES = 8 * HTB;
__host__ __device__ __forceinline__ int lds_byte(int r, int c) { const int st = (r >> 4) * 2 + (c >> 5), rr = r & 15, cc = c & 31, ob = rr * 64 + cc * 2; return st * 1024 + (ob ^ (((ob >> 9) & 1) << 5)); }
__host__ __device__ __forceinline__ void stage_rc(int b, int& R, int& C) { const int st = b / 1024, sb = b % 1024, swz = sb ^ (((sb >> 9) & 1) << 5); R = (st >> 1) * 16 + swz / 64; C = (st & 1) * 32 + (swz % 64) / 2; }
template <class Epi, class Sched, bool ALIGN_EPI>
__device__ __forceinline__ void gemm_fast(LAS unsigned char* lds, const Gemm g, const Sched& S, const Epi& E) {
    const int tid = threadIdx.x, wid = __builtin_amdgcn_readfirstlane(tid >> 6), lane = tid & 63, wr = wid >> 2, wc = wid & 3, fr = lane & 15, fq = lane >> 4;
    int K_ = g.K; asm volatile("" : "+s"(K_));
    const int K = K_, nt = K / BK;
    unsigned voffA[2], voffB[2];
#pragma unroll
    for (int i = 0; i < 2; ++i) { int R, C; stage_rc(tid * 16 + i * 8192, R, C); const int Rb = Epi::PERM ? ((R & ~31) + perm32(R & 31)) : R;
        voffA[i] = (unsigned)(R * K + C) * 2u; voffB[i] = (unsigned)(Rb * K + C) * 2u; }
    const size_t kstep = (size_t)(BK * 2);
    const size_t hstep = (size_t)HALF * K * 2;
    const size_t rstep = (size_t)K * 2;
    const unsigned ldsw = (unsigned)wid * 1024u;
    const int aoff = lds_byte(wr * 64 + fr, fq * 8), boff = lds_byte(wc * 32 + fr, fq * 8);
#define PG8_SA(b, h) (((b) * 2 + (h)) * HTB)
#define PG8_SB(b, h) ((4 + (b) * 2 + (h)) * HTB)
#define PG8_STAGE(bufoff, gbase, voff) do { _Pragma("unroll") for (int _i = 0; _i < 2; ++_i) \
        __builtin_amdgcn_global_load_lds((const unsigned*)((const char*)(gbase) + (voff)[_i]), (LAS unsigned*)(lds + (bufoff) + ldsw + _i * 8192), 16, 0, 0); } while (0)
#define PG8_LDA(dst, b, h) do { _Pragma("unroll") for (int m = 0; m < 4; ++m) _Pragma("unroll") for (int k = 0; k < 2; ++k) dst[m][k] = *(const LAS bf16x8*)(lds + PG8_SA(b, h) + aoff + m * 2048 + k * 1024); } while (0)
#define PG8_LDB(dst, b, h) do { _Pragma("unroll") for (int n = 0; n < 2; ++n) _Pragma("unroll") for (int k = 0; k < 2; ++k) dst[n][k] = *(const LAS bf16x8*)(lds + PG8_SB(b, h) + boff + n * 2048 + k * 1024); } while (0)
#define PG8_MMA(ai, bj, At, Bt) do { __builtin_amdgcn_s_setprio(1); _Pragma("unroll") for (int m = 0; m < 4; ++m) _Pragma("unroll") for (int n = 0; n < 2; ++n) _Pragma("unroll") for (int k = 0; k < 2; ++k) \
        acc[ai][bj][m][n] = __builtin_amdgcn_mfma_f32_16x16x32_bf16(Bt[n][k], At[m][k], acc[ai][bj][m][n], 0, 0, 0); __builtin_amdgcn_s_setprio(0); } while (0)
#define PG8_WAIT_V(n) asm volatile("s_waitcnt vmcnt(" #n ")" ::: "memory")
#define PG8_WAIT_L(n) asm volatile("s_waitcnt lgkmcnt(" #n ")" ::: "memory")
#define PG8_BAR __builtin_amdgcn_s_barrier()
#define PG8_SCHED __builtin_amdgcn_sched_barrier(0)
    Unit cur, nxt; int ui = 0;
    if (!S.next(0, cur)) return;
    f32x4 acc[2][2][4][2];
#pragma unroll
    for (int a = 0; a < 2; ++a)
#pragma unroll
        for (int b = 0; b < 2; ++b)
#pragma unroll
            for (int m = 0; m < 4; ++m)
#pragma unroll
                for (int n = 0; n < 2; ++n) acc[a][b][m][n] = (f32x4){0.f, 0.f, 0.f, 0.f};
    bf16x8 At[4][2], B0[2][2], B1[2][2];
    const char* cA = (const char*)g.A + (size_t)cur.arow * rstep; const char* cB = (const char*)g.Bt + (size_t)cur.brow * rstep;
    PG8_STAGE(PG8_SB(0, 0), cB, voffB); PG8_STAGE(PG8_SB(0, 1), cB + hstep, voffB); PG8_STAGE(PG8_SA(0, 0), cA, voffA); PG8_STAGE(PG8_SA(0, 1), cA + hstep, voffA);
    if (wr == 1) PG8_BAR;
    PG8_WAIT_V(2); PG8_BAR;
    PG8_STAGE(PG8_SB(1, 0), cB + kstep, voffB); PG8_STAGE(PG8_SA(1, 0), cA + kstep, voffA); PG8_STAGE(PG8_SB(1, 1), cB + hstep + kstep, voffB);
    PG8_WAIT_V(6); PG8_BAR;
    for (;;) {
        const bool has_next = S.next(ui + 1, nxt);
        const char* nA = has_next ? (const char*)g.A + (size_t)nxt.arow * rstep : cA; const char* nB = has_next ? (const char*)g.Bt + (size_t)nxt.brow * rstep : cB;
        for (int t = 0; t < nt; t += 2) {
            const bool last = (t == nt - 2);
            const char* a1 = cA + (size_t)(t + 1) * kstep;
            const char* a2 = last ? nA : cA + (size_t)(t + 2) * kstep; const char* b2 = last ? nB : cB + (size_t)(t + 2) * kstep;
            const char* a3 = a2 + kstep; const char* b3 = b2 + kstep;
            PG8_LDB(B0, 0, 0); PG8_LDB(B1, 0, 1); PG8_SCHED; PG8_LDA(At, 0, 0); PG8_STAGE(PG8_SA(1, 1), a1 + hstep, voffA);
            PG8_WAIT_V(8); PG8_WAIT_L(0); PG8_BAR; PG8_MMA(0, 0, At, B0); PG8_MMA(0, 1, At, B1); PG8_BAR; PG8_SCHED;
            PG8_LDA(At, 0, 1); PG8_STAGE(PG8_SB(0, 0), b2, voffB); PG8_STAGE(PG8_SB(0, 1), b2 + hstep, voffB); PG8_STAGE(PG8_SA(0, 0), a2, voffA);
            PG8_WAIT_V(8); PG8_WAIT_L(0); PG8_BAR; PG8_MMA(1, 0, At, B0); PG8_MMA(1, 1, At, B1); PG8_BAR; PG8_SCHED;
            PG8_LDB(B0, 1, 0); PG8_LDB(B1, 1, 1); PG8_SCHED; PG8_LDA(At, 1, 0); PG8_STAGE(PG8_SA(0, 1), a2 + hstep, voffA);
            PG8_WAIT_V(8); PG8_WAIT_L(0); PG8_BAR; PG8_MMA(0, 0, At, B0); PG8_MMA(0, 1, At, B1); PG8_BAR; PG8_SCHED;
            PG8_LDA(At, 1, 1); PG8_STAGE(PG8_SB(1, 0), b3, voffB); PG8_STAGE(PG8_SB(1, 1), b3 + hstep, voffB); PG8_STAGE(PG8_SA(1, 0), a3, voffA);
            PG8_WAIT_V(8); PG8_WAIT_L(0); PG8_BAR; PG8_MMA(1, 0, At, B0); PG8_MMA(1, 1, At, B1); PG8_BAR; PG8_SCHED;
        }
        if constexpr (ALIGN_EPI) { if (wr == 0) PG8_BAR; }
        if constexpr (!Epi::AFTER_DRAIN) { E(acc[0], 0, cur, wr, wc, fr, fq); E(acc[1], 1, cur, wr, wc, fr, fq); }
        if (!has_next) break;
#pragma unroll
        for (int a = 0; a < 2; ++a)
#pragma unroll
            for (int b = 0; b < 2; ++b)
#pragma unroll
                for (int m = 0; m < 4; ++m)
#pragma unroll
                    for (int n = 0; n < 2; ++n) acc[a][b][m][n] = (f32x4){0.f, 0.f, 0.f, 0.f};
        cur = nxt; cA = nA; cB = nB; ++ui;
        if constexpr (ALIGN_EPI) { if (wr == 1) PG8_BAR; }
    }
    PG8_WAIT_V(0);
    if constexpr (!ALIGN_EPI) { if (wr == 0) PG8_BAR; }
    PG8_BAR;
    if constexpr (Epi::AFTER_DRAIN) { E.fused(acc[0], 0, cur, wr, wc, fr, fq, lds); E.fused(acc[1], 1, cur, wr, wc, fr, fq, lds); }
#undef PG8_SA
#undef PG8_SB
#undef PG8_STAGE
#undef PG8_LDA
#undef PG8_LDB
#undef PG8_MMA
#undef PG8_WAIT_V
#undef PG8_WAIT_L
#undef PG8_BAR
#undef PG8_SCHED
}
template <class Epi, class Sched>
__device__ __forceinline__ void gemm_phase(LAS unsigned char* lds, const Gemm g, const Sched& S, const Epi& E) {
#if defined(SIMPLE_GEMM)
    gemm_simple(lds, g, S, E);
#else
    gemm_fast<Epi, Sched, !Epi::AFTER_DRAIN>(lds, g, S, E);
    __syncthreads();
#endif
}
}

namespace fox_body {
using bf16=__hip_bfloat16;
using bf16x8=__attribute__((ext_vector_type(8)))short;
using s16x4=__attribute__((ext_vector_type(4)))short;
using f32x16=__attribute__((ext_vector_type(16)))float;
using u32x4=__attribute__((ext_vector_type(4)))unsigned;
using f32x4v=__attribute__((ext_vector_type(4)))float;
constexpr int BATCH=8,NHEAD=16,SEQ=2048,D=64,DM=NHEAD*D;
constexpr int NW=8,QBLK=32,QB=QBLK*NW,KVBLK=64,NQB=SEQ/QB;
constexpr int ATTN_PITCH=DM, ATTN_UNIT_ROWS=QB;
__device__ __forceinline__ int crow(int r,int hi){return (r&3)+8*(r>>2)+4*hi;}
#define SBAR() __builtin_amdgcn_sched_barrier(0)
__device__ __forceinline__ void cmask(f32x16&p0,f32x16&p1,int jb,int qrel,int hi){
  const float NEG=-INFINITY; int kb=64*jb+4*hi;
  #pragma unroll
  for(int r=0;r<16;++r){int kv=kb+(r&3)+8*(r>>2); if(kv>qrel)p0[r]=NEG; if(kv+32>qrel)p1[r]=NEG;}
}

constexpr int NSLOT=3, SLOTB=8192;
constexpr int LDS_K=0, LDS_V=NSLOT*SLOTB, LDS_WS=2*NSLOT*SLOTB, LDS_OST=LDS_WS+NW*64*4, LDS_CS=LDS_OST+NW*4096, LDS_BYTES=LDS_CS+SEQ*4;
constexpr float C2=0.125f*1.4426950408889634f;
__device__ __forceinline__ void glds16(const void*gsrc,unsigned lds_dst){unsigned keep;
  asm volatile("s_mov_b32 %0, m0\n\ts_mov_b32 m0, %2\n\ts_nop 0\n\tglobal_load_lds_dwordx4 %1, off\n\ts_mov_b32 m0, %0":"=&s"(keep):"v"(gsrc),"s"(lds_dst):"memory");}
__device__ __forceinline__ float max3f(float a,float b,float c){float r;asm("v_max3_f32 %0, %1, %2, %3":"=v"(r):"v"(a),"v"(b),"v"(c));return r;}
__device__ __forceinline__ float max2f(float a,float b){float r;asm("v_max_f32_e32 %0, %1, %2":"=v"(r):"v"(a),"v"(b));return r;}
__device__ __forceinline__ float fadd_s(float a,float b){float r;asm("v_add_f32_e32 %0, %1, %2":"=v"(r):"v"(a),"v"(b));return r;}
__device__ __forceinline__ float fsub_s(float a,float b){float r;asm("v_sub_f32_e32 %0, %1, %2":"=v"(r):"v"(a),"v"(b));return r;}
typedef float f32x2_t __attribute__((ext_vector_type(2))); typedef __bf16 bf16x2_t __attribute__((ext_vector_type(2)));
__device__ __forceinline__ unsigned cvtpk_s(float lo,float hi){f32x2_t v={lo,hi};bf16x2_t b=__builtin_convertvector(v,bf16x2_t);return __builtin_bit_cast(unsigned,b);}
#define WAIT_BAR(N) asm volatile("s_waitcnt vmcnt(" #N ") lgkmcnt(0)\n\ts_barrier":::"memory")

__device__ __forceinline__ void qkt(f32x16&p0,f32x16&p1,const char*Kslot,const bf16x8*qr,const f32x16&negm,int r32,int hi){
  const char*kb=Kslot+hi*1024+r32*16;
  #pragma unroll
  for(int d0=0;d0<4;++d0){
    const bf16x8 b0=*reinterpret_cast<const bf16x8*>(kb+d0*2048);
    const bf16x8 b1=*reinterpret_cast<const bf16x8*>(kb+d0*2048+512);
    if(d0==0){p0=__builtin_amdgcn_mfma_f32_32x32x16_bf16(b0,qr[0],negm,0,0,0);p1=__builtin_amdgcn_mfma_f32_32x32x16_bf16(b1,qr[0],negm,0,0,0);}
    else{p0=__builtin_amdgcn_mfma_f32_32x32x16_bf16(b0,qr[d0],p0,0,0,0);p1=__builtin_amdgcn_mfma_f32_32x32x16_bf16(b1,qr[d0],p1,0,0,0);}}
}
typedef __attribute__((address_space(3))) const char* lds_cptr;
typedef short v4i16_t __attribute__((ext_vector_type(4)));
__device__ __forceinline__ void kload8(bf16x8*kf,lds_cptr kp){
  kf[0]=*(const __attribute__((address_space(3))) bf16x8*)(kp);      kf[1]=*(const __attribute__((address_space(3))) bf16x8*)(kp+512);
  kf[2]=*(const __attribute__((address_space(3))) bf16x8*)(kp+2048); kf[3]=*(const __attribute__((address_space(3))) bf16x8*)(kp+2560);
  kf[4]=*(const __attribute__((address_space(3))) bf16x8*)(kp+4096); kf[5]=*(const __attribute__((address_space(3))) bf16x8*)(kp+4608);
  kf[6]=*(const __attribute__((address_space(3))) bf16x8*)(kp+6144); kf[7]=*(const __attribute__((address_space(3))) bf16x8*)(kp+6656);
}
__device__ __forceinline__ void kload2(bf16x8*kf,lds_cptr kp,int j){ kf[2*j]=*(const __attribute__((address_space(3))) bf16x8*)(kp+j*2048); kf[2*j+1]=*(const __attribute__((address_space(3))) bf16x8*)(kp+j*2048+512); }
__device__ __forceinline__ s16x4 vtr(lds_cptr p){ return __builtin_bit_cast(s16x4,__builtin_amdgcn_ds_read_tr16_b64_v4i16((__attribute__((address_space(3))) v4i16_t*)p)); }
__device__ __forceinline__ float rowmax(const f32x16&p0,const f32x16&p1){
  float a=max3f(p0[0],p0[1],p1[0]),b=max3f(p0[2],p0[3],p1[1]);a=max3f(a,p1[2],p1[3]);
  #pragma unroll
  for(int r=4;r<16;r+=4){a=max3f(a,p0[r],p0[r+1]);b=max3f(b,p0[r+2],p0[r+3]);a=max3f(a,p1[r],p1[r+1]);b=max3f(b,p1[r+2],p1[r+3]);}
  const float m=max2f(a,b);
  auto rr=__builtin_amdgcn_permlane32_swap(__float_as_uint(m),__float_as_uint(m),false,false);
  return max2f(__uint_as_float(rr[0]),__uint_as_float(rr[1]));
}
__device__ __forceinline__ void pv(f32x16*o,int vb,bf16x8 pa0,bf16x8 pa1,bf16x8 pa2,bf16x8 pa3){
  #pragma unroll
  for(int d0=0;d0<2;++d0){s16x4 lo[4],hi[4];
    #pragma unroll
    for(int ks=0;ks<4;++ks){
      asm volatile("ds_read_b64_tr_b16 %0,%1 offset:%c2":"=&v"(lo[ks]):"v"(vb),"i"(d0*4096+ks*1024):"memory");
      asm volatile("ds_read_b64_tr_b16 %0,%1 offset:%c2":"=&v"(hi[ks]):"v"(vb),"i"(d0*4096+ks*1024+512):"memory");}
    asm volatile("s_waitcnt lgkmcnt(0)":::"memory");SBAR();
    #define PK(k) (bf16x8){lo[k][0],lo[k][1],lo[k][2],lo[k][3],hi[k][0],hi[k][1],hi[k][2],hi[k][3]}
    o[d0]=__builtin_amdgcn_mfma_f32_32x32x16_bf16(pa0,PK(0),o[d0],0,0,0);
    o[d0]=__builtin_amdgcn_mfma_f32_32x32x16_bf16(pa1,PK(1),o[d0],0,0,0);
    o[d0]=__builtin_amdgcn_mfma_f32_32x32x16_bf16(pa2,PK(2),o[d0],0,0,0);
    o[d0]=__builtin_amdgcn_mfma_f32_32x32x16_bf16(pa3,PK(3),o[d0],0,0,0);
    #undef PK
  }
}

#ifndef ATTN_STORE16
#define ATTN_STORE16(p,v) (*(u32x4*)(p)=(v))
#endif
template<int THRL> __device__ __forceinline__ void attn_unit(int b,int h,int qb,const bf16*Q,const bf16*__restrict__ K,const bf16*__restrict__ V,bf16*O,char*shm){
  const int tid=threadIdx.x,lane=tid&63,r32=lane&31,hi=lane>>5; const int wid=__builtin_amdgcn_readfirstlane(tid>>6);
  const long rowbase=(long)b*SEQ; const int q0=qb*QB;
  const bf16*Qw=Q+(rowbase+q0+wid*QBLK)*DM+h*D;
  const bf16*Kh=K+rowbase*DM+h*D,*Vh=V+rowbase*DM+h*D;
  const unsigned lds0=(unsigned)(uintptr_t)shm;
  float*wsf=(float*)(shm+LDS_WS)+wid*64;
  const bf16*ksrc=Kh+(long)lane*DM+wid*8;
  const bf16*vsrc=Vh+(long)(16*(wid&3)+(lane>>2))*DM+(wid>>2)*32+(lane&3)*8;
  const unsigned kdst=lds0+LDS_K+wid*1024, vdst=lds0+LDS_V+wid*1024;
  #define DMA_K(t,slot) glds16(ksrc+(long)(t)*KVBLK*DM,(unsigned)__builtin_amdgcn_readfirstlane(kdst+(slot)))
  #define DMA_V(t,slot) glds16(vsrc+(long)(t)*KVBLK*DM,(unsigned)__builtin_amdgcn_readfirstlane(vdst+(slot)))
  const int vb0=(int)(lds0+LDS_V)+((lane>>4)&1)*32+(lane&3)*8+(4*hi+((lane&15)>>2))*64;
  const char*Kbase=shm+LDS_K; bf16x8 kf[8];
  const lds_cptr shm3=(lds_cptr)shm; const lds_cptr kp0=shm3+LDS_K+hi*1024+r32*16; const lds_cptr vp0=shm3+LDS_V+((lane>>4)&1)*32+(lane&3)*8+(4*hi+((lane&15)>>2))*64;
  const int NT=(q0+QB)/KVBLK;
  DMA_K(0,0);DMA_V(0,0);DMA_K(1,SLOTB);
  __attribute__((address_space(3))) float*csl=(__attribute__((address_space(3))) float*)(uintptr_t)(unsigned)(uintptr_t)(shm+LDS_CS);
  const float ctq=csl[q0+wid*QBLK+r32];
  bf16x8 qr[4];
  #pragma unroll
  for(int d0=0;d0<4;++d0)qr[d0]=*reinterpret_cast<const bf16x8*>(&Qw[(long)r32*DM+d0*16+hi*8]);
  float mhat=-ctq,l_reg=0.f;f32x16 o[2];o[0]=f32x16{};o[1]=f32x16{};f32x16 negm;
  #pragma unroll
  for(int r=0;r<16;++r)negm[r]=ctq;
  asm volatile("":"+v"(negm));
  const int qrel=wid*QBLK+r32;
  #define CMASK(P0,P1,t) do{int jb_=(t)-(NT-4); if(jb_>=0)cmask(P0,P1,jb_,qrel,hi);}while(0)
  #define CSUB(P0,P1,t) do{ const __attribute__((address_space(3))) float*cp_=csl+(t)*KVBLK+4*hi; _Pragma("unroll") for(int g_=0;g_<4;g_+=2){ const f32x4v a_=*(const __attribute__((address_space(3))) f32x4v*)(cp_+8*g_), c_=*(const __attribute__((address_space(3))) f32x4v*)(cp_+8*g_+8); \
      _Pragma("unroll") for(int j_=0;j_<4;++j_){P0[4*g_+j_]-=a_[j_];P0[4*g_+4+j_]-=c_[j_];} SBAR(); } \
    _Pragma("unroll") for(int g_=0;g_<4;g_+=2){ const f32x4v b_=*(const __attribute__((address_space(3))) f32x4v*)(cp_+32+8*g_), d_=*(const __attribute__((address_space(3))) f32x4v*)(cp_+40+8*g_); \
      _Pragma("unroll") for(int j_=0;j_<4;++j_){P1[4*g_+j_]-=b_[j_];P1[4*g_+4+j_]-=d_[j_];} SBAR(); } }while(0)
  bool resc=false;
  #define START(P0,P1) do{ const float rm=rowmax(P0,P1); resc=false; \
    { const float dl=rm; mhat=fadd_s(mhat,dl); \
      _Pragma("unroll") for(int r=0;r<16;++r){P0[r]=fsub_s(P0[r],dl);P1[r]=fsub_s(P1[r],dl);} \
      _Pragma("unroll") for(int r=0;r<16;++r)negm[r]=-mhat; asm volatile("":"+v"(negm)); } \
    _Pragma("unroll") for(int r=0;r<16;++r)P0[r]=__builtin_amdgcn_exp2f(P0[r]); }while(0)
  #define RESC() do{ if(resc){ asm volatile("s_waitcnt lgkmcnt(0)":::"memory"); \
      _Pragma("unroll") for(int d_=0;d_<2;++d_) _Pragma("unroll") for(int r=0;r<16;++r)o[d_][r]*=wsf[crow(r,hi)]; } }while(0)
  f32x16 pA0,pA1,pB0,pB1;
  int sl_prev=0,sl_cur=0,sl_next=SLOTB;
  #define ROT() do{sl_prev=sl_cur;sl_cur=sl_next;sl_next=(sl_next==(NSLOT-1)*SLOTB)?0:sl_next+SLOTB;}while(0)
  DMA_K(2,2*SLOTB);
  WAIT_BAR(3);
  qkt(pA0,pA1,Kbase,qr,negm,r32,hi);asm volatile("s_nop 15\n\ts_nop 7":"+v"(pA0),"+v"(pA1));CSUB(pA0,pA1,0);CMASK(pA0,pA1,0);
  START(pA0,pA1);
  _Pragma("unroll") for(int r=0;r<16;++r)pA1[r]=__builtin_amdgcn_exp2f(pA1[r]);
  WAIT_BAR(0);
  DMA_K(3,0);DMA_V(1,SLOTB);
  ROT();
  kload8(kf,kp0+sl_cur);
  WAIT_BAR(2);
  s16x4 vlo[8],vhi[8]; u32x4 pw0,pw1,pw2,pw3;
  #define PKW(P,B) cvtpk_s(P[B],P[B+1])
  #define PAF(k) __builtin_bit_cast(bf16x8,pw##k)
  #define VFR(i) (bf16x8){vlo[i][0],vlo[i][1],vlo[i][2],vlo[i][3],vhi[i][0],vhi[i][1],vhi[i][2],vhi[i][3]}
  #define PIN(x) asm volatile("":"+v"(x))
  #define MX3(a,b,c) __builtin_fmaxf(__builtin_fmaxf((a),(b)),(c))
  #define GAPA(MF,A0,A1,A2,A3,W0,W1,PW) do{ MF; sacc+=A0; sacc+=A1; sacc+=A2; sacc+=A3; PIN(sacc); W0; W1; PIN(PW); SBAR(); }while(0)
  #define EX(v) __builtin_amdgcn_exp2f(v)
  #define GAPB(MF,X,B) do{ MF; X[B]=EX(X[B]); X[B+1]=EX(X[B+1]); X[B+2]=EX(X[B+2]); X[B+3]=EX(X[B+3]); PIN(X); SBAR(); }while(0)
  #define VRD(i) do{ vlo[i]=vtr(vp_+(((i)>>2)*4096+((i)&3)*1024)); vhi[i]=vtr(vp_+(((i)>>2)*4096+((i)&3)*1024+512)); }while(0)
  #define KRD(G,j) do{ if(G){ kload2(kf,kp0+sl_next,j); SBAR(); } }while(0)
  #define STEP(C0,C1,P0,P1,t,GK,GV,GL) do{ SBAR(); \
    const lds_cptr vp_=vp0+sl_prev; \
    VRD(0); SBAR(); float sacc=(P0[0]+P0[1]); \
    GAPA(C0=__builtin_amdgcn_mfma_f32_32x32x16_bf16(kf[0],qr[0],negm,0,0,0), P0[2],P0[3],P0[4],P0[5],     pw0[0]=PKW(P0,0), pw0[1]=PKW(P0,2), pw0); \
    VRD(4); SBAR(); GAPA(C1=__builtin_amdgcn_mfma_f32_32x32x16_bf16(kf[1],qr[0],negm,0,0,0), P0[6],P0[7],P0[8],P0[9],     pw0[2]=PKW(P0,4), pw0[3]=PKW(P0,6), pw0); \
    VRD(1); SBAR(); GAPA(C0=__builtin_amdgcn_mfma_f32_32x32x16_bf16(kf[2],qr[1],C0,0,0,0),   P0[10],P0[11],P0[12],P0[13], pw1[0]=PKW(P0,8), pw1[1]=PKW(P0,10), pw1); \
    VRD(5); SBAR(); GAPA(C1=__builtin_amdgcn_mfma_f32_32x32x16_bf16(kf[3],qr[1],C1,0,0,0),   P0[14],P0[15],P1[0],P1[1],   pw1[2]=PKW(P0,12),pw1[3]=PKW(P0,14), pw1); \
    VRD(2); SBAR(); GAPA(C0=__builtin_amdgcn_mfma_f32_32x32x16_bf16(kf[4],qr[2],C0,0,0,0),   P1[2],P1[3],P1[4],P1[5],     pw2[0]=PKW(P1,0), pw2[1]=PKW(P1,2), pw2); \
    VRD(6); SBAR(); GAPA(C1=__builtin_amdgcn_mfma_f32_32x32x16_bf16(kf[5],qr[2],C1,0,0,0),   P1[6],P1[7],P1[8],P1[9],     pw2[2]=PKW(P1,4), pw2[3]=PKW(P1,6), pw2); \
    VRD(3); SBAR(); GAPA(C0=__builtin_amdgcn_mfma_f32_32x32x16_bf16(kf[6],qr[3],C0,0,0,0),   P1[10],P1[11],P1[12],P1[13], pw3[0]=PKW(P1,8), pw3[1]=PKW(P1,10), pw3); \
    VRD(7); SBAR(); GAPA(C1=__builtin_amdgcn_mfma_f32_32x32x16_bf16(kf[7],qr[3],C1,0,0,0),   P1[14],P1[15],0.f,0.f,       pw3[2]=PKW(P1,12),pw3[3]=PKW(P1,14), pw3); \
    l_reg+=sacc; \
    if(GK){DMA_K((t)+3,sl_cur);} if(GV){DMA_V((t)+1,sl_next);} \
    SBAR(); CSUB(C0,C1,t); CMASK(C0,C1,t); \
    { float a=MX3(C0[0],C0[1],C1[0]),b=MX3(C0[2],C0[3],C1[1]); a=MX3(a,C1[2],C1[3]); \
      _Pragma("unroll") for(int r=4;r<16;r+=4){a=MX3(a,C0[r],C0[r+1]);b=MX3(b,C0[r+2],C0[r+3]);a=MX3(a,C1[r],C1[r+1]);b=MX3(b,C1[r+2],C1[r+3]);} \
      float rm=__builtin_fmaxf(a,b); { auto rr=__builtin_amdgcn_permlane32_swap(__float_as_uint(rm),__float_as_uint(rm),false,false); rm=__builtin_fmaxf(__uint_as_float(rr[0]),__uint_as_float(rr[1])); } \
      resc=false; \
      if(__builtin_expect(__any(rm>(float)THRL),0)){ const float dl=__builtin_fmaxf(rm,0.f); mhat+=dl; \
        _Pragma("unroll") for(int r=0;r<16;++r){C0[r]-=dl;C1[r]-=dl;} \
        _Pragma("unroll") for(int r=0;r<16;++r)negm[r]=-mhat; asm volatile("":"+v"(negm)); \
        const float f=__builtin_amdgcn_exp2f(-dl); l_reg*=f; if(hi==0)wsf[r32]=f; resc=true; } } \
    SBAR(); \
    GAPB(o[0]=__builtin_amdgcn_mfma_f32_32x32x16_bf16(PAF(0),VFR(0),o[0],0,0,0), C0,0); \
    GAPB(o[1]=__builtin_amdgcn_mfma_f32_32x32x16_bf16(PAF(0),VFR(4),o[1],0,0,0), C0,4); \
    KRD(GL,0); GAPB(o[0]=__builtin_amdgcn_mfma_f32_32x32x16_bf16(PAF(1),VFR(1),o[0],0,0,0), C0,8); \
    KRD(GL,1); GAPB(o[1]=__builtin_amdgcn_mfma_f32_32x32x16_bf16(PAF(1),VFR(5),o[1],0,0,0), C0,12); \
    KRD(GL,2); GAPB(o[0]=__builtin_amdgcn_mfma_f32_32x32x16_bf16(PAF(2),VFR(2),o[0],0,0,0), C1,0); \
    KRD(GL,3); GAPB(o[1]=__builtin_amdgcn_mfma_f32_32x32x16_bf16(PAF(2),VFR(6),o[1],0,0,0), C1,4); \
    GAPB(o[0]=__builtin_amdgcn_mfma_f32_32x32x16_bf16(PAF(3),VFR(3),o[0],0,0,0), C1,8); \
    GAPB(o[1]=__builtin_amdgcn_mfma_f32_32x32x16_bf16(PAF(3),VFR(7),o[1],0,0,0), C1,12); \
    }while(0)
  int t=1;
  #undef CMASK
  #define CMASK(P0,P1,t) do{}while(0)
  for(;t+5<NT;t+=2){
    STEP(pB0,pB1,pA0,pA1,t,true,true,true);     WAIT_BAR(2); RESC(); ROT();
    STEP(pA0,pA1,pB0,pB1,t+1,true,true,true);   WAIT_BAR(2); RESC(); ROT();
  }
  #undef CMASK
  #define CMASK(P0,P1,t) do{int jb_=(t)-(NT-4); if(jb_>=0)cmask(P0,P1,jb_,qrel,hi);}while(0)
  #define ENDW(tt) do{ if((tt)+3<NT){WAIT_BAR(2);} else if((tt)+2<NT){WAIT_BAR(1);} else {WAIT_BAR(0);} }while(0)
  for(;t+1<NT;t+=2){
    STEP(pB0,pB1,pA0,pA1,t,(t+3<NT),(t+1<NT),(t+1<NT));       ENDW(t);   RESC(); ROT();
    STEP(pA0,pA1,pB0,pB1,t+1,(t+4<NT),(t+2<NT),(t+2<NT));     ENDW(t+1); RESC(); ROT();
  }
  STEP(pB0,pB1,pA0,pA1,NT-1,false,false,false); RESC();
  { float sacc=pB0[0]+pB0[1]; _Pragma("unroll") for(int r=2;r<16;++r)sacc+=pB0[r]; _Pragma("unroll") for(int r=0;r<16;++r)sacc+=pB1[r]; l_reg+=sacc;
    pw0=(u32x4){PKW(pB0,0),PKW(pB0,2),PKW(pB0,4),PKW(pB0,6)};pw1=(u32x4){PKW(pB0,8),PKW(pB0,10),PKW(pB0,12),PKW(pB0,14)};pw2=(u32x4){PKW(pB1,0),PKW(pB1,2),PKW(pB1,4),PKW(pB1,6)};pw3=(u32x4){PKW(pB1,8),PKW(pB1,10),PKW(pB1,12),PKW(pB1,14)};
    SBAR(); pv(o,vb0+sl_cur,PAF(0),PAF(1),PAF(2),PAF(3)); }
  #undef PKW
  #undef PAF
  #undef VFR
  #undef PIN
  #undef MX3
  #undef GAPA
  #undef GAPB
  #undef EX
  #undef VRD
  #undef KRD
  #undef STEP
  #undef ENDW
  {auto rr=__builtin_amdgcn_permlane32_swap(__float_as_uint(l_reg),__float_as_uint(l_reg),false,false);l_reg=__uint_as_float(rr[0])+__uint_as_float(rr[1]);}
  if(hi==0)wsf[32+r32]=l_reg;asm volatile("s_waitcnt lgkmcnt(0)":::"memory");
  float rli[16];
  #pragma unroll
  for(int r=0;r<16;++r)rli[r]=__builtin_amdgcn_rcpf(wsf[32+crow(r,hi)]);
  bf16*Ow=O+(rowbase+q0+wid*QBLK)*DM+h*D;
  { bf16*stg=(bf16*)(shm+LDS_OST)+wid*2048;
    #pragma unroll
    for(int r=0;r<16;++r){const int orow=crow(r,hi);
      #pragma unroll
      for(int d0=0;d0<2;++d0)stg[orow*64+d0*32+r32]=__float2bfloat16(o[d0][r]*rli[r]);}
    asm volatile("s_waitcnt lgkmcnt(0)":::"memory");
    #pragma unroll
    for(int i=0;i<4;++i){const int row=i*8+(lane>>3),ch=lane&7; const u32x4 v=*(const u32x4*)(stg+row*64+ch*8); ATTN_STORE16(Ow+(long)row*DM+ch*8,v);} }
  asm volatile("s_waitcnt lgkmcnt(0)\n\ts_barrier":::"memory");
  #undef DMA_K
  #undef DMA_V
  #undef CMASK
  #undef CSUB
  #undef START
  #undef RESC
  #undef ROT
}
constexpr int ATTN_LDS_BYTES=LDS_BYTES;
struct AttnTensors { const bf16* Q; const bf16* K; const bf16* V; bf16* O; const float* CS; };
struct AttnUnit { int bh; int qb; };
struct StaticOrder {
  int vcu;
  __device__ __forceinline__ explicit StaticOrder(int grid,int block):vcu((block%8)*(grid/8)+block/8){}
  __device__ __forceinline__ bool next(int i,AttnUnit&u)const{ if(i>=4)return false; const int s=vcu&1; u.bh=vcu>>1; u.qb=(i==0)?s:(i==1)?7-s:(i==2)?3-s:4+s; return true; }
};
template<class Sched,int THRL=8> __device__ __forceinline__ void attn_phase(char*lds,const AttnTensors&T,const Sched&S){
  AttnUnit u;
  {
    const int tid=threadIdx.x, bh=S.vcu>>1, b=bh/NHEAD, h=bh%NHEAD;
    __attribute__((address_space(3))) float*csl=(__attribute__((address_space(3))) float*)(uintptr_t)(unsigned)(uintptr_t)(lds+LDS_CS);
    __attribute__((address_space(3))) float*sc=(__attribute__((address_space(3))) float*)(uintptr_t)(unsigned)(uintptr_t)(lds+LDS_WS);
    float v[4],run=0.f;
    #pragma unroll
    for(int i=0;i<4;++i){run+=T.CS[(long)(b*SEQ+4*tid+i)*NHEAD+h];v[i]=run;}
    sc[tid]=run;__syncthreads();
    for(int o=1;o<NW*64;o<<=1){const float a=(tid>=o)?sc[tid-o]:0.f;__syncthreads();sc[tid]+=a;__syncthreads();}
    const float excl=sc[tid]-run;
    #pragma unroll
    for(int i=0;i<4;++i)csl[4*tid+i]=(excl+v[i])*1.4426950408889634f;
    __syncthreads(); }
  for(int i=0;S.next(i,u);++i){ attn_unit<THRL>(u.bh/NHEAD,u.bh%NHEAD,u.qb,T.Q,T.K,T.V,T.O,lds); }
}

constexpr int SB_K=0, SB_V=2*SLOTB, SB_FLAG=4*SLOTB, SB_OST=SB_FLAG+256, SB_BYTES=SB_OST+NW*4096;
__device__ __forceinline__ void sb_unit(int b,int h,int qb,const bf16*Q,const bf16*__restrict__ K,const bf16*__restrict__ V,bf16*O,char*shm){
  const int tid=threadIdx.x,lane=tid&63,r32=lane&31,hi=lane>>5; const int wid=__builtin_amdgcn_readfirstlane(tid>>6);
  const long rowbase=(long)b*SEQ; const int q0=qb*QB;
  const bf16*Qw=Q+(rowbase+q0+wid*QBLK)*DM+h*D;
  const bf16*Kh=K+rowbase*DM+h*D,*Vh=V+rowbase*DM+h*D;
  const unsigned lds0=(unsigned)(uintptr_t)shm;
  const bf16*ksrc=Kh+(long)lane*DM+wid*8;
  const bf16*vsrc=Vh+(long)(16*(wid&3)+(lane>>2))*DM+(wid>>2)*32+(lane&3)*8;
  const unsigned kdst=lds0+SB_K+wid*1024, vdst=lds0+SB_V+wid*1024;
  #define DMA_K(t,slot) glds16(ksrc+(long)(t)*KVBLK*DM,(unsigned)__builtin_amdgcn_readfirstlane(kdst+(slot)))
  #define DMA_V(t,slot) glds16(vsrc+(long)(t)*KVBLK*DM,(unsigned)__builtin_amdgcn_readfirstlane(vdst+(slot)))
  const int vb0=(int)(lds0+SB_V)+((lane>>4)&1)*32+(lane&3)*8+(4*hi+((lane&15)>>2))*64;
  typedef __attribute__((address_space(3))) unsigned lds_u32;
  lds_u32* flag=(lds_u32*)(uintptr_t)(lds0+SB_FLAG);
  const int NT=(q0+QB)/KVBLK;
  DMA_K(NT-1,0);DMA_V(NT-1,0);
  bf16x8 qr[4];
  #pragma unroll
  for(int d0=0;d0<4;++d0)qr[d0]=*reinterpret_cast<const bf16x8*>(&Qw[(long)r32*DM+d0*16+hi*8]);
  f32x16 o[2];o[0]=f32x16{};o[1]=f32x16{};
  float rinv=1.0f; const int qrel=wid*QBLK+r32;
  for(int i=0;i<NT;++i){
    const int t=NT-1-i, slot=(i&1)*SLOTB;
    asm volatile("s_waitcnt vmcnt(0) lgkmcnt(0)\n\ts_barrier":::"memory");
    if(i>0){ const u32x4 f0=*(const __attribute__((address_space(3))) u32x4*)(flag+((i-1)&1)*8), f1=*(const __attribute__((address_space(3))) u32x4*)(flag+((i-1)&1)*8+4);
      if((f0.x&f0.y&f0.z&f0.w&f1.x&f1.y&f1.z&f1.w)!=0u)break; }
    if(i+1<NT){DMA_K(t-1,SLOTB-slot);DMA_V(t-1,SLOTB-slot);}
    f32x16 p0,p1; { f32x16 zc=f32x16{}; qkt(p0,p1,shm+SB_K+slot,qr,zc,r32,hi); }
    f32x16 c0,c1;
    #pragma unroll
    for(int r=0;r<16;++r){p0[r]=__builtin_amdgcn_exp2f(p0[r]);p1[r]=__builtin_amdgcn_exp2f(p1[r]);}
    { const int jb=t-(NT-4); if(jb>=0){ const int kb=64*jb+4*hi;
      #pragma unroll
      for(int r=0;r<16;++r){const int kv=kb+(r&3)+8*(r>>2); if(kv>=qrel)p0[r]=0.f; if(kv+32>=qrel)p1[r]=0.f;} } }
    #pragma unroll
    for(int r=0;r<16;++r){c0[r]=__builtin_amdgcn_rcpf(1.0f+p0[r]);c1[r]=__builtin_amdgcn_rcpf(1.0f+p1[r]);}
    #pragma unroll
    for(int g=0;g<4;++g){ c0[4*g+2]*=c0[4*g+3];c0[4*g+1]*=c0[4*g+2];c0[4*g]*=c0[4*g+1]; c1[4*g+2]*=c1[4*g+3];c1[4*g+1]*=c1[4*g+2];c1[4*g]*=c1[4*g+1]; }
    float tl[8],th[8],X[8];
    #pragma unroll
    for(int g=0;g<8;++g){ const float T=(g<4)?c0[4*g]:c1[4*(g-4)]; auto rr=__builtin_amdgcn_permlane32_swap(__float_as_uint(T),__float_as_uint(T),false,false); tl[g]=__uint_as_float(rr[0]); th[g]=__uint_as_float(rr[1]); }
    X[7]=1.0f;
    #pragma unroll
    for(int g=6;g>=0;--g)X[g]=X[g+1]*(tl[g+1]*th[g+1]);
    #pragma unroll
    for(int g=0;g<8;++g){ const float F=rinv*X[g]*(hi?1.0f:th[g]);
      #pragma unroll
      for(int j=0;j<4;++j){ if(g<4)p0[4*g+j]=p0[4*g+j]*c0[4*g+j]*F; else p1[4*(g-4)+j]=p1[4*(g-4)+j]*c1[4*(g-4)+j]*F; } }
    rinv=rinv*X[0]*(tl[0]*th[0]);
    { const bool dn=__all(rinv<8.6736174e-19f); if(lane==0)flag[(i&1)*8+wid]=dn?1u:0u; }
    u32x4 pw0,pw1,pw2,pw3;
    pw0=(u32x4){cvtpk_s(p0[0],p0[1]),cvtpk_s(p0[2],p0[3]),cvtpk_s(p0[4],p0[5]),cvtpk_s(p0[6],p0[7])};
    pw1=(u32x4){cvtpk_s(p0[8],p0[9]),cvtpk_s(p0[10],p0[11]),cvtpk_s(p0[12],p0[13]),cvtpk_s(p0[14],p0[15])};
    pw2=(u32x4){cvtpk_s(p1[0],p1[1]),cvtpk_s(p1[2],p1[3]),cvtpk_s(p1[4],p1[5]),cvtpk_s(p1[6],p1[7])};
    pw3=(u32x4){cvtpk_s(p1[8],p1[9]),cvtpk_s(p1[10],p1[11]),cvtpk_s(p1[12],p1[13]),cvtpk_s(p1[14],p1[15])};
    SBAR(); pv(o,vb0+slot,__builtin_bit_cast(bf16x8,pw0),__builtin_bit_cast(bf16x8,pw1),__builtin_bit_cast(bf16x8,pw2),__builtin_bit_cast(bf16x8,pw3));
  }
  bf16*Ow=O+(rowbase+q0+wid*QBLK)*DM+h*D;
  { bf16*stg=(bf16*)(shm+SB_OST)+wid*2048;
    #pragma unroll
    for(int r=0;r<16;++r){const int orow=crow(r,hi);
      #pragma unroll
      for(int d0=0;d0<2;++d0)stg[orow*64+d0*32+r32]=__float2bfloat16(o[d0][r]);}
    asm volatile("s_waitcnt lgkmcnt(0)":::"memory");
    #pragma unroll
    for(int i=0;i<4;++i){const int row=i*8+(lane>>3),ch=lane&7; const u32x4 v=*(const u32x4*)(stg+row*64+ch*8); *(u32x4*)(Ow+(long)row*DM+ch*8)=v;} }
  asm volatile("s_waitcnt vmcnt(0) lgkmcnt(0)\n\ts_barrier":::"memory");
  #undef DMA_K
  #undef DMA_V
}
template<class Sched> __device__ __forceinline__ void sb_phase(char*lds,const AttnTensors&T,const Sched&S){
  AttnUnit u;
  for(int i=0;S.next(i,u);++i){ sb_unit(u.bh/NHEAD,u.bh%NHEAD,u.qb,T.Q,T.K,T.V,T.O,lds); }
}
#undef SBAR
#undef WAIT_BAR
}
struct Args { const float* in[20]; float* out; unsigned char* ws; int ph_lo, ph_hi, li, pad; };

struct ConvDesc { const float* src; const float* gain; bf16_t* dst; int ldn, K; };
__device__ __forceinline__ void conv_load(const ConvDesc& d, f32x4 (&v)[16], f32x4 (&g)[2], int lane) {
#pragma unroll
    for (int i = 0; i < 16; ++i) v[i] = *(const GAS f32x4*)(d.src + (size_t)(4 * i + (lane >> 4)) * d.ldn + (lane & 15) * 4);
    if (d.gain) { g[0] = *(const GAS f32x4*)(d.gain + 8 * (lane & 7)); g[1] = *(const GAS f32x4*)(d.gain + 8 * (lane & 7) + 4); }
    else { g[0] = (f32x4){1.f, 1.f, 1.f, 1.f}; g[1] = g[0]; }
}
__device__ __forceinline__ void conv_store(const ConvDesc& d, const f32x4 (&v)[16], const f32x4 (&g)[2], LAS float* scr, int lane) {
#pragma unroll
    for (int i = 0; i < 16; ++i) { LAS float* s = scr + (4 * i + (lane >> 4)) * 65 + (lane & 15) * 4; s[0] = v[i][0]; s[1] = v[i][1]; s[2] = v[i][2]; s[3] = v[i][3]; }
    const int c = lane & 7;
    LDS_WAIT(); asm volatile("" ::: "memory");
#pragma unroll
    for (int j = 0; j < 8; ++j) { const int n = (lane >> 3) + 8 * j; const LAS float* s = scr + (8 * c) * 65 + n;
        u32x4 o; o.x = pk2(s[0 * 65] * g[0][0], s[1 * 65] * g[0][1]); o.y = pk2(s[2 * 65] * g[0][2], s[3 * 65] * g[0][3]); o.z = pk2(s[4 * 65] * g[1][0], s[5 * 65] * g[1][1]); o.w = pk2(s[6 * 65] * g[1][2], s[7 * 65] * g[1][3]);
        *(GAS u32x4*)(d.dst + (size_t)n * d.K + 8 * c) = o; }
    LDS_WAIT(); asm volatile("" ::: "memory");
}
__device__ __forceinline__ int gu_dest(int n0, int FH) { const int up = n0 >= FH ? 1 : 0, j = n0 - up * FH; return 256 * (j >> 7) + 128 * up + (j & 127); }

__device__ __forceinline__ void moe_prefix(const int* cntwg, int wg, volatile LAS int* L, int wave, int lane) {
    __syncthreads();
    { int tot = 0, pre = 0;
      for (int w = lane; w < 256; w += 64) { const int c = __hip_atomic_load(cntwg + w * 8 + wave, RLX_AGENT); tot += c; if (w < wg) pre += c; }
#pragma unroll
      for (int o = 1; o < 64; o <<= 1) { tot += __shfl_xor(tot, o); pre += __shfl_xor(pre, o); }
      if (lane == 0) { L[16 + wave] = tot; L[32 + wave] = pre; } }
    __syncthreads();
    if (threadIdx.x == 0) { int a = 0; L[0] = 0; for (int e = 0; e < NE; ++e) { a += (L[16 + e] + 255) >> 8; L[e + 1] = a; } }
    __syncthreads();
}

__device__ __forceinline__ const float* inp_ptr(int i) {
    typedef __attribute__((address_space(4))) const unsigned long long* kap_t;
    kap_t p = (kap_t)__builtin_amdgcn_kernarg_segment_ptr();
    asm volatile("" : "+s"(p));
    return (const float*)(const GAS float*)(uintptr_t)p[i];
}
constexpr int CI_IN = 16 * 48, CI_SQ = 16 * 16, CI_KV = 16 * 32, CI_GUD = 16 * 88, CI_DD = 44 * 16, CI_GUM1 = 16 * 112, CI_DM1 = 56 * 16, CI_PP1 = 4 * 16;
constexpr int CONV_NITEMS = CI_IN + CI_SQ + CI_KV + CI_SQ + CI_SQ + CI_GUD + CI_DD + NE * CI_GUM1 + NE * CI_DM1 + 2 * CI_PP1 + 2 * CI_SQ;
__device__ __forceinline__ ConvDesc conv_mk(const float* W, int ldn, int K, const float* gain, bf16_t* WT, int k0, int n0, int nd0) {
    ConvDesc d; d.src = W + (size_t)k0 * ldn + n0; d.gain = gain ? gain + k0 : nullptr; d.dst = WT + (size_t)nd0 * K + k0; d.ldn = ldn; d.K = K; return d;
}
__device__ __forceinline__ ConvDesc conv_decode(int it, unsigned char* ws) {
    int r = it;
    if (r < CI_IN) return conv_mk(inp_ptr(4), 3 * DM + NH, DM, inp_ptr(2), (bf16_t*)(ws + WS_W_IN), 64 * (r / 48), 64 * (r % 48), 64 * (r % 48)); r -= CI_IN;
    if (r < CI_SQ) return conv_mk(inp_ptr(6), DM, DM, nullptr, (bf16_t*)(ws + WS_W_OA), 64 * (r / 16), 64 * (r % 16), 64 * (r % 16)); r -= CI_SQ;
    if (r < CI_KV) return conv_mk(inp_ptr(8), 2 * DM, DM, inp_ptr(7), (bf16_t*)(ws + WS_W_KVQ), 64 * (r / 32), 64 * (r % 32), 64 * (r % 32)); r -= CI_KV;
    if (r < CI_SQ) return conv_mk(inp_ptr(9), DM, DM, inp_ptr(2) + DM, (bf16_t*)(ws + WS_W_KVQ), 64 * (r / 16), 64 * (r % 16), 2 * DM + 64 * (r % 16)); r -= CI_SQ;
    if (r < CI_SQ) return conv_mk(inp_ptr(10), DM, DM, nullptr, (bf16_t*)(ws + WS_W_OB), 64 * (r / 16), 64 * (r % 16), 64 * (r % 16)); r -= CI_SQ;
    if (r < CI_GUD) { const int n0 = 64 * (r % 88); return conv_mk(inp_ptr(11), 2 * FD, DM, inp_ptr(3), (bf16_t*)(ws + WS_W_GUD), 64 * (r / 88), n0, gu_dest(n0, FD)); } r -= CI_GUD;
    if (r < CI_DD) return conv_mk(inp_ptr(12), DM, FD, nullptr, (bf16_t*)(ws + WS_W_DD), 64 * (r / 16), 64 * (r % 16), 64 * (r % 16)); r -= CI_DD;
    if (r < NE * CI_GUM1) { const int e = r / CI_GUM1, q = r % CI_GUM1, n0 = 64 * (q % 112);
        return conv_mk(inp_ptr(15) + (size_t)e * DM * 2 * FE, 2 * FE, DM, inp_ptr(3) + DM, (bf16_t*)(ws + WS_W_GUM) + (size_t)e * 2 * FE * DM, 64 * (q / 112), n0, gu_dest(n0, FE)); } r -= NE * CI_GUM1;
    if (r < NE * CI_DM1) { const int e = r / CI_DM1, q = r % CI_DM1;
        return conv_mk(inp_ptr(16) + (size_t)e * FE * DM, DM, FE, nullptr, (bf16_t*)(ws + WS_W_DM) + (size_t)e * DM * FE, 64 * (q / 16), 64 * (q % 16), 64 * (q % 16)); } r -= NE * CI_DM1;
    if (r < 2 * CI_PP1) { const int e = r / CI_PP1, q = r % CI_PP1;
        return conv_mk(inp_ptr(17) + (size_t)e * DP * DM, DM, DP, nullptr, (bf16_t*)(ws + WS_W_PP) + (size_t)e * DM * DP, 64 * (q / 16), 64 * (q % 16), 64 * (q % 16)); } r -= 2 * CI_PP1;
    { const int e = r / CI_SQ, q = r % CI_SQ;
        return conv_mk(inp_ptr(18) + (size_t)e * DM * DM, DM, DM, nullptr, (bf16_t*)(ws + WS_W_PG) + (size_t)e * DM * DM, 64 * (q / 16), 64 * (q % 16), 64 * (q % 16)); }
}
__global__ void __launch_bounds__(NW * 64, 2) fwd_kernel(Args args) {
    extern __shared__ __attribute__((aligned(16))) unsigned char lds_raw[];
    LAS unsigned char* lds = (LAS unsigned char*)lds_raw;
    volatile LAS unsigned* MISC = (volatile LAS unsigned*)(lds + MISC_OFF);
    const int tid = threadIdx.x, lane = tid & 63, wave = __builtin_amdgcn_readfirstlane(tid >> 6);
    const int G = gridDim.x, bx = blockIdx.x;
    const int vcu = (G % 8 == 0) ? (bx % 8) * (G / 8) + bx / 8 : bx;
    const int gw = vcu * NW + wave, NGW = G * NW;
    unsigned char* ws = args.ws;
    gu32* ctl = (gu32*)(ws + WS_CTL);
    float* const hres = args.out;
#define INP(i) inp_ptr(i)
#define in_x INP(0)
#define p_in INP(1)
#define attn_norm INP(2)
#define ffn_norm INP(3)
#define w_in_a INP(4)
#define b_f INP(5)
#define w_o_a INP(6)
#define kv_norm INP(7)
#define w_kv INP(8)
#define w_q_b INP(9)
#define w_o_b INP(10)
#define w_gu_dense INP(11)
#define w_down_dense INP(12)
#define router_w INP(13)
#define router_b INP(14)
#define w_gu_moe INP(15)
#define w_down_moe INP(16)
#define w_ple_proj INP(17)
#define w_ple_gate INP(18)
#define final_norm INP(19)
#define rs0 ((float*)(ws + WS_RS0))
#define slab1 ((float*)(ws + WS_SLAB1))
#define slab3 ((float*)(ws + WS_SLAB3))
#define slab6 ((float*)(ws + WS_SLAB6))
#define logf_ ((float*)(ws + WS_LOGF))
#define cs ((float*)(ws + WS_CS))
#define cntwg ((int*)(ws + WS_CNTWG))
#define selE ((int*)(ws + WS_SELE))
#define selG ((float*)(ws + WS_SELG))
#define rr4 ((float*)(ws + WS_RR4))
#define tokpos ((int*)(ws + WS_TOKPOS))
#define grow ((float*)(ws + WS_GROW))
#define W_IN ((bf16_t*)(ws + WS_W_IN))
#define W_OA ((bf16_t*)(ws + WS_W_OA))
#define W_KVQ ((bf16_t*)(ws + WS_W_KVQ))
#define W_OB ((bf16_t*)(ws + WS_W_OB))
#define W_GUD ((bf16_t*)(ws + WS_W_GUD))
#define W_DD ((bf16_t*)(ws + WS_W_DD))
#define W_PP ((bf16_t*)(ws + WS_W_PP))
#define W_PG ((bf16_t*)(ws + WS_W_PG))
#define W_GUM ((bf16_t*)(ws + WS_W_GUM))
#define W_DM ((bf16_t*)(ws + WS_W_DM))
#define HBA ((bf16_t*)(ws + WS_HBA))
#define HBB ((bf16_t*)(ws + WS_HBB))
#define PB ((bf16_t*)(ws + WS_PB))
#define PP ((bf16_t*)(ws + WS_PP))
#define XG ((bf16_t*)(ws + WS_XGY))
#define YB ((bf16_t*)(ws + WS_XGY))
#define QB ((bf16_t*)(ws + WS_Q))
#define KB ((bf16_t*)(ws + WS_K))
#define VB ((bf16_t*)(ws + WS_V))
#define OB ((bf16_t*)(ws + WS_O))
#define ACTD ((bf16_t*)(ws + WS_ACTD))
#define ACTM ((bf16_t*)(ws + WS_ACTM))

    for (int u = tid; u < (LDS_BYTES - LDSCTL_OFF) / 4; u += NW * 64) ((LAS unsigned*)(lds + LDSCTL_OFF))[u] = 0u;
    __syncthreads();
    XcdBarrier bar; bar.bar = (unsigned*)(ctl + CW_BAR) + args.li * XCD_BAR_WORDS; bar.x = 0; bar.st = nullptr;
    if (N_LAUNCHES != NPH) bar = xcd_barrier_post((unsigned*)(ctl + CW_BAR) + args.li * XCD_BAR_WORDS, MISC + 8);
    const int lo = args.ph_lo, hi = args.ph_hi;
#ifndef PHASE_MASK
#define PHASE_MASK 0x1ffff
#endif
#define IN(k) ((((PHASE_MASK) >> (k)) & 1) && lo <= (k) && (k) < hi)
#define SEAM(k) do { if (IN(k) && IN((k) + 1)) xcd_barrier(bar); } while (0)

    if (IN(0)) {
        const int p0parts = args.pad;
        if (p0parts & 1) {
            LAS float* wfg = (LAS float*)lds;
            { const float* an_ = attn_norm; const float* wi_ = w_in_a;
              float tmp[32];
#pragma unroll
              for (int u = 0; u < 32; ++u) { const int i = tid + u * (NW * 64), k = i >> 4, h = i & 15; tmp[u] = an_[k] * wi_[(size_t)k * (3 * DM + NH) + 3 * DM + h]; }
#pragma unroll
              for (int u = 0; u < 32; ++u) { const int i = tid + u * (NW * 64), k = i >> 4, h = i & 15;
                wfg[((((((k >> 8) * 4 + (k & 3)) * 4 + (h >> 2)) * 64) + ((k & 255) >> 2)) << 2) + (h & 3)] = tmp[u]; } }
            const float* xin_ = in_x; const float* bf_ = b_f;
            __syncthreads();
            f32x4 vn[4];
            if (gw < MT) { const GAS f32x4* xr = (const GAS f32x4*)(xin_ + (size_t)gw * DM) + lane;
#pragma unroll
                for (int j = 0; j < 4; ++j) vn[j] = xr[64 * j]; }
            for (int m = gw; m < MT; m += NGW) {
                f32x4 v[4]; float s = 0.f;
#pragma unroll
                for (int j = 0; j < 4; ++j) v[j] = vn[j];
                if (m + NGW < MT) { const GAS f32x4* xr = (const GAS f32x4*)(xin_ + (size_t)(m + NGW) * DM) + lane;
#pragma unroll
                    for (int j = 0; j < 4; ++j) vn[j] = xr[64 * j]; }
#pragma unroll
                for (int j = 0; j < 4; ++j) s += (v[j][0] * v[j][0] + v[j][1] * v[j][1]) + (v[j][2] * v[j][2] + v[j][3] * v[j][3]);
                const float r = 1.0f / sqrtf(wave_sum(s) * (1.0f / DM) + RMS_EPS);
                GAS unsigned long long* o8 = (GAS unsigned long long*)(HBA + (size_t)m * DM) + lane;
#pragma unroll
                for (int j = 0; j < 4; ++j) o8[64 * j] = (unsigned long long)pk2(v[j][0], v[j][1]) | ((unsigned long long)pk2(v[j][2], v[j][3]) << 32);
                float fa[16];
#pragma unroll
                for (int h = 0; h < 16; ++h) fa[h] = 0.f;
#pragma unroll
                for (int j = 0; j < 4; ++j) {
#pragma unroll
                    for (int i = 0; i < 4; ++i) { const LAS f32x4* wp = (const LAS f32x4*)wfg + ((j * 4 + i) * 4) * 64 + lane; const float xv = v[j][i];
#pragma unroll
                        for (int q = 0; q < 4; ++q) { const f32x4 w4 = wp[q * 64]; fa[4 * q + 0] += xv * w4[0]; fa[4 * q + 1] += xv * w4[1]; fa[4 * q + 2] += xv * w4[2]; fa[4 * q + 3] += xv * w4[3]; } }
                    asm volatile("" ::: "memory"); }
#pragma unroll
                for (int h = 0; h < 16; ++h) fa[h] = wave_sum(fa[h]);
                if (lane == 0) rs0[m] = r;
                if (lane < 16) { float fv = 0.f;
#pragma unroll
                    for (int h = 0; h < 16; ++h) fv = (lane == h) ? fa[h] : fv;
                    const float z = fv * r + bf_[lane];
                    logf_[(size_t)m * NH + lane] = fminf(z, 0.f) - log1pf(expf(-fabsf(z))); }
            }
            __syncthreads();
        }
        const float* pin_ = p_in;
        if (p0parts & 1) {
            const size_t nth = (size_t)NGW * 64, i0 = (size_t)gw * 64 + lane, tot = (size_t)2 * MT * DP / 4;
            for (size_t ib = i0; ib < tot; ib += 8 * nth) { f32x4 v[8];
#pragma unroll
                for (int u = 0; u < 8; ++u) if (ib + u * nth < tot) v[u] = ((const GAS f32x4*)pin_)[ib + u * nth];
#pragma unroll
                for (int u = 0; u < 8; ++u) if (ib + u * nth < tot) { u32x2 w; w.x = pk2(v[u][0], v[u][1]); w.y = pk2(v[u][2], v[u][3]); ((GAS u32x2*)PB)[ib + u * nth] = w; } }
        }
        LAS float* scr = (LAS float*)(lds + wave * 16640);
        if (p0parts & 2) {
            ConvDesc dA, dB; f32x4 vA[16], vB[16], gA[2], gB[2];
            int it = gw;
            if (it < CONV_NITEMS) { dA = conv_decode(it, ws); conv_load(dA, vA, gA, lane); }
            while (it < CONV_NITEMS) {
                const bool hb = it + NGW < CONV_NITEMS;
                if (hb) { dB = conv_decode(it + NGW, ws); conv_load(dB, vB, gB, lane); }
                conv_store(dA, vA, gA, scr, lane);
                if (!hb) break;
                const bool ha = it + 2 * NGW < CONV_NITEMS;
                if (ha) { dA = conv_decode(it + 2 * NGW, ws); conv_load(dA, vA, gA, lane); }
                conv_store(dB, vB, gB, scr, lane);
                it += 2 * NGW;
                if (!ha) break;
            }
        }
    }
    SEAM(0);

    if (IN(1)) {
        pg8::Gemm g{HBA, W_IN, DM}; pg8::StaticOrder S; S.init(MT, 3 * DM, G, bx);
        pg8::EpiQKV E{QB, (size_t)(WS_K - WS_Q) / 2, 0, pg8::RowScale{rs0, 0}};
        pg8::gemm_phase(lds, g, S, E);
    }
    SEAM(1);

    if (IN(2)) {
#if !defined(NAIVE_FOX)
        static_assert(fox_body::LDS_BYTES <= RING_BYTES, "attention scratch vs LDS ring");
        const fox_body::AttnTensors AT{(const fox_body::bf16*)QB, (const fox_body::bf16*)KB, (const fox_body::bf16*)VB, (fox_body::bf16*)OB, logf_};
        const fox_body::StaticOrder S(G, bx);
        fox_body::attn_phase<fox_body::StaticOrder>((char*)lds_raw, AT, S);
        __syncthreads();
    }
#else
        const int zero = opaque_zero();
        for (int j = 0; j < 2; ++j) {
            const int it = gw + j * NGW; if (it >= NB * NH * 32) break;
            const int bh = it & 127, qq = it >> 7, qb = (j == 0) ? qq : 31 - (qq - 16);
            const int b = bh >> 4, h = bh & 15, t = qb * 64 + lane; const size_t row = (size_t)b * SEQ + t;
            float q[64], o[64];
            { const u32x4* qp = (const u32x4*)(QB + row * DM + h * HD);
#pragma unroll
              for (int c = 0; c < 8; ++c) { const u32x4 w = qp[c]; q[8 * c + 0] = bflo(w.x); q[8 * c + 1] = bfhi(w.x); q[8 * c + 2] = bflo(w.y); q[8 * c + 3] = bfhi(w.y); q[8 * c + 4] = bflo(w.z); q[8 * c + 5] = bfhi(w.z); q[8 * c + 6] = bflo(w.w); q[8 * c + 7] = bfhi(w.w); } }
#pragma unroll
            for (int d = 0; d < 64; ++d) o[d] = 0.f;
            const float* csb = cs + (size_t)bh * SEQ; const float ct = csb[t];
            float mx = -1e30f, l = 0.f;
            const int smax = qb * 64 + 63;
            for (int s = 0; s <= smax; ++s) {
                const size_t kro = ((size_t)b * SEQ + s) * DM + h * HD + zero;
                const u32x4* kp = (const u32x4*)(KB + kro); float dot = 0.f;
#pragma unroll
                for (int c = 0; c < 8; ++c) { const u32x4 w = kp[c]; dot += q[8 * c + 0] * bflo(w.x) + q[8 * c + 1] * bfhi(w.x) + q[8 * c + 2] * bflo(w.y) + q[8 * c + 3] * bfhi(w.y) + q[8 * c + 4] * bflo(w.z) + q[8 * c + 5] * bfhi(w.z) + q[8 * c + 6] * bflo(w.w) + q[8 * c + 7] * bfhi(w.w); }
                const float scv = dot + ct - csb[s + zero];
                if (s <= t) {
                    const float mn = fmaxf(mx, scv), a = __builtin_amdgcn_exp2f(mx - mn), pw = __builtin_amdgcn_exp2f(scv - mn);
                    l = l * a + pw; mx = mn;
                    const u32x4* vp = (const u32x4*)(VB + kro);
#pragma unroll
                    for (int c = 0; c < 8; ++c) { const u32x4 w = vp[c];
                        o[8 * c + 0] = o[8 * c + 0] * a + pw * bflo(w.x); o[8 * c + 1] = o[8 * c + 1] * a + pw * bfhi(w.x); o[8 * c + 2] = o[8 * c + 2] * a + pw * bflo(w.y); o[8 * c + 3] = o[8 * c + 3] * a + pw * bfhi(w.y);
                        o[8 * c + 4] = o[8 * c + 4] * a + pw * bflo(w.z); o[8 * c + 5] = o[8 * c + 5] * a + pw * bfhi(w.z); o[8 * c + 6] = o[8 * c + 6] * a + pw * bflo(w.w); o[8 * c + 7] = o[8 * c + 7] * a + pw * bfhi(w.w); }
                }
            }
            const float il = 1.0f / l; u32x4* op = (u32x4*)(OB + row * DM + h * HD);
#pragma unroll
            for (int c = 0; c < 8; ++c) { u32x4 w; w.x = pk2(o[8 * c + 0] * il, o[8 * c + 1] * il); w.y = pk2(o[8 * c + 2] * il, o[8 * c + 3] * il); w.z = pk2(o[8 * c + 4] * il, o[8 * c + 5] * il); w.w = pk2(o[8 * c + 6] * il, o[8 * c + 7] * il); op[c] = w; }
        }
    }
#endif
    SEAM(2);

    if (IN(3)) {
        pg8::Gemm g{OB, W_OA, DM}; pg8::StaticOrder S; S.init(MT, DM, G, bx);
        pg8::EpiResid E{in_x, hres, HBA, slab1};
        pg8::gemm_phase(lds, g, S, E);
    }
    SEAM(3);

    if (IN(4)) {
        { pg8::Gemm g{HBA, W_GUD, DM}; pg8::StaticOrder S; S.init(MT, 2 * FD, G, bx);
          pg8::EpiSwiGLU E{ACTD, FD, pg8::RowScale{slab1, 1}};
          pg8::gemm_phase(lds, g, S, E); }
        {
          pg8::MoeOrder S; S.mtp[0] = 0; S.mtp[1] = MT / 256;
#pragma unroll
          for (int e = 2; e <= NE; ++e) S.mtp[e] = 2 * MT / 256;
          S.nN = DM / 256; S.brows = DM; S.G = G / 2; S.c = bx >= G / 2 ? bx - G / 2 : (1 << 28);
          pg8::Gemm g{PB, W_PP, DP}; pg8::EpiBf16 E{PP, DM};
          pg8::gemm_phase(lds, g, S, E); }
    }
    SEAM(4);

    if (IN(5)) {
        pg8::Gemm g{ACTD, W_DD, FD}; pg8::StaticOrder S; S.init(MT, DM, G, bx);
        pg8::EpiResid E{hres, hres, HBA, nullptr};
        pg8::gemm_phase(lds, g, S, E);
    }
    SEAM(5);

    if (IN(6)) {
        pg8::Gemm g{HBA, W_PG, DM}; pg8::StaticOrder S; S.init(MT, DM, G, bx);
        pg8::EpiPLE E{hres, PP, HBB, slab3};
        pg8::gemm_phase(lds, g, S, E);
    }
    SEAM(6);

    if (IN(7)) {
        pg8::Gemm g{HBB, W_KVQ, DM}; pg8::StaticOrder S; S.init(MT, 3 * DM, G, bx);
        pg8::EpiQKV E{QB, (size_t)(WS_K - WS_Q) / 2, 1, pg8::RowScale{slab3, 1}};
        pg8::gemm_phase(lds, g, S, E);
    }
    SEAM(7);

    if (IN(8)) {
#if !defined(NAIVE_SB)
        static_assert(fox_body::SB_BYTES <= RING_BYTES, "attention scratch vs LDS ring");
        const fox_body::AttnTensors AT{(const fox_body::bf16*)QB, (const fox_body::bf16*)KB, (const fox_body::bf16*)VB, (fox_body::bf16*)OB, nullptr};
        const fox_body::StaticOrder S(G, bx);
        fox_body::sb_phase<fox_body::StaticOrder>((char*)lds_raw, AT, S);
        __syncthreads();
    }
#else
        const int zero = opaque_zero();
        for (int j = 0; j < 2; ++j) {
            const int it = gw + j * NGW; if (it >= NB * NH * 32) break;
            const int bh = it & 127, qq = it >> 7, qb = (j == 0) ? qq : 31 - (qq - 16);
            const int b = bh >> 4, h = bh & 15, t = qb * 64 + lane; const size_t row = (size_t)b * SEQ + t;
            float q[64], o[64];
            { const u32x4* qp = (const u32x4*)(QB + row * DM + h * HD);
#pragma unroll
              for (int c = 0; c < 8; ++c) { const u32x4 w = qp[c]; q[8 * c + 0] = bflo(w.x); q[8 * c + 1] = bfhi(w.x); q[8 * c + 2] = bflo(w.y); q[8 * c + 3] = bfhi(w.y); q[8 * c + 4] = bflo(w.z); q[8 * c + 5] = bfhi(w.z); q[8 * c + 6] = bflo(w.w); q[8 * c + 7] = bfhi(w.w); } }
#pragma unroll
            for (int d = 0; d < 64; ++d) o[d] = 0.f;
            float rem = 1.0f;
            for (int s = qb * 64 + 62; s >= 0; --s) {
                const size_t kro = ((size_t)b * SEQ + s) * DM + h * HD + zero;
                const u32x4* kp = (const u32x4*)(KB + kro); float dot = 0.f;
#pragma unroll
                for (int c = 0; c < 8; ++c) { const u32x4 w = kp[c]; dot += q[8 * c + 0] * bflo(w.x) + q[8 * c + 1] * bfhi(w.x) + q[8 * c + 2] * bflo(w.y) + q[8 * c + 3] * bfhi(w.y) + q[8 * c + 4] * bflo(w.z) + q[8 * c + 5] * bfhi(w.z) + q[8 * c + 6] * bflo(w.w) + q[8 * c + 7] * bfhi(w.w); }
                if (s < t) {
                    const float uu = __builtin_amdgcn_exp2f(dot), inv = 1.0f / (1.0f + uu), a = uu * inv * rem; rem *= inv;
                    const u32x4* vp = (const u32x4*)(VB + kro);
#pragma unroll
                    for (int c = 0; c < 8; ++c) { const u32x4 w = vp[c];
                        o[8 * c + 0] += a * bflo(w.x); o[8 * c + 1] += a * bfhi(w.x); o[8 * c + 2] += a * bflo(w.y); o[8 * c + 3] += a * bfhi(w.y);
                        o[8 * c + 4] += a * bflo(w.z); o[8 * c + 5] += a * bfhi(w.z); o[8 * c + 6] += a * bflo(w.w); o[8 * c + 7] += a * bfhi(w.w); }
                }
            }
            u32x4* op = (u32x4*)(OB + row * DM + h * HD);
#pragma unroll
            for (int c = 0; c < 8; ++c) { u32x4 w; w.x = pk2(o[8 * c + 0], o[8 * c + 1]); w.y = pk2(o[8 * c + 2], o[8 * c + 3]); w.z = pk2(o[8 * c + 4], o[8 * c + 5]); w.w = pk2(o[8 * c + 6], o[8 * c + 7]); op[c] = w; }
        }
    }
#endif
    SEAM(8);

    if (IN(9)) {
        pg8::Gemm g{OB, W_OB, DM}; pg8::StaticOrder S; S.init(MT, DM, G, bx);
        pg8::EpiResid E{hres, hres, nullptr, nullptr};
        pg8::gemm_phase(lds, g, S, E);
    }
    SEAM(9);

    if (IN(10)) {
        LAS float* wrg = (LAS float*)lds;
        LAS int* lsel = (LAS int*)(lds + 32768);
        { const float* fn_ = ffn_norm; const float* rw_ = router_w;
          float tmp[16];
#pragma unroll
          for (int u = 0; u < 16; ++u) { const int i = tid + u * (NW * 64); tmp[u] = fn_[DM + (i >> 3)] * rw_[i]; }
#pragma unroll
          for (int u = 0; u < 16; ++u) { const int i = tid + u * (NW * 64), k = i >> 3, e = i & 7;
              wrg[((((((k >> 8) * 4 + (k & 3)) * 2 + (e >> 2)) * 64) + ((k & 255) >> 2)) << 2) + (e & 3)] = tmp[u]; } }
        const float* rb_ = router_b;
        __syncthreads();
        f32x4 vn[4];
        { const GAS f32x4* hr = (const GAS f32x4*)(hres + (size_t)(vcu * 64 + wave * 8) * DM) + lane;
#pragma unroll
          for (int q = 0; q < 4; ++q) vn[q] = hr[64 * q]; }
        for (int j = 0; j < 8; ++j) {
            const int rl = wave * 8 + j, row = vcu * 64 + rl;
            f32x4 v[4]; float s = 0.f;
#pragma unroll
            for (int q = 0; q < 4; ++q) v[q] = vn[q];
            if (j < 7) { const GAS f32x4* hr = (const GAS f32x4*)(hres + (size_t)(row + 1) * DM) + lane;
#pragma unroll
                for (int q = 0; q < 4; ++q) vn[q] = hr[64 * q]; }
#pragma unroll
            for (int q = 0; q < 4; ++q) s += (v[q][0] * v[q][0] + v[q][1] * v[q][1]) + (v[q][2] * v[q][2] + v[q][3] * v[q][3]);
            const float r = 1.0f / sqrtf(wave_sum(s) * (1.0f / DM) + RMS_EPS);
            float la[8];
#pragma unroll
            for (int e = 0; e < 8; ++e) la[e] = 0.f;
#pragma unroll
            for (int q = 0; q < 4; ++q)
#pragma unroll
                for (int i = 0; i < 4; ++i) { const LAS f32x4* wp = (const LAS f32x4*)wrg + ((q * 4 + i) * 2) * 64 + lane; const float xv = v[q][i]; const f32x4 w0 = wp[0], w1 = wp[64];
                    la[0] += xv * w0[0]; la[1] += xv * w0[1]; la[2] += xv * w0[2]; la[3] += xv * w0[3]; la[4] += xv * w1[0]; la[5] += xv * w1[1]; la[6] += xv * w1[2]; la[7] += xv * w1[3]; }
#pragma unroll
            for (int e = 0; e < 8; ++e) la[e] = wave_sum(la[e]) * r + rb_[e];
            int e1 = 0; float v1 = la[0];
#pragma unroll
            for (int e = 1; e < 8; ++e) if (la[e] > v1) { v1 = la[e]; e1 = e; }
            int e2 = -1; float v2 = -3.0e38f;
#pragma unroll
            for (int e = 0; e < 8; ++e) if (e != e1 && la[e] > v2) { v2 = la[e]; e2 = e; }
            if (lane == 0) { const float g1 = 1.0f / (1.0f + expf(v2 - v1)); lsel[rl] = e1 | (e2 << 8); selE[row] = e1 | (e2 << 8); selG[row] = g1; rr4[row] = r; }
        }
        __syncthreads();
        if (tid < NE) { int c = 0; for (int i = 0; i < 64; ++i) { const int se = lsel[i]; c += ((se & 255) == tid) + ((se >> 8) == tid); } __hip_atomic_store(cntwg + vcu * 8 + tid, c, RLX_AGENT); }
        __syncthreads();
    }
    SEAM(10);

    if (IN(11)) {
        volatile LAS int* L = (volatile LAS int*)(lds + 65536);
        LAS int* lsel = (LAS int*)(lds + 32768); LAS int* lpos = (LAS int*)(lds + 33024);
        moe_prefix(cntwg, vcu, L, wave, lane);
        if (tid < 64) lsel[tid] = selE[vcu * 64 + tid];
        __syncthreads();
        if (tid < 128) { const int i = tid >> 1, k = tid & 1; const int se = lsel[i]; const int e = k ? (se >> 8) : (se & 255); int rank = 0;
            for (int i2 = 0; i2 <= i; ++i2) { const int s2 = lsel[i2]; if ((s2 & 255) == e && (i2 < i || k == 1)) ++rank; if ((s2 >> 8) == e && i2 < i) ++rank; }
            const int pos = 256 * L[e] + L[32 + e] + rank; lpos[tid] = pos; tokpos[(vcu * 64 + i) * 2 + k] = pos;
            const float g1 = selG[vcu * 64 + i]; grow[pos] = k ? 1.0f - g1 : g1; }
        __syncthreads();
#pragma unroll 1
        for (int jb = 0; jb < 8; jb += 4) {
            f32x4 v[4][4]; float rq[4];
#pragma unroll
            for (int j = 0; j < 4; ++j) { const int row = vcu * 64 + wave * 8 + jb + j; rq[j] = rr4[row]; const GAS f32x4* hr = (const GAS f32x4*)(hres + (size_t)row * DM) + lane;
#pragma unroll
                for (int q = 0; q < 4; ++q) v[j][q] = hr[64 * q]; }
#pragma unroll
            for (int j = 0; j < 4; ++j) { const int rl = wave * 8 + jb + j;
                GAS unsigned long long* d0 = (GAS unsigned long long*)(XG + (size_t)lpos[rl * 2] * DM) + lane; GAS unsigned long long* d1 = (GAS unsigned long long*)(XG + (size_t)lpos[rl * 2 + 1] * DM) + lane;
#pragma unroll
                for (int q = 0; q < 4; ++q) { const f32x4 x4 = v[j][q] * rq[j]; const unsigned long long w = (unsigned long long)pk2(x4[0], x4[1]) | ((unsigned long long)pk2(x4[2], x4[3]) << 32); d0[64 * q] = w; d1[64 * q] = w; } }
        }
        __syncthreads();
    }
    SEAM(11);

    if (IN(12)) {
        volatile LAS int* L = (volatile LAS int*)(lds + 65536);
        moe_prefix(cntwg, vcu, L, wave, lane);
        pg8::MoeOrder S; for (int e = 0; e <= NE; ++e) S.mtp[e] = L[e]; S.nN = 2 * FE / 256; S.brows = 2 * FE; S.G = G; S.c = bx;
        __syncthreads();
        pg8::Gemm g{XG, W_GUM, DM};
        pg8::EpiSwiGLU E{ACTM, FE, pg8::RowScale{nullptr, 2}};
        pg8::gemm_phase(lds, g, S, E);
    }
    SEAM(12);

    if (IN(13)) {
        volatile LAS int* L = (volatile LAS int*)(lds + 65536);
        moe_prefix(cntwg, vcu, L, wave, lane);
        pg8::MoeOrder S; for (int e = 0; e <= NE; ++e) S.mtp[e] = L[e]; S.nN = DM / 256; S.brows = DM; S.G = G; S.c = bx;
        __syncthreads();
        pg8::Gemm g{ACTM, W_DM, FE};
        pg8::EpiMoeDown E{YB, grow};
        pg8::gemm_phase(lds, g, S, E);
    }
    SEAM(13);

    if (IN(14)) {
        {
            const int* tp_ = tokpos;
            int pc0 = 0, pc1 = 0, pn0 = 0, pn1 = 0;
            if (gw < MT) { pc0 = tp_[2 * gw]; pc1 = tp_[2 * gw + 1]; }
            if (gw + NGW < MT) { pn0 = tp_[2 * (gw + NGW)]; pn1 = tp_[2 * (gw + NGW) + 1]; }
            f32x4 hv[4]; u32x2 ya[4], yb[4];
            if (gw < MT) { const GAS f32x4* hr = (const GAS f32x4*)(hres + (size_t)gw * DM) + lane; const GAS u32x2* y0 = (const GAS u32x2*)(YB + (size_t)pc0 * DM) + lane; const GAS u32x2* y1 = (const GAS u32x2*)(YB + (size_t)pc1 * DM) + lane;
#pragma unroll
                for (int q = 0; q < 4; ++q) { hv[q] = hr[64 * q]; ya[q] = y0[64 * q]; yb[q] = y1[64 * q]; } }
            for (int m = gw; m < MT; m += NGW) {
                f32x4 v[4]; u32x2 a[4], b[4];
#pragma unroll
                for (int q = 0; q < 4; ++q) { v[q] = hv[q]; a[q] = ya[q]; b[q] = yb[q]; }
                const int mn = m + NGW, mnn = m + 2 * NGW;
                if (mn < MT) { const GAS f32x4* hr = (const GAS f32x4*)(hres + (size_t)mn * DM) + lane; const GAS u32x2* y0 = (const GAS u32x2*)(YB + (size_t)pn0 * DM) + lane; const GAS u32x2* y1 = (const GAS u32x2*)(YB + (size_t)pn1 * DM) + lane;
#pragma unroll
                    for (int q = 0; q < 4; ++q) { hv[q] = hr[64 * q]; ya[q] = y0[64 * q]; yb[q] = y1[64 * q]; } }
                if (mnn < MT) { pn0 = tp_[2 * mnn]; pn1 = tp_[2 * mnn + 1]; }
                GAS f32x4* ho = (GAS f32x4*)(hres + (size_t)m * DM) + lane; GAS u32x2* hb = (GAS u32x2*)(HBA + (size_t)m * DM) + lane;
#pragma unroll
                for (int q = 0; q < 4; ++q) { f32x4 x4 = v[q];
                    x4[0] += bflo(a[q].x) + bflo(b[q].x); x4[1] += bfhi(a[q].x) + bfhi(b[q].x); x4[2] += bflo(a[q].y) + bflo(b[q].y); x4[3] += bfhi(a[q].y) + bfhi(b[q].y);
                    ho[64 * q] = x4; u32x2 w; w.x = pk2(x4[0], x4[1]); w.y = pk2(x4[2], x4[3]); hb[64 * q] = w; }
            }
        }
    }
    SEAM(14);

    if (IN(15)) {
        pg8::Gemm g{HBA, W_PG + (size_t)DM * DM, DM}; pg8::StaticOrder S; S.init(MT, DM, G, bx);
        pg8::EpiPLE E{hres, PP + (size_t)MT * DM, nullptr, slab6};
        pg8::gemm_phase(lds, g, S, E);
    }
    SEAM(15);

    if (IN(16)) {
        f32x4 gn[4];
        { const float* fnm_ = final_norm;
#pragma unroll
        for (int q = 0; q < 4; ++q) gn[q] = ((const GAS f32x4*)fnm_)[lane + 64 * q]; }
        {
            f32x4 vn[4], sqn;
            if (gw < MT) { const GAS f32x4* hr = (const GAS f32x4*)(hres + (size_t)gw * DM) + lane; sqn = *(const GAS f32x4*)(slab6 + 4 * (size_t)gw);
#pragma unroll
                for (int q = 0; q < 4; ++q) vn[q] = hr[64 * q]; }
            for (int m = gw; m < MT; m += NGW) {
                f32x4 v[4]; const f32x4 sq = sqn;
#pragma unroll
                for (int q = 0; q < 4; ++q) v[q] = vn[q];
                if (m + NGW < MT) { const GAS f32x4* hr = (const GAS f32x4*)(hres + (size_t)(m + NGW) * DM) + lane; sqn = *(const GAS f32x4*)(slab6 + 4 * (size_t)(m + NGW));
#pragma unroll
                    for (int q = 0; q < 4; ++q) vn[q] = hr[64 * q]; }
                const float r = __builtin_amdgcn_rsqf(((sq[0] + sq[1]) + (sq[2] + sq[3])) * (1.0f / DM) + RMS_EPS);
                GAS f32x4* ho = (GAS f32x4*)(hres + (size_t)m * DM) + lane;
#pragma unroll
                for (int q = 0; q < 4; ++q) ho[64 * q] = v[q] * r * gn[q];
            }
        }
    }
#undef IN
#undef SEAM
}

extern "C" void kernel_launch(void* const* d_in, const int* in_sizes, int n_in, void* d_out, int out_size, void* d_ws, size_t ws_size, hipStream_t stream) {
    static int grid = 0;
    if (grid == 0) {
        if (n_in != 20 || in_sizes[0] != MT * DM || out_size != MT * DM || ws_size < WS_END) { fprintf(stderr, "kernel_launch: unexpected shapes (n_in %d, in0 %d, out %d, ws %zu < %zu)\n", n_in, n_in > 0 ? in_sizes[0] : -1, out_size, ws_size, (size_t)WS_END); grid = -1; return; }
        int dev = 0, cus = 0, per_cu = 0;
        if (hipGetDevice(&dev) != hipSuccess || hipDeviceGetAttribute(&cus, hipDeviceAttributeMultiprocessorCount, dev) != hipSuccess) { grid = -1; return; }
        if (hipFuncSetAttribute((const void*)fwd_kernel, hipFuncAttributeMaxDynamicSharedMemorySize, LDS_BYTES) != hipSuccess) { fprintf(stderr, "kernel_launch: hipFuncSetAttribute failed\n"); grid = -1; return; }
        if (hipOccupancyMaxActiveBlocksPerMultiprocessor(&per_cu, (const void*)fwd_kernel, NW * 64, LDS_BYTES) != hipSuccess || per_cu < 1) { fprintf(stderr, "kernel_launch: occupancy query says %d blocks per CU\n", per_cu); per_cu = 1; }
        (void)hipGetLastError();
        grid = cus;
        if (grid != 256) fprintf(stderr, "kernel_launch: %d CUs; this kernel is written for 256\n", grid);
    }
    if (grid < 0) return;
    if (hipMemsetAsync((char*)d_ws + WS_CTL, 0, CTL_ZERO_BYTES, stream) != hipSuccess) return;
    Args a{};
    for (int i = 0; i < 20; ++i) a.in[i] = (const float*)d_in[i];
    a.out = (float*)d_out; a.ws = (unsigned char*)d_ws; a.pad = 3;
#if defined(PROBE_REP_LO)
    a.ph_lo = 0; a.ph_hi = PROBE_REP_HI + 1; a.li = 0; hipLaunchKernelGGL(fwd_kernel, dim3(grid), dim3(NW * 64), LDS_BYTES, stream, a);
#if defined(PROBE_P0PARTS)
    a.pad = PROBE_P0PARTS;
#endif
    a.ph_lo = PROBE_REP_LO; a.ph_hi = NPH; a.li = 1; hipLaunchKernelGGL(fwd_kernel, dim3(grid), dim3(NW * 64), LDS_BYTES, stream, a);
#else
    for (int li = 0; li < N_LAUNCHES; ++li) {
        a.ph_lo = (N_LAUNCHES == NPH) ? li : 0; a.ph_hi = (N_LAUNCHES == NPH) ? li + 1 : NPH; a.li = (N_LAUNCHES == NPH) ? 0 : li;
        hipLaunchKernelGGL(fwd_kernel, dim3(grid), dim3(NW * 64), LDS_BYTES, stream, a);
    }
#endif
}
```

```cpp
#include <hip/hip_runtime.h>
#include <hip/hip_bf16.h>
#include <cstdio>
#include <cstdint>

#define LAS __attribute__((address_space(3)))
#define GAS __attribute__((address_space(1)))
typedef unsigned short bf16_t;
typedef short bf16x8 __attribute__((ext_vector_type(8)));
typedef float f32x4 __attribute__((ext_vector_type(4)));
typedef float f32x2 __attribute__((ext_vector_type(2)));
typedef unsigned u32x4 __attribute__((ext_vector_type(4)));
typedef unsigned u32x2 __attribute__((ext_vector_type(2)));

#ifndef MK_N_LAUNCHES
#define MK_N_LAUNCHES 1
#endif
constexpr int NPH = 17;
constexpr int N_LAUNCHES = MK_N_LAUNCHES;

constexpr int NB = 8, SEQ = 2048, DM = 1024, NH = 16, HD = 64, MT = NB * SEQ, FD = 2816, FE = 3584, NE = 8, DP = 256;
constexpr int NW = 8;
constexpr float RMS_EPS = 1e-6f, LOG2E = 1.4426950408889634f, C2 = 0.125f * 1.4426950408889634f;
constexpr int MOE_ROWS = 2 * MT + NE * 256;

constexpr size_t MiB = 1u << 20, KiB = 1u << 10;
constexpr size_t WS_CTL = 0, CTL_ZERO_BYTES = 1 * MiB;
constexpr size_t WS_SMALL = 1 * MiB;
constexpr size_t WS_RS0 = WS_SMALL, WS_SLAB1 = WS_SMALL + 64 * KiB, WS_SLAB3 = WS_SMALL + 320 * KiB, WS_SLAB6 = WS_SMALL + 576 * KiB;
constexpr size_t WS_LOGF = WS_SMALL + 1024 * KiB, WS_CS = WS_SMALL + 2048 * KiB, WS_CNTWG = WS_SMALL + 3072 * KiB;
constexpr size_t WS_SELE = WS_SMALL + 3136 * KiB, WS_SELG = WS_SMALL + 3200 * KiB, WS_RR4 = WS_SMALL + 3264 * KiB, WS_TOKPOS = WS_SMALL + 3328 * KiB, WS_GROW = WS_SMALL + 3456 * KiB;
constexpr size_t WS_W_IN = 8 * MiB, WS_W_OA = 14 * MiB, WS_W_KVQ = 16 * MiB, WS_W_OB = 22 * MiB, WS_W_GUD = 24 * MiB, WS_W_DD = 35 * MiB, WS_W_PP = 41 * MiB, WS_W_PG = 42 * MiB;
constexpr size_t WS_W_GUM = 46 * MiB, WS_W_DM = 158 * MiB;
constexpr size_t WS_HBA = 214 * MiB, WS_HBB = 246 * MiB, WS_PB = 278 * MiB, WS_PP = 294 * MiB, WS_XGY = 358 * MiB;
constexpr size_t WS_ARENA = 426 * MiB, WS_Q = 426 * MiB, WS_K = 458 * MiB, WS_V = 490 * MiB, WS_O = 522 * MiB, WS_ACTD = 554 * MiB, WS_ACTM = WS_ARENA;
constexpr size_t WS_END = 664 * MiB;
static_assert(WS_ACTM + (size_t)MOE_ROWS * FE * 2 <= WS_END && WS_ACTD + (size_t)MT * FD * 2 <= WS_END && WS_XGY + (size_t)MOE_ROWS * DM * 2 <= WS_ARENA, "ws map");
static_assert(WS_W_GUM + (size_t)NE * 2 * FE * DM * 2 <= WS_W_DM && WS_W_DM + (size_t)NE * DM * FE * 2 <= WS_HBA && WS_GROW + (size_t)MOE_ROWS * 4 <= WS_W_IN, "ws map 2");
constexpr int CW_BAR = 4096;
static_assert(WS_V - WS_K == WS_K - WS_Q, "Q|K|V equally spaced");

constexpr int RING_BYTES = 133120;
constexpr int LDSCTL_OFF = RING_BYTES, MISC_OFF = LDSCTL_OFF + 320;
constexpr int LDS_BYTES = 147456;
static_assert(MISC_OFF + 1024 <= LDS_BYTES, "lds map");

typedef GAS unsigned gu32;
#define RLX_AGENT __ATOMIC_RELAXED, __HIP_MEMORY_SCOPE_AGENT
#define LDS_WAIT() asm volatile("s_waitcnt lgkmcnt(0)" ::: "memory")
#define VM_WAIT() asm volatile("s_waitcnt vmcnt(0)" ::: "memory")
__device__ __forceinline__ unsigned f2bf(float f) { unsigned u = __builtin_bit_cast(unsigned, f); return (u + 0x7fffu + ((u >> 16) & 1u)) >> 16; }
typedef __bf16 bf16x2_t __attribute__((ext_vector_type(2)));
__device__ __forceinline__ unsigned pk2(float lo, float hi) { const f32x2 v = {lo, hi}; return __builtin_bit_cast(unsigned, __builtin_convertvector(v, bf16x2_t)); }
__device__ __forceinline__ float bflo(unsigned w) { return __builtin_bit_cast(float, w << 16); }
__device__ __forceinline__ float bfhi(unsigned w) { return __builtin_bit_cast(float, w & 0xffff0000u); }
__device__ __forceinline__ float wave_sum(float v) {
#pragma unroll
    for (int o = 1; o < 64; o <<= 1) v += __shfl_xor(v, o);
    return v;
}
__device__ __forceinline__ int opaque_zero() { int z; asm volatile("v_mov_b32 %0, 0" : "=v"(z)); return z; }

#define XB_TMO      128
#define XB_XCNT(j)  (256  + 64 * (j))
#define XB_XSUB(j)  (1280 + 64 * (j))
#define XB_XGEN(j)  (2304 + 64 * (j))
#define XB_TOP      3328
#define XB_TOPGEN   3392
#define XCD_BAR_WORDS 3456
#define XB_SPIN_CAP (1u << 20)
__device__ __forceinline__ unsigned xb_ld(unsigned* p)              { return __hip_atomic_load(p, __ATOMIC_RELAXED, __HIP_MEMORY_SCOPE_AGENT); }
__device__ __forceinline__ unsigned xb_add(unsigned* p, unsigned v) { return __hip_atomic_fetch_add(p, v, __ATOMIC_RELAXED, __HIP_MEMORY_SCOPE_AGENT); }
__device__ __forceinline__ unsigned xb_xcc_id() { return (unsigned)__builtin_amdgcn_s_getreg((3 << 11) | 20) & 0xFu; }
#define XB_SPIN(cond, bar) do { unsigned _sp = 0; while (cond) { __builtin_amdgcn_s_sleep(1); \
    if ((++_sp & 255u) == 0u) { if (xb_ld(&(bar)[XB_TMO])) break; if (_sp > XB_SPIN_CAP) { atomicAdd(&(bar)[XB_TMO], 1u); break; } } } } while (0)
struct XcdBarrier { unsigned* bar; unsigned x; volatile LAS unsigned* st; };
__device__ __forceinline__ XcdBarrier xcd_barrier_post(unsigned* bar, volatile LAS unsigned* st) {
    XcdBarrier b; b.bar = bar; b.x = xb_xcc_id(); b.st = st;
    if (threadIdx.x == 0) (void)xb_add(&bar[XB_XCNT(b.x)], 1u);
    return b;
}
__device__ __forceinline__ void xcd_barrier_complete(unsigned* bar, unsigned x, unsigned& nloc, unsigned& nx) {
    const unsigned G = gridDim.x * gridDim.y * gridDim.z;
    unsigned sum, cnt, mine, sp = 0u;
    for (;;) {
        sum = 0u; cnt = 0u; mine = 0u;
#pragma unroll
        for (unsigned j = 0; j < 16; ++j) { const unsigned c = xb_ld(&bar[XB_XCNT(j)]); sum += c; cnt += (c > 0u) ? 1u : 0u; mine = (j == x) ? c : mine; }
        if (sum == G) break;
        __builtin_amdgcn_s_sleep(1);
        if ((++sp & 255u) == 0u) { if (xb_ld(&bar[XB_TMO])) break; if (sp > XB_SPIN_CAP) { atomicAdd(&bar[XB_TMO], 1u); break; } }
    }
    nloc = mine > 0u ? mine : 1u; nx = cnt > 0u ? cnt : 1u;
}
__device__ __forceinline__ void xcd_barrier(const XcdBarrier& b) {
    asm volatile("s_waitcnt vmcnt(0)" ::: "memory");
    __syncthreads();
    if (threadIdx.x == 0) {
        unsigned* bar = b.bar;
        __builtin_amdgcn_s_waitcnt(0);
        unsigned nloc = b.st[0], nx = b.st[1];
        if (nloc == 0u) { xcd_barrier_complete(bar, b.x, nloc, nx); b.st[0] = nloc; b.st[1] = nx; }
        const unsigned old = xb_add(&bar[XB_XSUB(b.x)], 1u);
        const unsigned gen = old / nloc;
        if (old + 1u == (gen + 1u) * nloc) {
            __builtin_amdgcn_fence(__ATOMIC_RELEASE, "agent");
            asm volatile("s_waitcnt vmcnt(0)" ::: "memory");
            const unsigned og = xb_add(&bar[XB_TOP], 1u);
            const unsigned tg = og / nx;
            if (og + 1u == (tg + 1u) * nx) xb_add(&bar[XB_TOPGEN], 1u);
            else XB_SPIN(xb_ld(&bar[XB_TOPGEN]) == tg, bar);
            __builtin_amdgcn_fence(__ATOMIC_ACQUIRE, "agent");
            xb_add(&bar[XB_XGEN(b.x)], 1u);
            asm volatile("s_waitcnt vmcnt(0)" ::: "memory");
        } else {
            XB_SPIN(xb_ld(&bar[XB_XGEN(b.x)]) == gen, bar);
            __builtin_amdgcn_fence(__ATOMIC_ACQUIRE, "agent");
            asm volatile("s_waitcnt vmcnt(0)" ::: "memory");
        }
    }
    __syncthreads();
}

namespace pg8 {
constexpr int BM = 256, BK = 64, HALF = 128, NXCD = 8, WGM = 8;
__host__ __device__ __forceinline__ int perm32(int rho) { const int n = rho >> 4, i = rho & 15; return 8 * (i >> 2) + 4 * n + (i & 3); }
struct Unit { int arow, brow, orow, ocol; };
struct Gemm { const bf16_t* A; const bf16_t* Bt; int K; };

__device__ __forceinline__ bool order_map(long L, int nM, int nN, int& pm, int& pn) {
    const int nwg = nM * nN; if (L >= nwg) return false;
    int wgid = (int)L; { const int q = nwg / NXCD, r = nwg % NXCD, xcd = wgid % NXCD, off = wgid / NXCD; wgid = (xcd < r ? xcd * (q + 1) : r * (q + 1) + (xcd - r) * q) + off; }
    const int nig = WGM * nN, gid = wgid / nig, fm = gid * WGM, gsz = (nM - fm) < WGM ? (nM - fm) : WGM;
    pm = fm + ((wgid % nig) % gsz); pn = (wgid % nig) / gsz; return true;
}
struct StaticOrder {
    int nM, nN, G, c;
    __device__ void init(int M, int N, int G_, int c_) { nM = M / BM; nN = N / BM; G = G_; c = c_; }
    __device__ __forceinline__ bool next(int i, Unit& u) const {
        int pm, pn; if (!order_map((long)i * G + c, nM, nN, pm, pn)) return false;
        u.arow = pm * BM; u.brow = pn * BM; u.orow = pm * BM; u.ocol = pn; return true;
    }
};
struct MoeOrder {
    int mtp[NE + 1]; int nN, brows, G, c;
    __device__ __forceinline__ bool next(int i, Unit& u) const {
        int pm, pn; if (!order_map((long)i * G + c, mtp[NE], nN, pm, pn)) return false;
        int e = 0;
#pragma unroll
        for (int j = 1; j < NE; ++j) e += (pm >= mtp[j]) ? 1 : 0;
        u.arow = pm * BM; u.orow = pm * BM; u.brow = e * brows + pn * BM; u.ocol = pn; return true;
    }
};

struct RowScale {
    const float* p; int mode;
    __device__ __forceinline__ float get(int row) const {
        if (mode == 0) return p[row];
        if (mode == 1) { const f32x4 q = *(const f32x4*)(p + 4 * (size_t)row); return __builtin_amdgcn_rsqf(((q[0] + q[1]) + (q[2] + q[3])) * (1.0f / DM) + RMS_EPS); }
        return 1.0f;
    }
};
struct EpiQKV {
    static constexpr bool PERM = true, AFTER_DRAIN = false;
    bf16_t* base; size_t stride; int rot; RowScale R;
    __device__ __forceinline__ void operator()(const f32x4 (&acc)[2][4][2], int ai, const Unit& u, int wr, int wc, int fr, int fq) const {
        int d = (u.ocol >> 2) + rot; d = d >= 3 ? d - 3 : d; bf16_t* ob = base + (size_t)d * stride; const float sc = d == 0 ? C2 : 1.0f;
        const int col0 = (u.ocol & 3) * BM + wc * 32 + 8 * fq;
#pragma unroll
            for (int m = 0; m < 4; ++m) { const int row = u.orow + ai * HALF + wr * 64 + m * 16 + fr; const float rr = R.get(row) * sc; bf16_t* rowp = ob + (size_t)row * DM + col0;
#pragma unroll
                for (int bj = 0; bj < 2; ++bj) { const f32x4 v0 = acc[bj][m][0] * rr, v1 = acc[bj][m][1] * rr;
                    u32x4 w; w.x = pk2(v0[0], v0[1]); w.y = pk2(v0[2], v0[3]); w.z = pk2(v1[0], v1[1]); w.w = pk2(v1[2], v1[3]);
                    *(u32x4*)(rowp + bj * HALF) = w; } }
    }
};
struct EpiBf16 {
    static constexpr bool PERM = true, AFTER_DRAIN = false;
    bf16_t* O; int ldo;
    __device__ __forceinline__ void operator()(const f32x4 (&acc)[2][4][2], int ai, const Unit& u, int wr, int wc, int fr, int fq) const {
        const int col0 = u.ocol * BM + wc * 32 + 8 * fq;
#pragma unroll
            for (int m = 0; m < 4; ++m) { const int row = u.orow + ai * HALF + wr * 64 + m * 16 + fr; bf16_t* rowp = O + (size_t)row * ldo + col0;
#pragma unroll
                for (int bj = 0; bj < 2; ++bj) { const f32x4 v0 = acc[bj][m][0], v1 = acc[bj][m][1];
                    u32x4 w; w.x = pk2(v0[0], v0[1]); w.y = pk2(v0[2], v0[3]); w.z = pk2(v1[0], v1[1]); w.w = pk2(v1[2], v1[3]);
                    *(u32x4*)(rowp + bj * HALF) = w; } }
    }
};
struct EpiSwiGLU {
    static constexpr bool PERM = true, AFTER_DRAIN = false;
    bf16_t* O; int ldo; RowScale R;
    __device__ __forceinline__ void operator()(const f32x4 (&acc)[2][4][2], int ai, const Unit& u, int wr, int wc, int fr, int fq) const {
        const int col0 = u.ocol * HALF + wc * 32 + 8 * fq;
#pragma unroll
            for (int m = 0; m < 4; ++m) { const int row = u.orow + ai * HALF + wr * 64 + m * 16 + fr; const float rr = R.get(row); float o[8];
#pragma unroll
                for (int n = 0; n < 2; ++n)
#pragma unroll
                    for (int j = 0; j < 4; ++j) { const float g = acc[0][m][n][j] * rr, uu = acc[1][m][n][j] * rr;
                        o[n * 4 + j] = g * __builtin_amdgcn_rcpf(1.0f + __builtin_amdgcn_exp2f(-g * LOG2E)) * uu; }
                u32x4 w; w.x = pk2(o[0], o[1]); w.y = pk2(o[2], o[3]); w.z = pk2(o[4], o[5]); w.w = pk2(o[6], o[7]);
                *(u32x4*)(O + (size_t)row * ldo + col0) = w; asm volatile("" ::: "memory"); }
    }
};
struct EpiMoeDown {
    static constexpr bool PERM = true, AFTER_DRAIN = false;
    bf16_t* O; const float* gate;
    __device__ __forceinline__ void operator()(const f32x4 (&acc)[2][4][2], int ai, const Unit& u, int wr, int wc, int fr, int fq) const {
        const int col0 = u.ocol * BM + wc * 32 + 8 * fq;
#pragma unroll
            for (int m = 0; m < 4; ++m) { const int row = u.orow + ai * HALF + wr * 64 + m * 16 + fr; const float gt = gate[row]; bf16_t* rowp = O + (size_t)row * DM + col0;
#pragma unroll
                for (int bj = 0; bj < 2; ++bj) { const f32x4 v0 = acc[bj][m][0] * gt, v1 = acc[bj][m][1] * gt;
                    u32x4 w; w.x = pk2(v0[0], v0[1]); w.y = pk2(v0[2], v0[3]); w.z = pk2(v1[0], v1[1]); w.w = pk2(v1[2], v1[3]);
                    *(u32x4*)(rowp + bj * HALF) = w; } }
    }
};
__device__ __forceinline__ void row_sumsq_to_slab(const f32x4 (&v)[2][4][2], int ai, const Unit& u, int wr, int wc, int fr, int fq, LAS unsigned char* lds, float* slab) {
    LAS float* P = (LAS float*)lds;
#pragma unroll
    for (int m = 0; m < 4; ++m) { float s = 0.f;
#pragma unroll
        for (int bj = 0; bj < 2; ++bj)
#pragma unroll
            for (int n = 0; n < 2; ++n) { const f32x4 x = v[bj][m][n]; s += (x[0] * x[0] + x[1] * x[1]) + (x[2] * x[2] + x[3] * x[3]); }
        s += __shfl_xor(s, 16); s += __shfl_xor(s, 32);
        if (fq == 0) P[(wr * 64 + m * 16 + fr) * 4 + wc] = s; }
    __syncthreads();
    const int t = threadIdx.x;
    if (t < HALF) slab[(size_t)(u.orow + ai * HALF + t) * 4 + u.ocol] = (P[t * 4 + 0] + P[t * 4 + 1]) + (P[t * 4 + 2] + P[t * 4 + 3]);
    __syncthreads();
}
__device__ __forceinline__ void unpack8(const u32x4 w, f32x4& lo, f32x4& hi) { lo = (f32x4){bflo(w.x), bfhi(w.x), bflo(w.y), bfhi(w.y)}; hi = (f32x4){bflo(w.z), bfhi(w.z), bflo(w.w), bfhi(w.w)}; }
__device__ __forceinline__ u32x4 pack8(const f32x4 lo, const f32x4 hi) { u32x4 w; w.x = pk2(lo[0], lo[1]); w.y = pk2(lo[2], lo[3]); w.z = pk2(hi[0], hi[1]); w.w = pk2(hi[2], hi[3]); return w; }
struct EpiResid {
    static constexpr bool PERM = true, AFTER_DRAIN = true;
    bf16_t* hb; float* slab;
    __device__ __forceinline__ void fused(f32x4 (&acc)[2][4][2], int ai, const Unit& u, int wr, int wc, int fr, int fq, LAS unsigned char* lds) const {
        const int col0 = u.ocol * BM + wc * 32 + 8 * fq;
#pragma unroll
        for (int m = 0; m < 4; ++m) { bf16_t* rowp = hb + (size_t)(u.orow + ai * HALF + wr * 64 + m * 16 + fr) * DM + col0;
#pragma unroll
            for (int bj = 0; bj < 2; ++bj) { f32x4 lo, hi; unpack8(*(const u32x4*)(rowp + bj * HALF), lo, hi); lo += acc[bj][m][0]; hi += acc[bj][m][1];
                acc[bj][m][0] = lo; acc[bj][m][1] = hi; *(u32x4*)(rowp + bj * HALF) = pack8(lo, hi); }
            if (m & 1) asm volatile("" ::: "memory"); }
        if (slab) row_sumsq_to_slab(acc, ai, u, wr, wc, fr, fq, lds, slab);
    }
};
struct EpiPLE {
    static constexpr bool PERM = true, AFTER_DRAIN = true;
    const bf16_t* hin; const bf16_t* pp; bf16_t* hout; float* out32; float* slab;
    __device__ __forceinline__ void fused(f32x4 (&acc)[2][4][2], int ai, const Unit& u, int wr, int wc, int fr, int fq, LAS unsigned char* lds) const {
        const int col0 = u.ocol * BM + wc * 32 + 8 * fq;
#pragma unroll
        for (int m = 0; m < 4; ++m) { const size_t off = (size_t)(u.orow + ai * HALF + wr * 64 + m * 16 + fr) * DM + col0;
#pragma unroll
            for (int bj = 0; bj < 2; ++bj) { const size_t o2 = off + bj * HALF; f32x4 hl, hh, pl, ph; unpack8(*(const u32x4*)(hin + o2), hl, hh); unpack8(*(const u32x4*)(pp + o2), pl, ph);
                const f32x4 a0 = acc[bj][m][0], a1 = acc[bj][m][1];
#pragma unroll
                for (int j = 0; j < 4; ++j) { hl[j] += pl[j] * __builtin_amdgcn_rcpf(1.0f + __builtin_amdgcn_exp2f(-a0[j] * LOG2E)); hh[j] += ph[j] * __builtin_amdgcn_rcpf(1.0f + __builtin_amdgcn_exp2f(-a1[j] * LOG2E)); }
                acc[bj][m][0] = hl; acc[bj][m][1] = hh;
                if (out32) { *(f32x4*)(out32 + o2) = hl; *(f32x4*)(out32 + o2 + 4) = hh; } else *(u32x4*)(hout + o2) = pack8(hl, hh); }
            if (m & 1) asm volatile("" ::: "memory"); }
        if (slab) row_sumsq_to_slab(acc, ai, u, wr, wc, fr, fq, lds, slab);
    }
};

template <class Epi, class Sched>
__device__ __forceinline__ void gemm_simple(LAS unsigned char* lds, const Gemm g, const Sched& S, const Epi& E) {
    const int tid = threadIdx.x, wid = __builtin_amdgcn_readfirstlane(tid >> 6), lane = tid & 63, wr = wid >> 2, wc = wid & 3, fr = lane & 15, fq = lane >> 4;
    const int K = g.K, nt = K / BK;
    Unit u;
    for (int i = 0; S.next(i, u); ++i) {
        const int br0 = Epi::PERM ? perm32(fr) : fr, br1 = Epi::PERM ? perm32(16 + fr) : 16 + fr;
        const bf16_t* Bb = g.Bt + (size_t)(u.brow + wc * 32) * K + fq * 8;
#pragma unroll 1
        for (int ai = 0; ai < 2; ++ai) {
            f32x4 acc[2][4][2];
#pragma unroll
            for (int b = 0; b < 2; ++b)
#pragma unroll
                for (int m = 0; m < 4; ++m)
#pragma unroll
                    for (int n = 0; n < 2; ++n) acc[b][m][n] = (f32x4){0.f, 0.f, 0.f, 0.f};
            const bf16_t* Ab = g.A + (size_t)(u.arow + ai * HALF + wr * 64 + fr) * K + fq * 8;
#pragma unroll 1
            for (int t = 0; t < nt; ++t) {
                bf16x8 Af[4][2];
#pragma unroll
                for (int m = 0; m < 4; ++m)
#pragma unroll
                    for (int k = 0; k < 2; ++k) Af[m][k] = *(const bf16x8*)(Ab + (size_t)(m * 16) * K + t * BK + k * 32);
#pragma unroll
                for (int bj = 0; bj < 2; ++bj) {
                    bf16x8 Bf[2][2];
#pragma unroll
                    for (int k = 0; k < 2; ++k) { Bf[0][k] = *(const bf16x8*)(Bb + (size_t)(bj * HALF + br0) * K + t * BK + k * 32); Bf[1][k] = *(const bf16x8*)(Bb + (size_t)(bj * HALF + br1) * K + t * BK + k * 32); }
#pragma unroll
                    for (int m = 0; m < 4; ++m)
#pragma unroll
                        for (int n = 0; n < 2; ++n)
#pragma unroll
                            for (int k = 0; k < 2; ++k) acc[bj][m][n] = __builtin_amdgcn_mfma_f32_16x16x32_bf16(Bf[n][k], Af[m][k], acc[bj][m][n], 0, 0, 0);
                }
            }
            if constexpr (Epi::AFTER_DRAIN) { __syncthreads(); E.fused(acc, ai, u, wr, wc, fr, fq, lds); }
            else E(acc, ai, u, wr, wc, fr, fq);
        }
    }
}

constexpr int HTB = HALF * BK * 2  , STAGE_BYTES = 8 * HTB;
__host__ __device__ __forceinline__ int lds_byte(int r, int c) { const int st = (r >> 4) * 2 + (c >> 5), rr = r & 15, cc = c & 31, ob = rr * 64 + cc * 2; return st * 1024 + (ob ^ (((ob >> 9) & 1) << 5)); }
__host__ __device__ __forceinline__ void stage_rc(int b, int& R, int& C) { const int st = b / 1024, sb = b % 1024, swz = sb ^ (((sb >> 9) & 1) << 5); R = (st >> 1) * 16 + swz / 64; C = (st & 1) * 32 + (swz % 64) / 2; }
template <class Epi, class Sched, bool ALIGN_EPI>
__device__ __forceinline__ void gemm_fast(LAS unsigned char* lds, const Gemm g, const Sched& S, const Epi& E) {
    const int tid = threadIdx.x, wid = __builtin_amdgcn_readfirstlane(tid >> 6), lane = tid & 63, wr = wid >> 2, wc = wid & 3, fr = lane & 15, fq = lane >> 4;
    int K_ = g.K; asm volatile("" : "+s"(K_));
    const int K = K_, nt = K / BK;
    unsigned voffA[2], voffB[2];
#pragma unroll
    for (int i = 0; i < 2; ++i) { int R, C; stage_rc(tid * 16 + i * 8192, R, C); const int Rb = Epi::PERM ? ((R & ~31) + perm32(R & 31)) : R;
        voffA[i] = (unsigned)(R * K + C) * 2u; voffB[i] = (unsigned)(Rb * K + C) * 2u; }
    const size_t kstep = (size_t)(BK * 2);
    const size_t hstep = (size_t)HALF * K * 2;
    const size_t rstep = (size_t)K * 2;
    const unsigned ldsw = (unsigned)wid * 1024u;
    const int aoff = lds_byte(wr * 64 + fr, fq * 8), boff = lds_byte(wc * 32 + fr, fq * 8);
#define PG8_SA(b, h) (((b) * 2 + (h)) * HTB)
#define PG8_SB(b, h) ((4 + (b) * 2 + (h)) * HTB)
#define PG8_STAGE(bufoff, gbase, voff) do { _Pragma("unroll") for (int _i = 0; _i < 2; ++_i) \
        __builtin_amdgcn_global_load_lds((const unsigned*)((const char*)(gbase) + (voff)[_i]), (LAS unsigned*)(lds + (bufoff) + ldsw + _i * 8192), 16, 0, 0); } while (0)
#define PG8_LDA(dst, b, h) do { _Pragma("unroll") for (int m = 0; m < 4; ++m) _Pragma("unroll") for (int k = 0; k < 2; ++k) dst[m][k] = *(const LAS bf16x8*)(lds + PG8_SA(b, h) + aoff + m * 2048 + k * 1024); } while (0)
#define PG8_LDB(dst, b, h) do { _Pragma("unroll") for (int n = 0; n < 2; ++n) _Pragma("unroll") for (int k = 0; k < 2; ++k) dst[n][k] = *(const LAS bf16x8*)(lds + PG8_SB(b, h) + boff + n * 2048 + k * 1024); } while (0)
#define PG8_MMA(ai, bj, At, Bt) do { __builtin_amdgcn_s_setprio(1); _Pragma("unroll") for (int m = 0; m < 4; ++m) _Pragma("unroll") for (int n = 0; n < 2; ++n) _Pragma("unroll") for (int k = 0; k < 2; ++k) \
        acc[ai][bj][m][n] = __builtin_amdgcn_mfma_f32_16x16x32_bf16(Bt[n][k], At[m][k], acc[ai][bj][m][n], 0, 0, 0); __builtin_amdgcn_s_setprio(0); } while (0)
#define PG8_WAIT_V(n) asm volatile("s_waitcnt vmcnt(" #n ")" ::: "memory")
#define PG8_WAIT_L(n) asm volatile("s_waitcnt lgkmcnt(" #n ")" ::: "memory")
#define PG8_BAR __builtin_amdgcn_s_barrier()
#define PG8_SCHED __builtin_amdgcn_sched_barrier(0)
    Unit cur, nxt; int ui = 0;
    if (!S.next(0, cur)) return;
    f32x4 acc[2][2][4][2];
#pragma unroll
    for (int a = 0; a < 2; ++a)
#pragma unroll
        for (int b = 0; b < 2; ++b)
#pragma unroll
            for (int m = 0; m < 4; ++m)
#pragma unroll
                for (int n = 0; n < 2; ++n) acc[a][b][m][n] = (f32x4){0.f, 0.f, 0.f, 0.f};
    bf16x8 At[4][2], B0[2][2], B1[2][2];
    const char* cA = (const char*)g.A + (size_t)cur.arow * rstep; const char* cB = (const char*)g.Bt + (size_t)cur.brow * rstep;
    PG8_STAGE(PG8_SB(0, 0), cB, voffB); PG8_STAGE(PG8_SB(0, 1), cB + hstep, voffB); PG8_STAGE(PG8_SA(0, 0), cA, voffA); PG8_STAGE(PG8_SA(0, 1), cA + hstep, voffA);
    if (wr == 1) PG8_BAR;
    PG8_WAIT_V(2); PG8_BAR;
    PG8_STAGE(PG8_SB(1, 0), cB + kstep, voffB); PG8_STAGE(PG8_SA(1, 0), cA + kstep, voffA); PG8_STAGE(PG8_SB(1, 1), cB + hstep + kstep, voffB);
    PG8_WAIT_V(6); PG8_BAR;
    for (;;) {
        const bool has_next = S.next(ui + 1, nxt);
        const char* nA = has_next ? (const char*)g.A + (size_t)nxt.arow * rstep : cA; const char* nB = has_next ? (const char*)g.Bt + (size_t)nxt.brow * rstep : cB;
        for (int t = 0; t < nt; t += 2) {
            const bool last = (t == nt - 2);
            const char* a1 = cA + (size_t)(t + 1) * kstep;
            const char* a2 = last ? nA : cA + (size_t)(t + 2) * kstep; const char* b2 = last ? nB : cB + (size_t)(t + 2) * kstep;
            const char* a3 = a2 + kstep; const char* b3 = b2 + kstep;
            PG8_LDB(B0, 0, 0); PG8_LDB(B1, 0, 1); PG8_SCHED; PG8_LDA(At, 0, 0); PG8_STAGE(PG8_SA(1, 1), a1 + hstep, voffA);
            PG8_WAIT_V(8); PG8_WAIT_L(0); PG8_BAR; PG8_MMA(0, 0, At, B0); PG8_MMA(0, 1, At, B1); PG8_BAR; PG8_SCHED;
            PG8_LDA(At, 0, 1); PG8_STAGE(PG8_SB(0, 0), b2, voffB); PG8_STAGE(PG8_SB(0, 1), b2 + hstep, voffB); PG8_STAGE(PG8_SA(0, 0), a2, voffA);
            PG8_WAIT_V(8); PG8_WAIT_L(0); PG8_BAR; PG8_MMA(1, 0, At, B0); PG8_MMA(1, 1, At, B1); PG8_BAR; PG8_SCHED;
            PG8_LDB(B0, 1, 0); PG8_LDB(B1, 1, 1); PG8_SCHED; PG8_LDA(At, 1, 0); PG8_STAGE(PG8_SA(0, 1), a2 + hstep, voffA);
            PG8_WAIT_V(8); PG8_WAIT_L(0); PG8_BAR; PG8_MMA(0, 0, At, B0); PG8_MMA(0, 1, At, B1); PG8_BAR; PG8_SCHED;
            PG8_LDA(At, 1, 1); PG8_STAGE(PG8_SB(1, 0), b3, voffB); PG8_STAGE(PG8_SB(1, 1), b3 + hstep, voffB); PG8_STAGE(PG8_SA(1, 0), a3, voffA);
            PG8_WAIT_V(8); PG8_WAIT_L(0); PG8_BAR; PG8_MMA(1, 0, At, B0); PG8_MMA(1, 1, At, B1); PG8_BAR; PG8_SCHED;
        }
        if constexpr (ALIGN_EPI) { if (wr == 0) PG8_BAR; }
        if constexpr (!Epi::AFTER_DRAIN) { E(acc[0], 0, cur, wr, wc, fr, fq); E(acc[1], 1, cur, wr, wc, fr, fq); }
        if (!has_next) break;
#pragma unroll
        for (int a = 0; a < 2; ++a)
#pragma unroll
            for (int b = 0; b < 2; ++b)
#pragma unroll
                for (int m = 0; m < 4; ++m)
#pragma unroll
                    for (int n = 0; n < 2; ++n) acc[a][b][m][n] = (f32x4){0.f, 0.f, 0.f, 0.f};
        cur = nxt; cA = nA; cB = nB; ++ui;
        if constexpr (ALIGN_EPI) { if (wr == 1) PG8_BAR; }
    }
    PG8_WAIT_V(0);
    if constexpr (!ALIGN_EPI) { if (wr == 0) PG8_BAR; }
    PG8_BAR;
    if constexpr (Epi::AFTER_DRAIN) { E.fused(acc[0], 0, cur, wr, wc, fr, fq, lds); E.fused(acc[1], 1, cur, wr, wc, fr, fq, lds); }
#undef PG8_SA
#undef PG8_SB
#undef PG8_STAGE
#undef PG8_LDA
#undef PG8_LDB
#undef PG8_MMA
#undef PG8_WAIT_V
#undef PG8_WAIT_L
#undef PG8_BAR
#undef PG8_SCHED
}
template <class Epi, class Sched>
__device__ __forceinline__ void gemm_phase(LAS unsigned char* lds, const Gemm g, const Sched& S, const Epi& E) {
#if defined(SIMPLE_GEMM)
    gemm_simple(lds, g, S, E);
#else
    gemm_fast<Epi, Sched, !Epi::AFTER_DRAIN>(lds, g, S, E);
    __syncthreads();
#endif
}
}

namespace fox_body {
using bf16=__hip_bfloat16;
using bf16x8=__attribute__((ext_vector_type(8)))short;
using s16x4=__attribute__((ext_vector_type(4)))short;
using f32x16=__attribute__((ext_vector_type(16)))float;
using u32x4=__attribute__((ext_vector_type(4)))unsigned;
using f32x4v=__attribute__((ext_vector_type(4)))float;
constexpr int BATCH=8,NHEAD=16,SEQ=2048,D=64,DM=NHEAD*D;
constexpr int NW=8,QBLK=32,QB=QBLK*NW,KVBLK=64,NQB=SEQ/QB;
constexpr int ATTN_PITCH=DM, ATTN_UNIT_ROWS=QB;
__device__ __forceinline__ int crow(int r,int hi){return (r&3)+8*(r>>2)+4*hi;}
#define SBAR() __builtin_amdgcn_sched_barrier(0)
__device__ __forceinline__ void cmask(f32x16&p0,f32x16&p1,int jb,int qrel,int hi){
  const float NEG=-INFINITY; int kb=64*jb+4*hi;
  #pragma unroll
  for(int r=0;r<16;++r){int kv=kb+(r&3)+8*(r>>2); if(kv>qrel)p0[r]=NEG; if(kv+32>qrel)p1[r]=NEG;}
}

constexpr int NSLOT=3, SLOTB=8192;
constexpr int LDS_K=0, LDS_V=NSLOT*SLOTB, LDS_WS=2*NSLOT*SLOTB, LDS_OST=LDS_WS+NW*64*4, LDS_CS=LDS_OST+NW*4096, LDS_BYTES=LDS_CS+SEQ*4;
constexpr float C2=0.125f*1.4426950408889634f;
__device__ __forceinline__ void glds16(const void*gsrc,unsigned lds_dst){unsigned keep;
  asm volatile("s_mov_b32 %0, m0\n\ts_mov_b32 m0, %2\n\ts_nop 0\n\tglobal_load_lds_dwordx4 %1, off\n\ts_mov_b32 m0, %0":"=&s"(keep):"v"(gsrc),"s"(lds_dst):"memory");}
__device__ __forceinline__ float max3f(float a,float b,float c){float r;asm("v_max3_f32 %0, %1, %2, %3":"=v"(r):"v"(a),"v"(b),"v"(c));return r;}
__device__ __forceinline__ float max2f(float a,float b){float r;asm("v_max_f32_e32 %0, %1, %2":"=v"(r):"v"(a),"v"(b));return r;}
__device__ __forceinline__ float fadd_s(float a,float b){float r;asm("v_add_f32_e32 %0, %1, %2":"=v"(r):"v"(a),"v"(b));return r;}
__device__ __forceinline__ float fsub_s(float a,float b){float r;asm("v_sub_f32_e32 %0, %1, %2":"=v"(r):"v"(a),"v"(b));return r;}
typedef float f32x2_t __attribute__((ext_vector_type(2))); typedef __bf16 bf16x2_t __attribute__((ext_vector_type(2)));
__device__ __forceinline__ unsigned cvtpk_s(float lo,float hi){f32x2_t v={lo,hi};bf16x2_t b=__builtin_convertvector(v,bf16x2_t);return __builtin_bit_cast(unsigned,b);}
#define WAIT_BAR(N) asm volatile("s_waitcnt vmcnt(" #N ") lgkmcnt(0)\n\ts_barrier":::"memory")

__device__ __forceinline__ void qkt(f32x16&p0,f32x16&p1,const char*Kslot,const bf16x8*qr,const f32x16&negm,int r32,int hi){
  const char*kb=Kslot+hi*1024+r32*16;
  #pragma unroll
  for(int d0=0;d0<4;++d0){
    const bf16x8 b0=*reinterpret_cast<const bf16x8*>(kb+d0*2048);
    const bf16x8 b1=*reinterpret_cast<const bf16x8*>(kb+d0*2048+512);
    if(d0==0){p0=__builtin_amdgcn_mfma_f32_32x32x16_bf16(b0,qr[0],negm,0,0,0);p1=__builtin_amdgcn_mfma_f32_32x32x16_bf16(b1,qr[0],negm,0,0,0);}
    else{p0=__builtin_amdgcn_mfma_f32_32x32x16_bf16(b0,qr[d0],p0,0,0,0);p1=__builtin_amdgcn_mfma_f32_32x32x16_bf16(b1,qr[d0],p1,0,0,0);}}
}
typedef __attribute__((address_space(3))) const char* lds_cptr;
typedef short v4i16_t __attribute__((ext_vector_type(4)));
__device__ __forceinline__ void kload8(bf16x8*kf,lds_cptr kp){
  kf[0]=*(const __attribute__((address_space(3))) bf16x8*)(kp);      kf[1]=*(const __attribute__((address_space(3))) bf16x8*)(kp+512);
  kf[2]=*(const __attribute__((address_space(3))) bf16x8*)(kp+2048); kf[3]=*(const __attribute__((address_space(3))) bf16x8*)(kp+2560);
  kf[4]=*(const __attribute__((address_space(3))) bf16x8*)(kp+4096); kf[5]=*(const __attribute__((address_space(3))) bf16x8*)(kp+4608);
  kf[6]=*(const __attribute__((address_space(3))) bf16x8*)(kp+6144); kf[7]=*(const __attribute__((address_space(3))) bf16x8*)(kp+6656);
}
__device__ __forceinline__ void kload2(bf16x8*kf,lds_cptr kp,int j){ kf[2*j]=*(const __attribute__((address_space(3))) bf16x8*)(kp+j*2048); kf[2*j+1]=*(const __attribute__((address_space(3))) bf16x8*)(kp+j*2048+512); }
__device__ __forceinline__ s16x4 vtr(lds_cptr p){ return __builtin_bit_cast(s16x4,__builtin_amdgcn_ds_read_tr16_b64_v4i16((__attribute__((address_space(3))) v4i16_t*)p)); }
__device__ __forceinline__ float rowmax(const f32x16&p0,const f32x16&p1){
  float a=max3f(p0[0],p0[1],p1[0]),b=max3f(p0[2],p0[3],p1[1]);a=max3f(a,p1[2],p1[3]);
  #pragma unroll
  for(int r=4;r<16;r+=4){a=max3f(a,p0[r],p0[r+1]);b=max3f(b,p0[r+2],p0[r+3]);a=max3f(a,p1[r],p1[r+1]);b=max3f(b,p1[r+2],p1[r+3]);}
  const float m=max2f(a,b);
  auto rr=__builtin_amdgcn_permlane32_swap(__float_as_uint(m),__float_as_uint(m),false,false);
  return max2f(__uint_as_float(rr[0]),__uint_as_float(rr[1]));
}
__device__ __forceinline__ void pv(f32x16*o,int vb,bf16x8 pa0,bf16x8 pa1,bf16x8 pa2,bf16x8 pa3){
  #pragma unroll
  for(int d0=0;d0<2;++d0){s16x4 lo[4],hi[4];
    #pragma unroll
    for(int ks=0;ks<4;++ks){
      asm volatile("ds_read_b64_tr_b16 %0,%1 offset:%c2":"=&v"(lo[ks]):"v"(vb),"i"(d0*4096+ks*1024):"memory");
      asm volatile("ds_read_b64_tr_b16 %0,%1 offset:%c2":"=&v"(hi[ks]):"v"(vb),"i"(d0*4096+ks*1024+512):"memory");}
    asm volatile("s_waitcnt lgkmcnt(0)":::"memory");SBAR();
    #define PK(k) (bf16x8){lo[k][0],lo[k][1],lo[k][2],lo[k][3],hi[k][0],hi[k][1],hi[k][2],hi[k][3]}
    o[d0]=__builtin_amdgcn_mfma_f32_32x32x16_bf16(pa0,PK(0),o[d0],0,0,0);
    o[d0]=__builtin_amdgcn_mfma_f32_32x32x16_bf16(pa1,PK(1),o[d0],0,0,0);
    o[d0]=__builtin_amdgcn_mfma_f32_32x32x16_bf16(pa2,PK(2),o[d0],0,0,0);
    o[d0]=__builtin_amdgcn_mfma_f32_32x32x16_bf16(pa3,PK(3),o[d0],0,0,0);
    #undef PK
  }
}

#ifndef ATTN_STORE16
#define ATTN_STORE16(p,v) (*(u32x4*)(p)=(v))
#endif
template<int THRL> __device__ __forceinline__ void attn_unit(int b,int h,int qb,const bf16*Q,const bf16*__restrict__ K,const bf16*__restrict__ V,bf16*O,char*shm){
  const int tid=threadIdx.x,lane=tid&63,r32=lane&31,hi=lane>>5; const int wid=__builtin_amdgcn_readfirstlane(tid>>6);
  const long rowbase=(long)b*SEQ; const int q0=qb*QB;
  const bf16*Qw=Q+(rowbase+q0+wid*QBLK)*DM+h*D;
  const bf16*Kh=K+rowbase*DM+h*D,*Vh=V+rowbase*DM+h*D;
  const unsigned lds0=(unsigned)(uintptr_t)shm;
  float*wsf=(float*)(shm+LDS_WS)+wid*64;
  const bf16*ksrc=Kh+(long)lane*DM+wid*8;
  const bf16*vsrc=Vh+(long)(16*(wid&3)+(lane>>2))*DM+(wid>>2)*32+(lane&3)*8;
  const unsigned kdst=lds0+LDS_K+wid*1024, vdst=lds0+LDS_V+wid*1024;
  #define DMA_K(t,slot) glds16(ksrc+(long)(t)*KVBLK*DM,(unsigned)__builtin_amdgcn_readfirstlane(kdst+(slot)))
  #define DMA_V(t,slot) glds16(vsrc+(long)(t)*KVBLK*DM,(unsigned)__builtin_amdgcn_readfirstlane(vdst+(slot)))
  const int vb0=(int)(lds0+LDS_V)+((lane>>4)&1)*32+(lane&3)*8+(4*hi+((lane&15)>>2))*64;
  const char*Kbase=shm+LDS_K; bf16x8 kf[8];
  const lds_cptr shm3=(lds_cptr)shm; const lds_cptr kp0=shm3+LDS_K+hi*1024+r32*16; const lds_cptr vp0=shm3+LDS_V+((lane>>4)&1)*32+(lane&3)*8+(4*hi+((lane&15)>>2))*64;
  const int NT=(q0+QB)/KVBLK;
  DMA_K(0,0);DMA_V(0,0);DMA_K(1,SLOTB);
  __attribute__((address_space(3))) float*csl=(__attribute__((address_space(3))) float*)(uintptr_t)(unsigned)(uintptr_t)(shm+LDS_CS);
  const float ctq=csl[q0+wid*QBLK+r32];
  bf16x8 qr[4];
  #pragma unroll
  for(int d0=0;d0<4;++d0)qr[d0]=*reinterpret_cast<const bf16x8*>(&Qw[(long)r32*DM+d0*16+hi*8]);
  float mhat=-ctq,l_reg=0.f;f32x16 o[2];o[0]=f32x16{};o[1]=f32x16{};f32x16 negm;
  #pragma unroll
  for(int r=0;r<16;++r)negm[r]=ctq;
  asm volatile("":"+v"(negm));
  const int qrel=wid*QBLK+r32;
  #define CMASK(P0,P1,t) do{int jb_=(t)-(NT-4); if(jb_>=0)cmask(P0,P1,jb_,qrel,hi);}while(0)
  #define CSUB(P0,P1,t) do{ const __attribute__((address_space(3))) float*cp_=csl+(t)*KVBLK+4*hi; _Pragma("unroll") for(int g_=0;g_<4;g_+=2){ const f32x4v a_=*(const __attribute__((address_space(3))) f32x4v*)(cp_+8*g_), c_=*(const __attribute__((address_space(3))) f32x4v*)(cp_+8*g_+8); \
      _Pragma("unroll") for(int j_=0;j_<4;++j_){P0[4*g_+j_]-=a_[j_];P0[4*g_+4+j_]-=c_[j_];} SBAR(); } \
    _Pragma("unroll") for(int g_=0;g_<4;g_+=2){ const f32x4v b_=*(const __attribute__((address_space(3))) f32x4v*)(cp_+32+8*g_), d_=*(const __attribute__((address_space(3))) f32x4v*)(cp_+40+8*g_); \
      _Pragma("unroll") for(int j_=0;j_<4;++j_){P1[4*g_+j_]-=b_[j_];P1[4*g_+4+j_]-=d_[j_];} SBAR(); } }while(0)
  bool resc=false;
  #define START(P0,P1) do{ const float rm=rowmax(P0,P1); resc=false; \
    { const float dl=rm; mhat=fadd_s(mhat,dl); \
      _Pragma("unroll") for(int r=0;r<16;++r){P0[r]=fsub_s(P0[r],dl);P1[r]=fsub_s(P1[r],dl);} \
      _Pragma("unroll") for(int r=0;r<16;++r)negm[r]=-mhat; asm volatile("":"+v"(negm)); } \
    _Pragma("unroll") for(int r=0;r<16;++r)P0[r]=__builtin_amdgcn_exp2f(P0[r]); }while(0)
  #define RESC() do{ if(resc){ asm volatile("s_waitcnt lgkmcnt(0)":::"memory"); \
      _Pragma("unroll") for(int d_=0;d_<2;++d_) _Pragma("unroll") for(int r=0;r<16;++r)o[d_][r]*=wsf[crow(r,hi)]; } }while(0)
  f32x16 pA0,pA1,pB0,pB1;
  int sl_prev=0,sl_cur=0,sl_next=SLOTB;
  #define ROT() do{sl_prev=sl_cur;sl_cur=sl_next;sl_next=(sl_next==(NSLOT-1)*SLOTB)?0:sl_next+SLOTB;}while(0)
  DMA_K(2,2*SLOTB);
  WAIT_BAR(3);
  qkt(pA0,pA1,Kbase,qr,negm,r32,hi);asm volatile("s_nop 15\n\ts_nop 7":"+v"(pA0),"+v"(pA1));CSUB(pA0,pA1,0);CMASK(pA0,pA1,0);
  START(pA0,pA1);
  _Pragma("unroll") for(int r=0;r<16;++r)pA1[r]=__builtin_amdgcn_exp2f(pA1[r]);
  WAIT_BAR(0);
  DMA_K(3,0);DMA_V(1,SLOTB);
  ROT();
  kload8(kf,kp0+sl_cur);
  WAIT_BAR(2);
  s16x4 vlo[8],vhi[8]; u32x4 pw0,pw1,pw2,pw3;
  #define PKW(P,B) cvtpk_s(P[B],P[B+1])
  #define PAF(k) __builtin_bit_cast(bf16x8,pw##k)
  #define VFR(i) (bf16x8){vlo[i][0],vlo[i][1],vlo[i][2],vlo[i][3],vhi[i][0],vhi[i][1],vhi[i][2],vhi[i][3]}
  #define PIN(x) asm volatile("":"+v"(x))
  #define MX3(a,b,c) __builtin_fmaxf(__builtin_fmaxf((a),(b)),(c))
  #define GAPA(MF,A0,A1,A2,A3,W0,W1,PW) do{ MF; sacc+=A0; sacc+=A1; sacc+=A2; sacc+=A3; PIN(sacc); W0; W1; PIN(PW); SBAR(); }while(0)
  #define EX(v) __builtin_amdgcn_exp2f(v)
  #define GAPB(MF,X,B) do{ MF; X[B]=EX(X[B]); X[B+1]=EX(X[B+1]); X[B+2]=EX(X[B+2]); X[B+3]=EX(X[B+3]); PIN(X); SBAR(); }while(0)
  #define VRD(i) do{ vlo[i]=vtr(vp_+(((i)>>2)*4096+((i)&3)*1024)); vhi[i]=vtr(vp_+(((i)>>2)*4096+((i)&3)*1024+512)); }while(0)
  #define KRD(G,j) do{ if(G){ kload2(kf,kp0+sl_next,j); SBAR(); } }while(0)
  #define STEP(C0,C1,P0,P1,t,GK,GV,GL) do{ SBAR(); \
    const lds_cptr vp_=vp0+sl_prev; \
    VRD(0); SBAR(); float sacc=(P0[0]+P0[1]); \
    GAPA(C0=__builtin_amdgcn_mfma_f32_32x32x16_bf16(kf[0],qr[0],negm,0,0,0), P0[2],P0[3],P0[4],P0[5],     pw0[0]=PKW(P0,0), pw0[1]=PKW(P0,2), pw0); \
    VRD(4); SBAR(); GAPA(C1=__builtin_amdgcn_mfma_f32_32x32x16_bf16(kf[1],qr[0],negm,0,0,0), P0[6],P0[7],P0[8],P0[9],     pw0[2]=PKW(P0,4), pw0[3]=PKW(P0,6), pw0); \
    VRD(1); SBAR(); GAPA(C0=__builtin_amdgcn_mfma_f32_32x32x16_bf16(kf[2],qr[1],C0,0,0,0),   P0[10],P0[11],P0[12],P0[13], pw1[0]=PKW(P0,8), pw1[1]=PKW(P0,10), pw1); \
    VRD(5); SBAR(); GAPA(C1=__builtin_amdgcn_mfma_f32_32x32x16_bf16(kf[3],qr[1],C1,0,0,0),   P0[14],P0[15],P1[0],P1[1],   pw1[2]=PKW(P0,12),pw1[3]=PKW(P0,14), pw1); \
    VRD(2); SBAR(); GAPA(C0=__builtin_amdgcn_mfma_f32_32x32x16_bf16(kf[4],qr[2],C0,0,0,0),   P1[2],P1[3],P1[4],P1[5],     pw2[0]=PKW(P1,0), pw2[1]=PKW(P1,2), pw2); \
    VRD(6); SBAR(); GAPA(C1=__builtin_amdgcn_mfma_f32_32x32x16_bf16(kf[5],qr[2],C1,0,0,0),   P1[6],P1[7],P1[8],P1[9],     pw2[2]=PKW(P1,4), pw2[3]=PKW(P1,6), pw2); \
    VRD(3); SBAR(); GAPA(C0=__builtin_amdgcn_mfma_f32_32x32x16_bf16(kf[6],qr[3],C0,0,0,0),   P1[10],P1[11],P1[12],P1[13], pw3[0]=PKW(P1,8), pw3[1]=PKW(P1,10), pw3); \
    VRD(7); SBAR(); GAPA(C1=__builtin_amdgcn_mfma_f32_32x32x16_bf16(kf[7],qr[3],C1,0,0,0),   P1[14],P1[15],0.f,0.f,       pw3[2]=PKW(P1,12),pw3[3]=PKW(P1,14), pw3); \
    l_reg+=sacc; \
    if(GK){DMA_K((t)+3,sl_cur);} if(GV){DMA_V((t)+1,sl_next);} \
    SBAR(); CSUB(C0,C1,t); CMASK(C0,C1,t); \
    { float a=MX3(C0[0],C0[1],C1[0]),b=MX3(C0[2],C0[3],C1[1]); a=MX3(a,C1[2],C1[3]); \
      _Pragma("unroll") for(int r=4;r<16;r+=4){a=MX3(a,C0[r],C0[r+1]);b=MX3(b,C0[r+2],C0[r+3]);a=MX3(a,C1[r],C1[r+1]);b=MX3(b,C1[r+2],C1[r+3]);} \
      float rm=__builtin_fmaxf(a,b); { auto rr=__builtin_amdgcn_permlane32_swap(__float_as_uint(rm),__float_as_uint(rm),false,false); rm=__builtin_fmaxf(__uint_as_float(rr[0]),__uint_as_float(rr[1])); } \
      resc=false; \
      if(__builtin_expect(__any(rm>(float)THRL),0)){ const float dl=__builtin_fmaxf(rm,0.f); mhat+=dl; \
        _Pragma("unroll") for(int r=0;r<16;++r){C0[r]-=dl;C1[r]-=dl;} \
        _Pragma("unroll") for(int r=0;r<16;++r)negm[r]=-mhat; asm volatile("":"+v"(negm)); \
        const float f=__builtin_amdgcn_exp2f(-dl); l_reg*=f; if(hi==0)wsf[r32]=f; resc=true; } } \
    SBAR(); \
    GAPB(o[0]=__builtin_amdgcn_mfma_f32_32x32x16_bf16(PAF(0),VFR(0),o[0],0,0,0), C0,0); \
    GAPB(o[1]=__builtin_amdgcn_mfma_f32_32x32x16_bf16(PAF(0),VFR(4),o[1],0,0,0), C0,4); \
    KRD(GL,0); GAPB(o[0]=__builtin_amdgcn_mfma_f32_32x32x16_bf16(PAF(1),VFR(1),o[0],0,0,0), C0,8); \
    KRD(GL,1); GAPB(o[1]=__builtin_amdgcn_mfma_f32_32x32x16_bf16(PAF(1),VFR(5),o[1],0,0,0), C0,12); \
    KRD(GL,2); GAPB(o[0]=__builtin_amdgcn_mfma_f32_32x32x16_bf16(PAF(2),VFR(2),o[0],0,0,0), C1,0); \
    KRD(GL,3); GAPB(o[1]=__builtin_amdgcn_mfma_f32_32x32x16_bf16(PAF(2),VFR(6),o[1],0,0,0), C1,4); \
    GAPB(o[0]=__builtin_amdgcn_mfma_f32_32x32x16_bf16(PAF(3),VFR(3),o[0],0,0,0), C1,8); \
    GAPB(o[1]=__builtin_amdgcn_mfma_f32_32x32x16_bf16(PAF(3),VFR(7),o[1],0,0,0), C1,12); \
    }while(0)
  int t=1;
  #undef CMASK
  #define CMASK(P0,P1,t) do{}while(0)
  for(;t+5<NT;t+=2){
    STEP(pB0,pB1,pA0,pA1,t,true,true,true);     WAIT_BAR(2); RESC(); ROT();
    STEP(pA0,pA1,pB0,pB1,t+1,true,true,true);   WAIT_BAR(2); RESC(); ROT();
  }
  #undef CMASK
  #define CMASK(P0,P1,t) do{int jb_=(t)-(NT-4); if(jb_>=0)cmask(P0,P1,jb_,qrel,hi);}while(0)
  #define ENDW(tt) do{ if((tt)+3<NT){WAIT_BAR(2);} else if((tt)+2<NT){WAIT_BAR(1);} else {WAIT_BAR(0);} }while(0)
  for(;t+1<NT;t+=2){
    STEP(pB0,pB1,pA0,pA1,t,(t+3<NT),(t+1<NT),(t+1<NT));       ENDW(t);   RESC(); ROT();
    STEP(pA0,pA1,pB0,pB1,t+1,(t+4<NT),(t+2<NT),(t+2<NT));     ENDW(t+1); RESC(); ROT();
  }
  STEP(pB0,pB1,pA0,pA1,NT-1,false,false,false); RESC();
  { float sacc=pB0[0]+pB0[1]; _Pragma("unroll") for(int r=2;r<16;++r)sacc+=pB0[r]; _Pragma("unroll") for(int r=0;r<16;++r)sacc+=pB1[r]; l_reg+=sacc;
    pw0=(u32x4){PKW(pB0,0),PKW(pB0,2),PKW(pB0,4),PKW(pB0,6)};pw1=(u32x4){PKW(pB0,8),PKW(pB0,10),PKW(pB0,12),PKW(pB0,14)};pw2=(u32x4){PKW(pB1,0),PKW(pB1,2),PKW(pB1,4),PKW(pB1,6)};pw3=(u32x4){PKW(pB1,8),PKW(pB1,10),PKW(pB1,12),PKW(pB1,14)};
    SBAR(); pv(o,vb0+sl_cur,PAF(0),PAF(1),PAF(2),PAF(3)); }
  #undef PKW
  #undef PAF
  #undef VFR
  #undef PIN
  #undef MX3
  #undef GAPA
  #undef GAPB
  #undef EX
  #undef VRD
  #undef KRD
  #undef STEP
  #undef ENDW
  {auto rr=__builtin_amdgcn_permlane32_swap(__float_as_uint(l_reg),__float_as_uint(l_reg),false,false);l_reg=__uint_as_float(rr[0])+__uint_as_float(rr[1]);}
  if(hi==0)wsf[32+r32]=l_reg;asm volatile("s_waitcnt lgkmcnt(0)":::"memory");
  float rli[16];
  #pragma unroll
  for(int r=0;r<16;++r)rli[r]=__builtin_amdgcn_rcpf(wsf[32+crow(r,hi)]);
  bf16*Ow=O+(rowbase+q0+wid*QBLK)*DM+h*D;
  { bf16*stg=(bf16*)(shm+LDS_OST)+wid*2048;
    #pragma unroll
    for(int r=0;r<16;++r){const int orow=crow(r,hi);
      #pragma unroll
      for(int d0=0;d0<2;++d0)stg[orow*64+d0*32+r32]=__float2bfloat16(o[d0][r]*rli[r]);}
    asm volatile("s_waitcnt lgkmcnt(0)":::"memory");
    #pragma unroll
    for(int i=0;i<4;++i){const int row=i*8+(lane>>3),ch=lane&7; const u32x4 v=*(const u32x4*)(stg+row*64+ch*8); ATTN_STORE16(Ow+(long)row*DM+ch*8,v);} }
  asm volatile("s_waitcnt lgkmcnt(0)\n\ts_barrier":::"memory");
  #undef DMA_K
  #undef DMA_V
  #undef CMASK
  #undef CSUB
  #undef START
  #undef RESC
  #undef ROT
}
constexpr int ATTN_LDS_BYTES=LDS_BYTES;
struct AttnTensors { const bf16* Q; const bf16* K; const bf16* V; bf16* O; const float* CS; };
struct AttnUnit { int bh; int qb; };
struct StaticOrder {
  int vcu;
  __device__ __forceinline__ explicit StaticOrder(int grid,int block):vcu((block%8)*(grid/8)+block/8){}
  __device__ __forceinline__ bool next(int i,AttnUnit&u)const{ if(i>=4)return false; const int s=vcu&1; u.bh=vcu>>1; u.qb=(i==0)?s:(i==1)?7-s:(i==2)?3-s:4+s; return true; }
};
template<class Sched,int THRL=8> __device__ __forceinline__ void attn_phase(char*lds,const AttnTensors&T,const Sched&S){
  AttnUnit u;
  {
    const int tid=threadIdx.x, bh=S.vcu>>1, b=bh/NHEAD, h=bh%NHEAD;
    __attribute__((address_space(3))) float*csl=(__attribute__((address_space(3))) float*)(uintptr_t)(unsigned)(uintptr_t)(lds+LDS_CS);
    __attribute__((address_space(3))) float*sc=(__attribute__((address_space(3))) float*)(uintptr_t)(unsigned)(uintptr_t)(lds+LDS_WS);
    float v[4],run=0.f;
    #pragma unroll
    for(int i=0;i<4;++i){run+=T.CS[(long)(b*SEQ+4*tid+i)*NHEAD+h];v[i]=run;}
    sc[tid]=run;__syncthreads();
    for(int o=1;o<NW*64;o<<=1){const float a=(tid>=o)?sc[tid-o]:0.f;__syncthreads();sc[tid]+=a;__syncthreads();}
    const float excl=sc[tid]-run;
    #pragma unroll
    for(int i=0;i<4;++i)csl[4*tid+i]=(excl+v[i])*1.4426950408889634f;
    __syncthreads(); }
  for(int i=0;S.next(i,u);++i){ attn_unit<THRL>(u.bh/NHEAD,u.bh%NHEAD,u.qb,T.Q,T.K,T.V,T.O,lds); }
}

constexpr int SB_K=0, SB_V=2*SLOTB, SB_FLAG=4*SLOTB, SB_OST=SB_FLAG+256, SB_BYTES=SB_OST+NW*4096;
__device__ __forceinline__ void sb_unit(int b,int h,int qb,const bf16*Q,const bf16*__restrict__ K,const bf16*__restrict__ V,bf16*O,char*shm){
  const int tid=threadIdx.x,lane=tid&63,r32=lane&31,hi=lane>>5; const int wid=__builtin_amdgcn_readfirstlane(tid>>6);
  const long rowbase=(long)b*SEQ; const int q0=qb*QB;
  const bf16*Qw=Q+(rowbase+q0+wid*QBLK)*DM+h*D;
  const bf16*Kh=K+rowbase*DM+h*D,*Vh=V+rowbase*DM+h*D;
  const unsigned lds0=(unsigned)(uintptr_t)shm;
  const bf16*ksrc=Kh+(long)lane*DM+wid*8;
  const bf16*vsrc=Vh+(long)(16*(wid&3)+(lane>>2))*DM+(wid>>2)*32+(lane&3)*8;
  const unsigned kdst=lds0+SB_K+wid*1024, vdst=lds0+SB_V+wid*1024;
  #define DMA_K(t,slot) glds16(ksrc+(long)(t)*KVBLK*DM,(unsigned)__builtin_amdgcn_readfirstlane(kdst+(slot)))
  #define DMA_V(t,slot) glds16(vsrc+(long)(t)*KVBLK*DM,(unsigned)__builtin_amdgcn_readfirstlane(vdst+(slot)))
  const int vb0=(int)(lds0+SB_V)+((lane>>4)&1)*32+(lane&3)*8+(4*hi+((lane&15)>>2))*64;
  typedef __attribute__((address_space(3))) unsigned lds_u32;
  lds_u32* flag=(lds_u32*)(uintptr_t)(lds0+SB_FLAG);
  const int NT=(q0+QB)/KVBLK;
  DMA_K(NT-1,0);DMA_V(NT-1,0);
  bf16x8 qr[4];
  #pragma unroll
  for(int d0=0;d0<4;++d0)qr[d0]=*reinterpret_cast<const bf16x8*>(&Qw[(long)r32*DM+d0*16+hi*8]);
  f32x16 o[2];o[0]=f32x16{};o[1]=f32x16{};
  float rinv=1.0f; const int qrel=wid*QBLK+r32;
  for(int i=0;i<NT;++i){
    const int t=NT-1-i, slot=(i&1)*SLOTB;
    asm volatile("s_waitcnt vmcnt(0) lgkmcnt(0)\n\ts_barrier":::"memory");
    if(i>0){ const u32x4 f0=*(const __attribute__((address_space(3))) u32x4*)(flag+((i-1)&1)*8), f1=*(const __attribute__((address_space(3))) u32x4*)(flag+((i-1)&1)*8+4);
      if((f0.x&f0.y&f0.z&f0.w&f1.x&f1.y&f1.z&f1.w)!=0u)break; }
    if(i+1<NT){DMA_K(t-1,SLOTB-slot);DMA_V(t-1,SLOTB-slot);}
    f32x16 p0,p1; { f32x16 zc=f32x16{}; qkt(p0,p1,shm+SB_K+slot,qr,zc,r32,hi); }
    f32x16 c0,c1;
    #pragma unroll
    for(int r=0;r<16;++r){p0[r]=__builtin_amdgcn_exp2f(p0[r]);p1[r]=__builtin_amdgcn_exp2f(p1[r]);}
    { const int jb=t-(NT-4); if(jb>=0){ const int kb=64*jb+4*hi;
      #pragma unroll
      for(int r=0;r<16;++r){const int kv=kb+(r&3)+8*(r>>2); if(kv>=qrel)p0[r]=0.f; if(kv+32>=qrel)p1[r]=0.f;} } }
    #pragma unroll
    for(int r=0;r<16;++r){c0[r]=__builtin_amdgcn_rcpf(1.0f+p0[r]);c1[r]=__builtin_amdgcn_rcpf(1.0f+p1[r]);}
    #pragma unroll
    for(int g=0;g<4;++g){ c0[4*g+2]*=c0[4*g+3];c0[4*g+1]*=c0[4*g+2];c0[4*g]*=c0[4*g+1]; c1[4*g+2]*=c1[4*g+3];c1[4*g+1]*=c1[4*g+2];c1[4*g]*=c1[4*g+1]; }
    float tl[8],th[8],X[8];
    #pragma unroll
    for(int g=0;g<8;++g){ const float T=(g<4)?c0[4*g]:c1[4*(g-4)]; auto rr=__builtin_amdgcn_permlane32_swap(__float_as_uint(T),__float_as_uint(T),false,false); tl[g]=__uint_as_float(rr[0]); th[g]=__uint_as_float(rr[1]); }
    X[7]=1.0f;
    #pragma unroll
    for(int g=6;g>=0;--g)X[g]=X[g+1]*(tl[g+1]*th[g+1]);
    #pragma unroll
    for(int g=0;g<8;++g){ const float F=rinv*X[g]*(hi?1.0f:th[g]);
      #pragma unroll
      for(int j=0;j<4;++j){ if(g<4)p0[4*g+j]=p0[4*g+j]*c0[4*g+j]*F; else p1[4*(g-4)+j]=p1[4*(g-4)+j]*c1[4*(g-4)+j]*F; } }
    rinv=rinv*X[0]*(tl[0]*th[0]);
    { const bool dn=__all(rinv<8.6736174e-19f); if(lane==0)flag[(i&1)*8+wid]=dn?1u:0u; }
    u32x4 pw0,pw1,pw2,pw3;
    pw0=(u32x4){cvtpk_s(p0[0],p0[1]),cvtpk_s(p0[2],p0[3]),cvtpk_s(p0[4],p0[5]),cvtpk_s(p0[6],p0[7])};
    pw1=(u32x4){cvtpk_s(p0[8],p0[9]),cvtpk_s(p0[10],p0[11]),cvtpk_s(p0[12],p0[13]),cvtpk_s(p0[14],p0[15])};
    pw2=(u32x4){cvtpk_s(p1[0],p1[1]),cvtpk_s(p1[2],p1[3]),cvtpk_s(p1[4],p1[5]),cvtpk_s(p1[6],p1[7])};
    pw3=(u32x4){cvtpk_s(p1[8],p1[9]),cvtpk_s(p1[10],p1[11]),cvtpk_s(p1[12],p1[13]),cvtpk_s(p1[14],p1[15])};
    SBAR(); pv(o,vb0+slot,__builtin_bit_cast(bf16x8,pw0),__builtin_bit_cast(bf16x8,pw1),__builtin_bit_cast(bf16x8,pw2),__builtin_bit_cast(bf16x8,pw3));
  }
  bf16*Ow=O+(rowbase+q0+wid*QBLK)*DM+h*D;
  { bf16*stg=(bf16*)(shm+SB_OST)+wid*2048;
    #pragma unroll
    for(int r=0;r<16;++r){const int orow=crow(r,hi);
      #pragma unroll
      for(int d0=0;d0<2;++d0)stg[orow*64+d0*32+r32]=__float2bfloat16(o[d0][r]);}
    asm volatile("s_waitcnt lgkmcnt(0)":::"memory");
    #pragma unroll
    for(int i=0;i<4;++i){const int row=i*8+(lane>>3),ch=lane&7; const u32x4 v=*(const u32x4*)(stg+row*64+ch*8); *(u32x4*)(Ow+(long)row*DM+ch*8)=v;} }
  asm volatile("s_waitcnt vmcnt(0) lgkmcnt(0)\n\ts_barrier":::"memory");
  #undef DMA_K
  #undef DMA_V
}
template<class Sched> __device__ __forceinline__ void sb_phase(char*lds,const AttnTensors&T,const Sched&S){
  AttnUnit u;
  for(int i=0;S.next(i,u);++i){ sb_unit(u.bh/NHEAD,u.bh%NHEAD,u.qb,T.Q,T.K,T.V,T.O,lds); }
}
#undef SBAR
#undef WAIT_BAR
}
struct Args { const float* in[20]; float* out; unsigned char* ws; int ph_lo, ph_hi, li, pad; };

struct ConvDesc { const float* src; const float* gain; bf16_t* dst; int ldn, K; };
__device__ __forceinline__ void conv_load(const ConvDesc& d, f32x4 (&v)[16], f32x4 (&g)[2], int lane) {
#pragma unroll
    for (int i = 0; i < 16; ++i) v[i] = *(const GAS f32x4*)(d.src + (size_t)(4 * i + (lane >> 4)) * d.ldn + (lane & 15) * 4);
    if (d.gain) { g[0] = *(const GAS f32x4*)(d.gain + 8 * (lane & 7)); g[1] = *(const GAS f32x4*)(d.gain + 8 * (lane & 7) + 4); }
    else { g[0] = (f32x4){1.f, 1.f, 1.f, 1.f}; g[1] = g[0]; }
}
__device__ __forceinline__ void conv_store(const ConvDesc& d, const f32x4 (&v)[16], const f32x4 (&g)[2], LAS float* scr, int lane) {
#pragma unroll
    for (int i = 0; i < 16; ++i) { LAS float* s = scr + (4 * i + (lane >> 4)) * 65 + (lane & 15) * 4; s[0] = v[i][0]; s[1] = v[i][1]; s[2] = v[i][2]; s[3] = v[i][3]; }
    const int c = lane & 7;
    LDS_WAIT(); asm volatile("" ::: "memory");
#pragma unroll
    for (int j = 0; j < 8; ++j) { const int n = (lane >> 3) + 8 * j; const LAS float* s = scr + (8 * c) * 65 + n;
        u32x4 o; o.x = pk2(s[0 * 65] * g[0][0], s[1 * 65] * g[0][1]); o.y = pk2(s[2 * 65] * g[0][2], s[3 * 65] * g[0][3]); o.z = pk2(s[4 * 65] * g[1][0], s[5 * 65] * g[1][1]); o.w = pk2(s[6 * 65] * g[1][2], s[7 * 65] * g[1][3]);
        *(GAS u32x4*)(d.dst + (size_t)n * d.K + 8 * c) = o; }
    LDS_WAIT(); asm volatile("" ::: "memory");
}
__device__ __forceinline__ int gu_dest(int n0, int FH) { const int up = n0 >= FH ? 1 : 0, j = n0 - up * FH; return 256 * (j >> 7) + 128 * up + (j & 127); }

__device__ __forceinline__ void moe_prefix(const int* cntwg, int wg, volatile LAS int* L, int wave, int lane) {
    __syncthreads();
    { int tot = 0, pre = 0;
      for (int w = lane; w < 256; w += 64) { const int c = __hip_atomic_load(cntwg + w * 8 + wave, RLX_AGENT); tot += c; if (w < wg) pre += c; }
#pragma unroll
      for (int o = 1; o < 64; o <<= 1) { tot += __shfl_xor(tot, o); pre += __shfl_xor(pre, o); }
      if (lane == 0) { L[16 + wave] = tot; L[32 + wave] = pre; } }
    __syncthreads();
    if (threadIdx.x == 0) { int a = 0; L[0] = 0; for (int e = 0; e < NE; ++e) { a += (L[16 + e] + 255) >> 8; L[e + 1] = a; } }
    __syncthreads();
}

__device__ __forceinline__ const float* inp_ptr(int i) {
    typedef __attribute__((address_space(4))) const unsigned long long* kap_t;
    kap_t p = (kap_t)__builtin_amdgcn_kernarg_segment_ptr();
    asm volatile("" : "+s"(p));
    return (const float*)(const GAS float*)(uintptr_t)p[i];
}
constexpr int CI_IN = 16 * 48, CI_SQ = 16 * 16, CI_KV = 16 * 32, CI_GUD = 16 * 88, CI_DD = 44 * 16, CI_GUM1 = 16 * 112, CI_DM1 = 56 * 16, CI_PP1 = 4 * 16;
constexpr int CONV_NITEMS = CI_IN + CI_SQ + CI_KV + CI_SQ + CI_SQ + CI_GUD + CI_DD + NE * CI_GUM1 + NE * CI_DM1 + 2 * CI_PP1 + 2 * CI_SQ;
__device__ __forceinline__ ConvDesc conv_mk(const float* W, int ldn, int K, const float* gain, bf16_t* WT, int k0, int n0, int nd0) {
    ConvDesc d; d.src = W + (size_t)k0 * ldn + n0; d.gain = gain ? gain + k0 : nullptr; d.dst = WT + (size_t)nd0 * K + k0; d.ldn = ldn; d.K = K; return d;
}
__device__ __forceinline__ ConvDesc conv_decode(int it, unsigned char* ws) {
    int r = it;
    if (r < CI_IN) return conv_mk(inp_ptr(4), 3 * DM + NH, DM, inp_ptr(2), (bf16_t*)(ws + WS_W_IN), 64 * (r / 48), 64 * (r % 48), 64 * (r % 48)); r -= CI_IN;
    if (r < CI_SQ) return conv_mk(inp_ptr(6), DM, DM, nullptr, (bf16_t*)(ws + WS_W_OA), 64 * (r / 16), 64 * (r % 16), 64 * (r % 16)); r -= CI_SQ;
    if (r < CI_KV) return conv_mk(inp_ptr(8), 2 * DM, DM, inp_ptr(7), (bf16_t*)(ws + WS_W_KVQ), 64 * (r / 32), 64 * (r % 32), 64 * (r % 32)); r -= CI_KV;
    if (r < CI_SQ) return conv_mk(inp_ptr(9), DM, DM, inp_ptr(2) + DM, (bf16_t*)(ws + WS_W_KVQ), 64 * (r / 16), 64 * (r % 16), 2 * DM + 64 * (r % 16)); r -= CI_SQ;
    if (r < CI_SQ) return conv_mk(inp_ptr(10), DM, DM, nullptr, (bf16_t*)(ws + WS_W_OB), 64 * (r / 16), 64 * (r % 16), 64 * (r % 16)); r -= CI_SQ;
    if (r < CI_GUD) { const int n0 = 64 * (r % 88); return conv_mk(inp_ptr(11), 2 * FD, DM, inp_ptr(3), (bf16_t*)(ws + WS_W_GUD), 64 * (r / 88), n0, gu_dest(n0, FD)); } r -= CI_GUD;
    if (r < CI_DD) return conv_mk(inp_ptr(12), DM, FD, nullptr, (bf16_t*)(ws + WS_W_DD), 64 * (r / 16), 64 * (r % 16), 64 * (r % 16)); r -= CI_DD;
    if (r < NE * CI_GUM1) { const int e = r / CI_GUM1, q = r % CI_GUM1, n0 = 64 * (q % 112);
        return conv_mk(inp_ptr(15) + (size_t)e * DM * 2 * FE, 2 * FE, DM, inp_ptr(3) + DM, (bf16_t*)(ws + WS_W_GUM) + (size_t)e * 2 * FE * DM, 64 * (q / 112), n0, gu_dest(n0, FE)); } r -= NE * CI_GUM1;
    if (r < NE * CI_DM1) { const int e = r / CI_DM1, q = r % CI_DM1;
        return conv_mk(inp_ptr(16) + (size_t)e * FE * DM, DM, FE, nullptr, (bf16_t*)(ws + WS_W_DM) + (size_t)e * DM * FE, 64 * (q / 16), 64 * (q % 16), 64 * (q % 16)); } r -= NE * CI_DM1;
    if (r < 2 * CI_PP1) { const int e = r / CI_PP1, q = r % CI_PP1;
        return conv_mk(inp_ptr(17) + (size_t)e * DP * DM, DM, DP, nullptr, (bf16_t*)(ws + WS_W_PP) + (size_t)e * DM * DP, 64 * (q / 16), 64 * (q % 16), 64 * (q % 16)); } r -= 2 * CI_PP1;
    { const int e = r / CI_SQ, q = r % CI_SQ;
        return conv_mk(inp_ptr(18) + (size_t)e * DM * DM, DM, DM, nullptr, (bf16_t*)(ws + WS_W_PG) + (size_t)e * DM * DM, 64 * (q / 16), 64 * (q % 16), 64 * (q % 16)); }
}
__global__ void __launch_bounds__(NW * 64, 2) fwd_kernel(Args args) {
    extern __shared__ __attribute__((aligned(16))) unsigned char lds_raw[];
    LAS unsigned char* lds = (LAS unsigned char*)lds_raw;
    volatile LAS unsigned* MISC = (volatile LAS unsigned*)(lds + MISC_OFF);
    const int tid = threadIdx.x, lane = tid & 63, wave = __builtin_amdgcn_readfirstlane(tid >> 6);
    const int G = gridDim.x, bx = blockIdx.x;
    const int vcu = (G % 8 == 0) ? (bx % 8) * (G / 8) + bx / 8 : bx;
    const int gw = vcu * NW + wave, NGW = G * NW;
    unsigned char* ws = args.ws;
    gu32* ctl = (gu32*)(ws + WS_CTL);
    float* const hres = args.out;
#define INP(i) inp_ptr(i)
#define in_x INP(0)
#define p_in INP(1)
#define attn_norm INP(2)
#define ffn_norm INP(3)
#define w_in_a INP(4)
#define b_f INP(5)
#define w_o_a INP(6)
#define kv_norm INP(7)
#define w_kv INP(8)
#define w_q_b INP(9)
#define w_o_b INP(10)
#define w_gu_dense INP(11)
#define w_down_dense INP(12)
#define router_w INP(13)
#define router_b INP(14)
#define w_gu_moe INP(15)
#define w_down_moe INP(16)
#define w_ple_proj INP(17)
#define w_ple_gate INP(18)
#define final_norm INP(19)
#define rs0 ((float*)(ws + WS_RS0))
#define slab1 ((float*)(ws + WS_SLAB1))
#define slab3 ((float*)(ws + WS_SLAB3))
#define slab6 ((float*)(ws + WS_SLAB6))
#define logf_ ((float*)(ws + WS_LOGF))
#define cs ((float*)(ws + WS_CS))
#define cntwg ((int*)(ws + WS_CNTWG))
#define selE ((int*)(ws + WS_SELE))
#define selG ((float*)(ws + WS_SELG))
#define rr4 ((float*)(ws + WS_RR4))
#define tokpos ((int*)(ws + WS_TOKPOS))
#define grow ((float*)(ws + WS_GROW))
#define W_IN ((bf16_t*)(ws + WS_W_IN))
#define W_OA ((bf16_t*)(ws + WS_W_OA))
#define W_KVQ ((bf16_t*)(ws + WS_W_KVQ))
#define W_OB ((bf16_t*)(ws + WS_W_OB))
#define W_GUD ((bf16_t*)(ws + WS_W_GUD))
#define W_DD ((bf16_t*)(ws + WS_W_DD))
#define W_PP ((bf16_t*)(ws + WS_W_PP))
#define W_PG ((bf16_t*)(ws + WS_W_PG))
#define W_GUM ((bf16_t*)(ws + WS_W_GUM))
#define W_DM ((bf16_t*)(ws + WS_W_DM))
#define HBA ((bf16_t*)(ws + WS_HBA))
#define HBB ((bf16_t*)(ws + WS_HBB))
#define PB ((bf16_t*)(ws + WS_PB))
#define PP ((bf16_t*)(ws + WS_PP))
#define XG ((bf16_t*)(ws + WS_XGY))
#define YB ((bf16_t*)(ws + WS_XGY))
#define QB ((bf16_t*)(ws + WS_Q))
#define KB ((bf16_t*)(ws + WS_K))
#define VB ((bf16_t*)(ws + WS_V))
#define OB ((bf16_t*)(ws + WS_O))
#define ACTD ((bf16_t*)(ws + WS_ACTD))
#define ACTM ((bf16_t*)(ws + WS_ACTM))

    for (int u = tid; u < (LDS_BYTES - LDSCTL_OFF) / 4; u += NW * 64) ((LAS unsigned*)(lds + LDSCTL_OFF))[u] = 0u;
    __syncthreads();
    XcdBarrier bar; bar.bar = (unsigned*)(ctl + CW_BAR) + args.li * XCD_BAR_WORDS; bar.x = 0; bar.st = nullptr;
    if (N_LAUNCHES != NPH) bar = xcd_barrier_post((unsigned*)(ctl + CW_BAR) + args.li * XCD_BAR_WORDS, MISC + 8);
    const int lo = args.ph_lo, hi = args.ph_hi;
#ifndef PHASE_MASK
#define PHASE_MASK 0x1ffff
#endif
#define IN(k) ((((PHASE_MASK) >> (k)) & 1) && lo <= (k) && (k) < hi)
#define SEAM(k) do { if (IN(k) && IN((k) + 1)) xcd_barrier(bar); } while (0)

    if (IN(0)) {
        const int p0parts = args.pad;
        if (p0parts & 1) {
            LAS float* wfg = (LAS float*)lds;
            { const float* an_ = attn_norm; const float* wi_ = w_in_a;
              float tmp[32];
#pragma unroll
              for (int u = 0; u < 32; ++u) { const int i = tid + u * (NW * 64), k = i >> 4, h = i & 15; tmp[u] = an_[k] * wi_[(size_t)k * (3 * DM + NH) + 3 * DM + h]; }
#pragma unroll
              for (int u = 0; u < 32; ++u) { const int i = tid + u * (NW * 64), k = i >> 4, h = i & 15;
                wfg[((((((k >> 8) * 4 + (k & 3)) * 4 + (h >> 2)) * 64) + ((k & 255) >> 2)) << 2) + (h & 3)] = tmp[u]; } }
            const float* xin_ = in_x; const float* bf_ = b_f;
            __syncthreads();
            f32x4 vn[4];
            if (gw < MT) { const GAS f32x4* xr = (const GAS f32x4*)(xin_ + (size_t)gw * DM) + lane;
#pragma unroll
                for (int j = 0; j < 4; ++j) vn[j] = xr[64 * j]; }
            for (int m = gw; m < MT; m += NGW) {
                f32x4 v[4]; float s = 0.f;
#pragma unroll
                for (int j = 0; j < 4; ++j) v[j] = vn[j];
                if (m + NGW < MT) { const GAS f32x4* xr = (const GAS f32x4*)(xin_ + (size_t)(m + NGW) * DM) + lane;
#pragma unroll
                    for (int j = 0; j < 4; ++j) vn[j] = xr[64 * j]; }
#pragma unroll
                for (int j = 0; j < 4; ++j) s += (v[j][0] * v[j][0] + v[j][1] * v[j][1]) + (v[j][2] * v[j][2] + v[j][3] * v[j][3]);
                const float r = 1.0f / sqrtf(wave_sum(s) * (1.0f / DM) + RMS_EPS);
                GAS unsigned long long* o8 = (GAS unsigned long long*)(HBA + (size_t)m * DM) + lane;
#pragma unroll
                for (int j = 0; j < 4; ++j) o8[64 * j] = (unsigned long long)pk2(v[j][0], v[j][1]) | ((unsigned long long)pk2(v[j][2], v[j][3]) << 32);
                float fa[16];
#pragma unroll
                for (int h = 0; h < 16; ++h) fa[h] = 0.f;
#pragma unroll
                for (int j = 0; j < 4; ++j) {
#pragma unroll
                    for (int i = 0; i < 4; ++i) { const LAS f32x4* wp = (const LAS f32x4*)wfg + ((j * 4 + i) * 4) * 64 + lane; const float xv = v[j][i];
#pragma unroll
                        for (int q = 0; q < 4; ++q) { const f32x4 w4 = wp[q * 64]; fa[4 * q + 0] += xv * w4[0]; fa[4 * q + 1] += xv * w4[1]; fa[4 * q + 2] += xv * w4[2]; fa[4 * q + 3] += xv * w4[3]; } }
                    asm volatile("" ::: "memory"); }
#pragma unroll
                for (int h = 0; h < 16; ++h) fa[h] = wave_sum(fa[h]);
                if (lane == 0) rs0[m] = r;
                if (lane < 16) { float fv = 0.f;
#pragma unroll
                    for (int h = 0; h < 16; ++h) fv = (lane == h) ? fa[h] : fv;
                    const float z = fv * r + bf_[lane];
                    logf_[(size_t)m * NH + lane] = fminf(z, 0.f) - log1pf(expf(-fabsf(z))); }
            }
            __syncthreads();
        }
        const float* pin_ = p_in;
        if (p0parts & 1) {
            const size_t nth = (size_t)NGW * 64, i0 = (size_t)gw * 64 + lane, tot = (size_t)2 * MT * DP / 4;
            for (size_t ib = i0; ib < tot; ib += 8 * nth) { f32x4 v[8];
#pragma unroll
                for (int u = 0; u < 8; ++u) if (ib + u * nth < tot) v[u] = ((const GAS f32x4*)pin_)[ib + u * nth];
#pragma unroll
                for (int u = 0; u < 8; ++u) if (ib + u * nth < tot) { u32x2 w; w.x = pk2(v[u][0], v[u][1]); w.y = pk2(v[u][2], v[u][3]); ((GAS u32x2*)PB)[ib + u * nth] = w; } }
        }
        LAS float* scr = (LAS float*)(lds + wave * 16640);
        if (p0parts & 2) {
            ConvDesc dA, dB; f32x4 vA[16], vB[16], gA[2], gB[2];
            int it = gw;
            if (it < CONV_NITEMS) { dA = conv_decode(it, ws); conv_load(dA, vA, gA, lane); }
            while (it < CONV_NITEMS) {
                const bool hb = it + NGW < CONV_NITEMS;
                if (hb) { dB = conv_decode(it + NGW, ws); conv_load(dB, vB, gB, lane); }
                conv_store(dA, vA, gA, scr, lane);
                if (!hb) break;
                const bool ha = it + 2 * NGW < CONV_NITEMS;
                if (ha) { dA = conv_decode(it + 2 * NGW, ws); conv_load(dA, vA, gA, lane); }
                conv_store(dB, vB, gB, scr, lane);
                it += 2 * NGW;
                if (!ha) break;
            }
        }
    }
    SEAM(0);

    if (IN(1)) {
        pg8::Gemm g{HBA, W_IN, DM}; pg8::StaticOrder S; S.init(MT, 3 * DM, G, bx);
        pg8::EpiQKV E{QB, (size_t)(WS_K - WS_Q) / 2, 0, pg8::RowScale{rs0, 0}};
        pg8::gemm_phase(lds, g, S, E);
    }
    SEAM(1);

    if (IN(2)) {
#if !defined(NAIVE_FOX)
        static_assert(fox_body::LDS_BYTES <= RING_BYTES, "attention scratch vs LDS ring");
        const fox_body::AttnTensors AT{(const fox_body::bf16*)QB, (const fox_body::bf16*)KB, (const fox_body::bf16*)VB, (fox_body::bf16*)OB, logf_};
        const fox_body::StaticOrder S(G, bx);
        fox_body::attn_phase<fox_body::StaticOrder>((char*)lds_raw, AT, S);
        __syncthreads();
    }
#else
        const int zero = opaque_zero();
        for (int j = 0; j < 2; ++j) {
            const int it = gw + j * NGW; if (it >= NB * NH * 32) break;
            const int bh = it & 127, qq = it >> 7, qb = (j == 0) ? qq : 31 - (qq - 16);
            const int b = bh >> 4, h = bh & 15, t = qb * 64 + lane; const size_t row = (size_t)b * SEQ + t;
            float q[64], o[64];
            { const u32x4* qp = (const u32x4*)(QB + row * DM + h * HD);
#pragma unroll
              for (int c = 0; c < 8; ++c) { const u32x4 w = qp[c]; q[8 * c + 0] = bflo(w.x); q[8 * c + 1] = bfhi(w.x); q[8 * c + 2] = bflo(w.y); q[8 * c + 3] = bfhi(w.y); q[8 * c + 4] = bflo(w.z); q[8 * c + 5] = bfhi(w.z); q[8 * c + 6] = bflo(w.w); q[8 * c + 7] = bfhi(w.w); } }
#pragma unroll
            for (int d = 0; d < 64; ++d) o[d] = 0.f;
            const float* csb = cs + (size_t)bh * SEQ; const float ct = csb[t];
            float mx = -1e30f, l = 0.f;
            const int smax = qb * 64 + 63;
            for (int s = 0; s <= smax; ++s) {
                const size_t kro = ((size_t)b * SEQ + s) * DM + h * HD + zero;
                const u32x4* kp = (const u32x4*)(KB + kro); float dot = 0.f;
#pragma unroll
                for (int c = 0; c < 8; ++c) { const u32x4 w = kp[c]; dot += q[8 * c + 0] * bflo(w.x) + q[8 * c + 1] * bfhi(w.x) + q[8 * c + 2] * bflo(w.y) + q[8 * c + 3] * bfhi(w.y) + q[8 * c + 4] * bflo(w.z) + q[8 * c + 5] * bfhi(w.z) + q[8 * c + 6] * bflo(w.w) + q[8 * c + 7] * bfhi(w.w); }
                const float scv = dot + ct - csb[s + zero];
                if (s <= t) {
                    const float mn = fmaxf(mx, scv), a = __builtin_amdgcn_exp2f(mx - mn), pw = __builtin_amdgcn_exp2f(scv - mn);
                    l = l * a + pw; mx = mn;
                    const u32x4* vp = (const u32x4*)(VB + kro);
#pragma unroll
                    for (int c = 0; c < 8; ++c) { const u32x4 w = vp[c];
                        o[8 * c + 0] = o[8 * c + 0] * a + pw * bflo(w.x); o[8 * c + 1] = o[8 * c + 1] * a + pw * bfhi(w.x); o[8 * c + 2] = o[8 * c + 2] * a + pw * bflo(w.y); o[8 * c + 3] = o[8 * c + 3] * a + pw * bfhi(w.y);
                        o[8 * c + 4] = o[8 * c + 4] * a + pw * bflo(w.z); o[8 * c + 5] = o[8 * c + 5] * a + pw * bfhi(w.z); o[8 * c + 6] = o[8 * c + 6] * a + pw * bflo(w.w); o[8 * c + 7] = o[8 * c + 7] * a + pw * bfhi(w.w); }
                }
            }
            const float il = 1.0f / l; u32x4* op = (u32x4*)(OB + row * DM + h * HD);
#pragma unroll
            for (int c = 0; c < 8; ++c) { u32x4 w; w.x = pk2(o[8 * c + 0] * il, o[8 * c + 1] * il); w.y = pk2(o[8 * c + 2] * il, o[8 * c + 3] * il); w.z = pk2(o[8 * c + 4] * il, o[8 * c + 5] * il); w.w = pk2(o[8 * c + 6] * il, o[8 * c + 7] * il); op[c] = w; }
        }
    }
#endif
    SEAM(2);

    if (IN(3)) {
        pg8::Gemm g{OB, W_OA, DM}; pg8::StaticOrder S; S.init(MT, DM, G, bx);
        pg8::EpiResid E{HBA, slab1};
        pg8::gemm_phase(lds, g, S, E);
    }
    SEAM(3);

    if (IN(4)) {
        { pg8::Gemm g{HBA, W_GUD, DM}; pg8::StaticOrder S; S.init(MT, 2 * FD, G, bx);
          pg8::EpiSwiGLU E{ACTD, FD, pg8::RowScale{slab1, 1}};
          pg8::gemm_phase(lds, g, S, E); }
        {
          pg8::MoeOrder S; S.mtp[0] = 0; S.mtp[1] = MT / 256;
#pragma unroll
          for (int e = 2; e <= NE; ++e) S.mtp[e] = 2 * MT / 256;
          S.nN = DM / 256; S.brows = DM; S.G = G / 2; S.c = bx >= G / 2 ? bx - G / 2 : (1 << 28);
          pg8::Gemm g{PB, W_PP, DP}; pg8::EpiBf16 E{PP, DM};
          pg8::gemm_phase(lds, g, S, E); }
    }
    SEAM(4);

    if (IN(5)) {
        pg8::Gemm g{ACTD, W_DD, FD}; pg8::StaticOrder S; S.init(MT, DM, G, bx);
        pg8::EpiResid E{HBA, nullptr};
        pg8::gemm_phase(lds, g, S, E);
    }
    SEAM(5);

    if (IN(6)) {
        pg8::Gemm g{HBA, W_PG, DM}; pg8::StaticOrder S; S.init(MT, DM, G, bx);
        pg8::EpiPLE E{HBA, PP, HBB, nullptr, slab3};
        pg8::gemm_phase(lds, g, S, E);
    }
    SEAM(6);

    if (IN(7)) {
        pg8::Gemm g{HBB, W_KVQ, DM}; pg8::StaticOrder S; S.init(MT, 3 * DM, G, bx);
        pg8::EpiQKV E{QB, (size_t)(WS_K - WS_Q) / 2, 1, pg8::RowScale{slab3, 1}};
        pg8::gemm_phase(lds, g, S, E);
    }
    SEAM(7);

    if (IN(8)) {
#if !defined(NAIVE_SB)
        static_assert(fox_body::SB_BYTES <= RING_BYTES, "attention scratch vs LDS ring");
        const fox_body::AttnTensors AT{(const fox_body::bf16*)QB, (const fox_body::bf16*)KB, (const fox_body::bf16*)VB, (fox_body::bf16*)OB, nullptr};
        const fox_body::StaticOrder S(G, bx);
        fox_body::sb_phase<fox_body::StaticOrder>((char*)lds_raw, AT, S);
        __syncthreads();
    }
#else
        const int zero = opaque_zero();
        for (int j = 0; j < 2; ++j) {
            const int it = gw + j * NGW; if (it >= NB * NH * 32) break;
            const int bh = it & 127, qq = it >> 7, qb = (j == 0) ? qq : 31 - (qq - 16);
            const int b = bh >> 4, h = bh & 15, t = qb * 64 + lane; const size_t row = (size_t)b * SEQ + t;
            float q[64], o[64];
            { const u32x4* qp = (const u32x4*)(QB + row * DM + h * HD);
#pragma unroll
              for (int c = 0; c < 8; ++c) { const u32x4 w = qp[c]; q[8 * c + 0] = bflo(w.x); q[8 * c + 1] = bfhi(w.x); q[8 * c + 2] = bflo(w.y); q[8 * c + 3] = bfhi(w.y); q[8 * c + 4] = bflo(w.z); q[8 * c + 5] = bfhi(w.z); q[8 * c + 6] = bflo(w.w); q[8 * c + 7] = bfhi(w.w); } }
#pragma unroll
            for (int d = 0; d < 64; ++d) o[d] = 0.f;
            float rem = 1.0f;
            for (int s = qb * 64 + 62; s >= 0; --s) {
                const size_t kro = ((size_t)b * SEQ + s) * DM + h * HD + zero;
                const u32x4* kp = (const u32x4*)(KB + kro); float dot = 0.f;
#pragma unroll
                for (int c = 0; c < 8; ++c) { const u32x4 w = kp[c]; dot += q[8 * c + 0] * bflo(w.x) + q[8 * c + 1] * bfhi(w.x) + q[8 * c + 2] * bflo(w.y) + q[8 * c + 3] * bfhi(w.y) + q[8 * c + 4] * bflo(w.z) + q[8 * c + 5] * bfhi(w.z) + q[8 * c + 6] * bflo(w.w) + q[8 * c + 7] * bfhi(w.w); }
                if (s < t) {
                    const float uu = __builtin_amdgcn_exp2f(dot), inv = 1.0f / (1.0f + uu), a = uu * inv * rem; rem *= inv;
                    const u32x4* vp = (const u32x4*)(VB + kro);
#pragma unroll
                    for (int c = 0; c < 8; ++c) { const u32x4 w = vp[c];
                        o[8 * c + 0] += a * bflo(w.x); o[8 * c + 1] += a * bfhi(w.x); o[8 * c + 2] += a * bflo(w.y); o[8 * c + 3] += a * bfhi(w.y);
                        o[8 * c + 4] += a * bflo(w.z); o[8 * c + 5] += a * bfhi(w.z); o[8 * c + 6] += a * bflo(w.w); o[8 * c + 7] += a * bfhi(w.w); }
                }
            }
            u32x4* op = (u32x4*)(OB + row * DM + h * HD);
#pragma unroll
            for (int c = 0; c < 8; ++c) { u32x4 w; w.x = pk2(o[8 * c + 0], o[8 * c + 1]); w.y = pk2(o[8 * c + 2], o[8 * c + 3]); w.z = pk2(o[8 * c + 4], o[8 * c + 5]); w.w = pk2(o[8 * c + 6], o[8 * c + 7]); op[c] = w; }
        }
    }
#endif
    SEAM(8);

    if (IN(9)) {
        pg8::Gemm g{OB, W_OB, DM}; pg8::StaticOrder S; S.init(MT, DM, G, bx);
        pg8::EpiResid E{HBB, nullptr};
        pg8::gemm_phase(lds, g, S, E);
    }
    SEAM(9);

    if (IN(10)) {
        LAS float* wrg = (LAS float*)lds;
        LAS int* lsel = (LAS int*)(lds + 32768);
        { const float* fn_ = ffn_norm; const float* rw_ = router_w;
          float tmp[16];
#pragma unroll
          for (int u = 0; u < 16; ++u) { const int i = tid + u * (NW * 64); tmp[u] = fn_[DM + (i >> 3)] * rw_[i]; }
#pragma unroll
          for (int u = 0; u < 16; ++u) { const int i = tid + u * (NW * 64), k = i >> 3, e = i & 7;
              wrg[((((((k >> 8) * 4 + (k & 3)) * 2 + (e >> 2)) * 64) + ((k & 255) >> 2)) << 2) + (e & 3)] = tmp[u]; } }
        const float* rb_ = router_b;
        __syncthreads();
        u32x2 vn[4];
        { const GAS u32x2* hr = (const GAS u32x2*)(HBB + (size_t)(vcu * 64 + wave * 8) * DM) + lane;
#pragma unroll
          for (int q = 0; q < 4; ++q) vn[q] = hr[64 * q]; }
        for (int j = 0; j < 8; ++j) {
            const int rl = wave * 8 + j, row = vcu * 64 + rl;
            f32x4 v[4]; float s = 0.f;
#pragma unroll
            for (int q = 0; q < 4; ++q) v[q] = (f32x4){bflo(vn[q].x), bfhi(vn[q].x), bflo(vn[q].y), bfhi(vn[q].y)};
            if (j < 7) { const GAS u32x2* hr = (const GAS u32x2*)(HBB + (size_t)(row + 1) * DM) + lane;
#pragma unroll
                for (int q = 0; q < 4; ++q) vn[q] = hr[64 * q]; }
#pragma unroll
            for (int q = 0; q < 4; ++q) s += (v[q][0] * v[q][0] + v[q][1] * v[q][1]) + (v[q][2] * v[q][2] + v[q][3] * v[q][3]);
            const float r = 1.0f / sqrtf(wave_sum(s) * (1.0f / DM) + RMS_EPS);
            float la[8];
#pragma unroll
            for (int e = 0; e < 8; ++e) la[e] = 0.f;
#pragma unroll
            for (int q = 0; q < 4; ++q)
#pragma unroll
                for (int i = 0; i < 4; ++i) { const LAS f32x4* wp = (const LAS f32x4*)wrg + ((q * 4 + i) * 2) * 64 + lane; const float xv = v[q][i]; const f32x4 w0 = wp[0], w1 = wp[64];
                    la[0] += xv * w0[0]; la[1] += xv * w0[1]; la[2] += xv * w0[2]; la[3] += xv * w0[3]; la[4] += xv * w1[0]; la[5] += xv * w1[1]; la[6] += xv * w1[2]; la[7] += xv * w1[3]; }
#pragma unroll
            for (int e = 0; e < 8; ++e) la[e] = wave_sum(la[e]) * r + rb_[e];
            int e1 = 0; float v1 = la[0];
#pragma unroll
            for (int e = 1; e < 8; ++e) if (la[e] > v1) { v1 = la[e]; e1 = e; }
            int e2 = -1; float v2 = -3.0e38f;
#pragma unroll
            for (int e = 0; e < 8; ++e) if (e != e1 && la[e] > v2) { v2 = la[e]; e2 = e; }
            if (lane == 0) { const float g1 = 1.0f / (1.0f + expf(v2 - v1)); lsel[rl] = e1 | (e2 << 8); selE[row] = e1 | (e2 << 8); selG[row] = g1; rr4[row] = r; }
        }
        __syncthreads();
        if (tid < NE) { int c = 0; for (int i = 0; i < 64; ++i) { const int se = lsel[i]; c += ((se & 255) == tid) + ((se >> 8) == tid); } __hip_atomic_store(cntwg + vcu * 8 + tid, c, RLX_AGENT); }
        __syncthreads();
    }
    SEAM(10);

    if (IN(11)) {
        volatile LAS int* L = (volatile LAS int*)(lds + 65536);
        LAS int* lsel = (LAS int*)(lds + 32768); LAS int* lpos = (LAS int*)(lds + 33024);
        moe_prefix(cntwg, vcu, L, wave, lane);
        if (tid < 64) lsel[tid] = selE[vcu * 64 + tid];
        __syncthreads();
        if (tid < 128) { const int i = tid >> 1, k = tid & 1; const int se = lsel[i]; const int e = k ? (se >> 8) : (se & 255); int rank = 0;
            for (int i2 = 0; i2 <= i; ++i2) { const int s2 = lsel[i2]; if ((s2 & 255) == e && (i2 < i || k == 1)) ++rank; if ((s2 >> 8) == e && i2 < i) ++rank; }
            const int pos = 256 * L[e] + L[32 + e] + rank; lpos[tid] = pos; tokpos[(vcu * 64 + i) * 2 + k] = pos;
            const float g1 = selG[vcu * 64 + i]; grow[pos] = k ? 1.0f - g1 : g1; }
        __syncthreads();
#pragma unroll 1
        for (int jb = 0; jb < 8; jb += 4) {
            u32x2 v[4][4]; float rq[4];
#pragma unroll
            for (int j = 0; j < 4; ++j) { const int row = vcu * 64 + wave * 8 + jb + j; rq[j] = rr4[row]; const GAS u32x2* hr = (const GAS u32x2*)(HBB + (size_t)row * DM) + lane;
#pragma unroll
                for (int q = 0; q < 4; ++q) v[j][q] = hr[64 * q]; }
#pragma unroll
            for (int j = 0; j < 4; ++j) { const int rl = wave * 8 + jb + j;
                GAS unsigned long long* d0 = (GAS unsigned long long*)(XG + (size_t)lpos[rl * 2] * DM) + lane; GAS unsigned long long* d1 = (GAS unsigned long long*)(XG + (size_t)lpos[rl * 2 + 1] * DM) + lane;
#pragma unroll
                for (int q = 0; q < 4; ++q) { const float r_ = rq[j]; const unsigned long long w = (unsigned long long)pk2(bflo(v[j][q].x) * r_, bfhi(v[j][q].x) * r_) | ((unsigned long long)pk2(bflo(v[j][q].y) * r_, bfhi(v[j][q].y) * r_) << 32); d0[64 * q] = w; d1[64 * q] = w; } }
        }
        __syncthreads();
    }
    SEAM(11);

    if (IN(12)) {
        volatile LAS int* L = (volatile LAS int*)(lds + 65536);
        moe_prefix(cntwg, vcu, L, wave, lane);
        pg8::MoeOrder S; for (int e = 0; e <= NE; ++e) S.mtp[e] = L[e]; S.nN = 2 * FE / 256; S.brows = 2 * FE; S.G = G; S.c = bx;
        __syncthreads();
        pg8::Gemm g{XG, W_GUM, DM};
        pg8::EpiSwiGLU E{ACTM, FE, pg8::RowScale{nullptr, 2}};
        pg8::gemm_phase(lds, g, S, E);
    }
    SEAM(12);

    if (IN(13)) {
        volatile LAS int* L = (volatile LAS int*)(lds + 65536);
        moe_prefix(cntwg, vcu, L, wave, lane);
        pg8::MoeOrder S; for (int e = 0; e <= NE; ++e) S.mtp[e] = L[e]; S.nN = DM / 256; S.brows = DM; S.G = G; S.c = bx;
        __syncthreads();
        pg8::Gemm g{ACTM, W_DM, FE};
        pg8::EpiMoeDown E{YB, grow};
        pg8::gemm_phase(lds, g, S, E);
    }
    SEAM(13);

    if (IN(14)) {
        {
            const int* tp_ = tokpos;
            int pc0 = 0, pc1 = 0, pn0 = 0, pn1 = 0;
            if (gw < MT) { pc0 = tp_[2 * gw]; pc1 = tp_[2 * gw + 1]; }
            if (gw + NGW < MT) { pn0 = tp_[2 * (gw + NGW)]; pn1 = tp_[2 * (gw + NGW) + 1]; }
            u32x2 hv[4], ya[4], yb[4];
            if (gw < MT) { const GAS u32x2* hr = (const GAS u32x2*)(HBB + (size_t)gw * DM) + lane; const GAS u32x2* y0 = (const GAS u32x2*)(YB + (size_t)pc0 * DM) + lane; const GAS u32x2* y1 = (const GAS u32x2*)(YB + (size_t)pc1 * DM) + lane;
#pragma unroll
                for (int q = 0; q < 4; ++q) { hv[q] = hr[64 * q]; ya[q] = y0[64 * q]; yb[q] = y1[64 * q]; } }
            for (int m = gw; m < MT; m += NGW) {
                u32x2 v[4], a[4], b[4];
#pragma unroll
                for (int q = 0; q < 4; ++q) { v[q] = hv[q]; a[q] = ya[q]; b[q] = yb[q]; }
                const int mn = m + NGW, mnn = m + 2 * NGW;
                if (mn < MT) { const GAS u32x2* hr = (const GAS u32x2*)(HBB + (size_t)mn * DM) + lane; const GAS u32x2* y0 = (const GAS u32x2*)(YB + (size_t)pn0 * DM) + lane; const GAS u32x2* y1 = (const GAS u32x2*)(YB + (size_t)pn1 * DM) + lane;
#pragma unroll
                    for (int q = 0; q < 4; ++q) { hv[q] = hr[64 * q]; ya[q] = y0[64 * q]; yb[q] = y1[64 * q]; } }
                if (mnn < MT) { pn0 = tp_[2 * mnn]; pn1 = tp_[2 * mnn + 1]; }
                GAS u32x2* hb = (GAS u32x2*)(HBA + (size_t)m * DM) + lane;
#pragma unroll
                for (int q = 0; q < 4; ++q) { u32x2 w;
                    w.x = pk2(bflo(v[q].x) + (bflo(a[q].x) + bflo(b[q].x)), bfhi(v[q].x) + (bfhi(a[q].x) + bfhi(b[q].x)));
                    w.y = pk2(bflo(v[q].y) + (bflo(a[q].y) + bflo(b[q].y)), bfhi(v[q].y) + (bfhi(a[q].y) + bfhi(b[q].y))); hb[64 * q] = w; }
            }
        }
    }
    SEAM(14);

    if (IN(15)) {
        pg8::Gemm g{HBA, W_PG + (size_t)DM * DM, DM}; pg8::StaticOrder S; S.init(MT, DM, G, bx);
        pg8::EpiPLE E{HBA, PP + (size_t)MT * DM, nullptr, hres, slab6};
        pg8::gemm_phase(lds, g, S, E);
    }
    SEAM(15);

    if (IN(16)) {
        f32x4 gn[4];
        { const float* fnm_ = final_norm;
#pragma unroll
        for (int q = 0; q < 4; ++q) gn[q] = ((const GAS f32x4*)fnm_)[lane + 64 * q]; }
        {
            f32x4 vn[4], sqn;
            if (gw < MT) { const GAS f32x4* hr = (const GAS f32x4*)(hres + (size_t)gw * DM) + lane; sqn = *(const GAS f32x4*)(slab6 + 4 * (size_t)gw);
#pragma unroll
                for (int q = 0; q < 4; ++q) vn[q] = hr[64 * q]; }
            for (int m = gw; m < MT; m += NGW) {
                f32x4 v[4]; const f32x4 sq = sqn;
#pragma unroll
                for (int q = 0; q < 4; ++q) v[q] = vn[q];
                if (m + NGW < MT) { const GAS f32x4* hr = (const GAS f32x4*)(hres + (size_t)(m + NGW) * DM) + lane; sqn = *(const GAS f32x4*)(slab6 + 4 * (size_t)(m + NGW));
#pragma unroll
                    for (int q = 0; q < 4; ++q) vn[q] = hr[64 * q]; }
                const float r = __builtin_amdgcn_rsqf(((sq[0] + sq[1]) + (sq[2] + sq[3])) * (1.0f / DM) + RMS_EPS);
                GAS f32x4* ho = (GAS f32x4*)(hres + (size_t)m * DM) + lane;
#pragma unroll
                for (int q = 0; q < 4; ++q) ho[64 * q] = v[q] * r * gn[q];
            }
        }
    }
#undef IN
#undef SEAM
}

extern "C" void kernel_launch(void* const* d_in, const int* in_sizes, int n_in, void* d_out, int out_size, void* d_ws, size_t ws_size, hipStream_t stream) {
    static int grid = 0;
    if (grid == 0) {
        if (n_in != 20 || in_sizes[0] != MT * DM || out_size != MT * DM || ws_size < WS_END) { fprintf(stderr, "kernel_launch: unexpected shapes (n_in %d, in0 %d, out %d, ws %zu < %zu)\n", n_in, n_in > 0 ? in_sizes[0] : -1, out_size, ws_size, (size_t)WS_END); grid = -1; return; }
        int dev = 0, cus = 0, per_cu = 0;
        if (hipGetDevice(&dev) != hipSuccess || hipDeviceGetAttribute(&cus, hipDeviceAttributeMultiprocessorCount, dev) != hipSuccess) { grid = -1; return; }
        if (hipFuncSetAttribute((const void*)fwd_kernel, hipFuncAttributeMaxDynamicSharedMemorySize, LDS_BYTES) != hipSuccess) { fprintf(stderr, "kernel_launch: hipFuncSetAttribute failed\n"); grid = -1; return; }
        if (hipOccupancyMaxActiveBlocksPerMultiprocessor(&per_cu, (const void*)fwd_kernel, NW * 64, LDS_BYTES) != hipSuccess || per_cu < 1) { fprintf(stderr, "kernel_launch: occupancy query says %d blocks per CU\n", per_cu); per_cu = 1; }
        (void)hipGetLastError();
        grid = cus;
        if (grid != 256) fprintf(stderr, "kernel_launch: %d CUs; this kernel is written for 256\n", grid);
    }
    if (grid < 0) return;
    if (hipMemsetAsync((char*)d_ws + WS_CTL, 0, CTL_ZERO_BYTES, stream) != hipSuccess) return;
    Args a{};
    for (int i = 0; i < 20; ++i) a.in[i] = (const float*)d_in[i];
    a.out = (float*)d_out; a.ws = (unsigned char*)d_ws; a.pad = 3;
#if defined(PROBE_REP_LO)
    a.ph_lo = 0; a.ph_hi = PROBE_REP_HI + 1; a.li = 0; hipLaunchKernelGGL(fwd_kernel, dim3(grid), dim3(NW * 64), LDS_BYTES, stream, a);
#if defined(PROBE_P0PARTS)
    a.pad = PROBE_P0PARTS;
#endif
    a.ph_lo = PROBE_REP_LO; a.ph_hi = NPH; a.li = 1; hipLaunchKernelGGL(fwd_kernel, dim3(grid), dim3(NW * 64), LDS_BYTES, stream, a);
#else
    for (int li = 0; li < N_LAUNCHES; ++li) {
        a.ph_lo = (N_LAUNCHES == NPH) ? li : 0; a.ph_hi = (N_LAUNCHES == NPH) ? li + 1 : NPH; a.li = (N_LAUNCHES == NPH) ? 0 : li;
        hipLaunchKernelGGL(fwd_kernel, dim3(grid), dim3(NW * 64), LDS_BYTES, stream, a);
    }
#endif
}
```

```cpp
#include <hip/hip_runtime.h>
#include <hip/hip_bf16.h>
#include <cstdio>
#include <cstdint>

#define LAS __attribute__((address_space(3)))
#define GAS __attribute__((address_space(1)))
typedef unsigned short bf16_t;
typedef short bf16x8 __attribute__((ext_vector_type(8)));
typedef float f32x4 __attribute__((ext_vector_type(4)));
typedef float f32x2 __attribute__((ext_vector_type(2)));
typedef unsigned u32x4 __attribute__((ext_vector_type(4)));
typedef unsigned u32x2 __attribute__((ext_vector_type(2)));

#ifndef MK_N_LAUNCHES
#define MK_N_LAUNCHES 1
#endif
constexpr int NPH = 17;
constexpr int N_LAUNCHES = MK_N_LAUNCHES;

constexpr int NB = 8, SEQ = 2048, DM = 1024, NH = 16, HD = 64, MT = NB * SEQ, FD = 2816, FE = 3584, NE = 8, DP = 256;
constexpr int NW = 8;
constexpr float RMS_EPS = 1e-6f, LOG2E = 1.4426950408889634f, C2 = 0.125f * 1.4426950408889634f;
constexpr int MOE_ROWS = 2 * MT + NE * 256;

constexpr size_t MiB = 1u << 20, KiB = 1u << 10;
constexpr size_t WS_CTL = 0, CTL_ZERO_BYTES = 1 * MiB;
constexpr size_t WS_SMALL = 1 * MiB;
constexpr size_t WS_RS0 = WS_SMALL, WS_SLAB1 = WS_SMALL + 64 * KiB, WS_SLAB3 = WS_SMALL + 320 * KiB, WS_SLAB6 = WS_SMALL + 576 * KiB;
constexpr size_t WS_LOGF = WS_SMALL + 1024 * KiB, WS_CS = WS_SMALL + 2048 * KiB, WS_CNTWG = WS_SMALL + 3072 * KiB;
constexpr size_t WS_SELE = WS_SMALL + 3136 * KiB, WS_SELG = WS_SMALL + 3200 * KiB, WS_RR4 = WS_SMALL + 3264 * KiB, WS_TOKPOS = WS_SMALL + 3328 * KiB, WS_GROW = WS_SMALL + 3456 * KiB;
constexpr size_t WS_W_IN = 8 * MiB, WS_W_OA = 14 * MiB, WS_W_KVQ = 16 * MiB, WS_W_OB = 22 * MiB, WS_W_GUD = 24 * MiB, WS_W_DD = 35 * MiB, WS_W_PP = 41 * MiB, WS_W_PG = 42 * MiB;
constexpr size_t WS_W_GUM = 46 * MiB, WS_W_DM = 158 * MiB;
constexpr size_t WS_HBA = 214 * MiB, WS_HBB = 246 * MiB, WS_PB = 278 * MiB, WS_PP = 294 * MiB, WS_XGY = 358 * MiB;
constexpr size_t WS_ARENA = 426 * MiB, WS_Q = 426 * MiB, WS_K = 458 * MiB, WS_V = 490 * MiB, WS_O = 522 * MiB, WS_ACTD = 554 * MiB, WS_ACTM = WS_ARENA;
constexpr size_t WS_END = 664 * MiB;
static_assert(WS_ACTM + (size_t)MOE_ROWS * FE * 2 <= WS_END && WS_ACTD + (size_t)MT * FD * 2 <= WS_END && WS_XGY + (size_t)MOE_ROWS * DM * 2 <= WS_ARENA, "ws map");
static_assert(WS_W_GUM + (size_t)NE * 2 * FE * DM * 2 <= WS_W_DM && WS_W_DM + (size_t)NE * DM * FE * 2 <= WS_HBA && WS_GROW + (size_t)MOE_ROWS * 4 <= WS_W_IN, "ws map 2");
constexpr int CW_BAR = 4096;
static_assert(WS_V - WS_K == WS_K - WS_Q, "Q|K|V equally spaced");

constexpr int RING_BYTES = 133120;
constexpr int LDSCTL_OFF = RING_BYTES, MISC_OFF = LDSCTL_OFF + 320;
constexpr int LDS_BYTES = 147456;
static_assert(MISC_OFF + 1024 <= LDS_BYTES, "lds map");

typedef GAS unsigned gu32;
#define RLX_AGENT __ATOMIC_RELAXED, __HIP_MEMORY_SCOPE_AGENT
#define LDS_WAIT() asm volatile("s_waitcnt lgkmcnt(0)" ::: "memory")
#define VM_WAIT() asm volatile("s_waitcnt vmcnt(0)" ::: "memory")
__device__ __forceinline__ unsigned f2bf(float f) { unsigned u = __builtin_bit_cast(unsigned, f); return (u + 0x7fffu + ((u >> 16) & 1u)) >> 16; }
typedef __bf16 bf16x2_t __attribute__((ext_vector_type(2)));
__device__ __forceinline__ unsigned pk2(float lo, float hi) { const f32x2 v = {lo, hi}; return __builtin_bit_cast(unsigned, __builtin_convertvector(v, bf16x2_t)); }
__device__ __forceinline__ float bflo(unsigned w) { return __builtin_bit_cast(float, w << 16); }
__device__ __forceinline__ float bfhi(unsigned w) { return __builtin_bit_cast(float, w & 0xffff0000u); }
__device__ __forceinline__ float wave_sum(float v) {
    v += __builtin_bit_cast(float, __builtin_amdgcn_update_dpp(0, __builtin_bit_cast(int, v), 0xB1, 0xf, 0xf, true));
    v += __builtin_bit_cast(float, __builtin_amdgcn_update_dpp(0, __builtin_bit_cast(int, v), 0x4E, 0xf, 0xf, true));
    v += __builtin_bit_cast(float, __builtin_amdgcn_update_dpp(0, __builtin_bit_cast(int, v), 0x141, 0xf, 0xf, true));
    v += __builtin_bit_cast(float, __builtin_amdgcn_update_dpp(0, __builtin_bit_cast(int, v), 0x140, 0xf, 0xf, true));
    v += __builtin_bit_cast(float, __builtin_amdgcn_update_dpp(0, __builtin_bit_cast(int, v), 0x142, 0xa, 0xf, false));
    v += __builtin_bit_cast(float, __builtin_amdgcn_update_dpp(0, __builtin_bit_cast(int, v), 0x143, 0xc, 0xf, false));
    return __builtin_bit_cast(float, __builtin_amdgcn_readlane(__builtin_bit_cast(int, v), 63));
}
__device__ __forceinline__ int opaque_zero() { int z; asm volatile("v_mov_b32 %0, 0" : "=v"(z)); return z; }

#define XB_TMO      128
#define XB_XCNT(j)  (256  + 64 * (j))
#define XB_XSUB(j)  (1280 + 64 * (j))
#define XB_XGEN(j)  (2304 + 64 * (j))
#define XB_TOP      3328
#define XB_TOPGEN   3392
#define XCD_BAR_WORDS 3456
#define XB_SPIN_CAP (1u << 20)
__device__ __forceinline__ unsigned xb_ld(unsigned* p)              { return __hip_atomic_load(p, __ATOMIC_RELAXED, __HIP_MEMORY_SCOPE_AGENT); }
__device__ __forceinline__ unsigned xb_add(unsigned* p, unsigned v) { return __hip_atomic_fetch_add(p, v, __ATOMIC_RELAXED, __HIP_MEMORY_SCOPE_AGENT); }
__device__ __forceinline__ unsigned xb_xcc_id() { return (unsigned)__builtin_amdgcn_s_getreg((3 << 11) | 20) & 0xFu; }
#define XB_SPIN(cond, bar) do { unsigned _sp = 0; while (cond) { __builtin_amdgcn_s_sleep(1); \
    if ((++_sp & 255u) == 0u) { if (xb_ld(&(bar)[XB_TMO])) break; if (_sp > XB_SPIN_CAP) { atomicAdd(&(bar)[XB_TMO], 1u); break; } } } } while (0)
struct XcdBarrier { unsigned* bar; unsigned x; volatile LAS unsigned* st; };
__device__ __forceinline__ XcdBarrier xcd_barrier_post(unsigned* bar, volatile LAS unsigned* st) {
    XcdBarrier b; b.bar = bar; b.x = xb_xcc_id(); b.st = st;
    if (threadIdx.x == 0) (void)xb_add(&bar[XB_XCNT(b.x)], 1u);
    return b;
}
__device__ __forceinline__ void xcd_barrier_complete(unsigned* bar, unsigned x, unsigned& nloc, unsigned& nx) {
    const unsigned G = gridDim.x * gridDim.y * gridDim.z;
    unsigned sum, cnt, mine, sp = 0u;
    for (;;) {
        sum = 0u; cnt = 0u; mine = 0u;
#pragma unroll
        for (unsigned j = 0; j < 16; ++j) { const unsigned c = xb_ld(&bar[XB_XCNT(j)]); sum += c; cnt += (c > 0u) ? 1u : 0u; mine = (j == x) ? c : mine; }
        if (sum == G) break;
        __builtin_amdgcn_s_sleep(1);
        if ((++sp & 255u) == 0u) { if (xb_ld(&bar[XB_TMO])) break; if (sp > XB_SPIN_CAP) { atomicAdd(&bar[XB_TMO], 1u); break; } }
    }
    nloc = mine > 0u ? mine : 1u; nx = cnt > 0u ? cnt : 1u;
}
__device__ __forceinline__ void xcd_barrier(const XcdBarrier& b) {
    asm volatile("s_waitcnt vmcnt(0)" ::: "memory");
    __syncthreads();
    if (threadIdx.x == 0) {
        unsigned* bar = b.bar;
        __builtin_amdgcn_s_waitcnt(0);
        unsigned nloc = b.st[0], nx = b.st[1];
        if (nloc == 0u) { xcd_barrier_complete(bar, b.x, nloc, nx); b.st[0] = nloc; b.st[1] = nx; }
        const unsigned old = xb_add(&bar[XB_XSUB(b.x)], 1u);
        const unsigned gen = old / nloc;
        if (old + 1u == (gen + 1u) * nloc) {
            __builtin_amdgcn_fence(__ATOMIC_RELEASE, "agent");
            asm volatile("s_waitcnt vmcnt(0)" ::: "memory");
            const unsigned og = xb_add(&bar[XB_TOP], 1u);
            const unsigned tg = og / nx;
            if (og + 1u == (tg + 1u) * nx) xb_add(&bar[XB_TOPGEN], 1u);
            else XB_SPIN(xb_ld(&bar[XB_TOPGEN]) == tg, bar);
            __builtin_amdgcn_fence(__ATOMIC_ACQUIRE, "agent");
            xb_add(&bar[XB_XGEN(b.x)], 1u);
            asm volatile("s_waitcnt vmcnt(0)" ::: "memory");
        } else {
            XB_SPIN(xb_ld(&bar[XB_XGEN(b.x)]) == gen, bar);
            __builtin_amdgcn_fence(__ATOMIC_ACQUIRE, "agent");
            asm volatile("s_waitcnt vmcnt(0)" ::: "memory");
        }
    }
    __syncthreads();
}

namespace pg8 {
constexpr int BM = 256, BK = 64, HALF = 128, NXCD = 8, WGM = 8;
__host__ __device__ __forceinline__ int perm32(int rho) { const int n = rho >> 4, i = rho & 15; return 8 * (i >> 2) + 4 * n + (i & 3); }
struct Unit { int arow, brow, orow, ocol; };
struct Gemm { const bf16_t* A; const bf16_t* Bt; int K; };

__device__ __forceinline__ bool order_map(long L, int nM, int nN, int& pm, int& pn) {
    const int nwg = nM * nN; if (L >= nwg) return false;
    int wgid = (int)L; { const int q = nwg / NXCD, r = nwg % NXCD, xcd = wgid % NXCD, off = wgid / NXCD; wgid = (xcd < r ? xcd * (q + 1) : r * (q + 1) + (xcd - r) * q) + off; }
    const int nig = WGM * nN, gid = wgid / nig, fm = gid * WGM, gsz = (nM - fm) < WGM ? (nM - fm) : WGM;
    pm = fm + ((wgid % nig) % gsz); pn = (wgid % nig) / gsz; return true;
}
struct StaticOrder {
    int nM, nN, G, c;
    __device__ void init(int M, int N, int G_, int c_) { nM = M / BM; nN = N / BM; G = G_; c = c_; }
    __device__ __forceinline__ bool next(int i, Unit& u) const {
        int pm, pn; if (!order_map((long)i * G + c, nM, nN, pm, pn)) return false;
        u.arow = pm * BM; u.brow = pn * BM; u.orow = pm * BM; u.ocol = pn; return true;
    }
};
struct MoeOrder {
    int mtp[NE + 1]; int nN, brows, G, c;
    __device__ __forceinline__ bool next(int i, Unit& u) const {
        int pm, pn; if (!order_map((long)i * G + c, mtp[NE], nN, pm, pn)) return false;
        int e = 0;
#pragma unroll
        for (int j = 1; j < NE; ++j) e += (pm >= mtp[j]) ? 1 : 0;
        u.arow = pm * BM; u.orow = pm * BM; u.brow = e * brows + pn * BM; u.ocol = pn; return true;
    }
};

struct RowScale {
    const float* p; int mode;
    __device__ __forceinline__ float get(int row) const {
        if (mode == 0) return p[row];
        if (mode == 1) { const f32x4 q = *(const f32x4*)(p + 4 * (size_t)row); return __builtin_amdgcn_rsqf(((q[0] + q[1]) + (q[2] + q[3])) * (1.0f / DM) + RMS_EPS); }
        return 1.0f;
    }
};
struct EpiQKV {
    static constexpr bool PERM = true, AFTER_DRAIN = false;
    bf16_t* base; size_t stride; int rot; RowScale R;
    __device__ __forceinline__ void operator()(const f32x4 (&acc)[2][4][2], int ai, const Unit& u, int wr, int wc, int fr, int fq) const {
        int d = (u.ocol >> 2) + rot; d = d >= 3 ? d - 3 : d; bf16_t* ob = base + (size_t)d * stride; const float sc = d == 0 ? C2 : 1.0f;
        const int col0 = (u.ocol & 3) * BM + wc * 32 + 8 * fq;
#pragma unroll
            for (int m = 0; m < 4; ++m) { const int row = u.orow + ai * HALF + wr * 64 + m * 16 + fr; const float rr = R.get(row) * sc; bf16_t* rowp = ob + (size_t)row * DM + col0;
#pragma unroll
                for (int bj = 0; bj < 2; ++bj) { const f32x4 v0 = acc[bj][m][0] * rr, v1 = acc[bj][m][1] * rr;
                    u32x4 w; w.x = pk2(v0[0], v0[1]); w.y = pk2(v0[2], v0[3]); w.z = pk2(v1[0], v1[1]); w.w = pk2(v1[2], v1[3]);
                    *(u32x4*)(rowp + bj * HALF) = w; } }
    }
};
struct EpiBf16 {
    static constexpr bool PERM = true, AFTER_DRAIN = false;
    bf16_t* O; int ldo;
    __device__ __forceinline__ void operator()(const f32x4 (&acc)[2][4][2], int ai, const Unit& u, int wr, int wc, int fr, int fq) const {
        const int col0 = u.ocol * BM + wc * 32 + 8 * fq;
#pragma unroll
            for (int m = 0; m < 4; ++m) { const int row = u.orow + ai * HALF + wr * 64 + m * 16 + fr; bf16_t* rowp = O + (size_t)row * ldo + col0;
#pragma unroll
                for (int bj = 0; bj < 2; ++bj) { const f32x4 v0 = acc[bj][m][0], v1 = acc[bj][m][1];
                    u32x4 w; w.x = pk2(v0[0], v0[1]); w.y = pk2(v0[2], v0[3]); w.z = pk2(v1[0], v1[1]); w.w = pk2(v1[2], v1[3]);
                    *(u32x4*)(rowp + bj * HALF) = w; } }
    }
};
struct EpiSwiGLU {
    static constexpr bool PERM = true, AFTER_DRAIN = false;
    bf16_t* O; int ldo; RowScale R;
    __device__ __forceinline__ void operator()(const f32x4 (&acc)[2][4][2], int ai, const Unit& u, int wr, int wc, int fr, int fq) const {
        const int col0 = u.ocol * HALF + wc * 32 + 8 * fq;
#pragma unroll
            for (int m = 0; m < 4; ++m) { const int row = u.orow + ai * HALF + wr * 64 + m * 16 + fr; const float rr = R.get(row); float o[8];
#pragma unroll
                for (int n = 0; n < 2; ++n)
#pragma unroll
                    for (int j = 0; j < 4; ++j) { const float g = acc[0][m][n][j] * rr, uu = acc[1][m][n][j] * rr;
                        o[n * 4 + j] = g * __builtin_amdgcn_rcpf(1.0f + __builtin_amdgcn_exp2f(-g * LOG2E)) * uu; }
                u32x4 w; w.x = pk2(o[0], o[1]); w.y = pk2(o[2], o[3]); w.z = pk2(o[4], o[5]); w.w = pk2(o[6], o[7]);
                *(u32x4*)(O + (size_t)row * ldo + col0) = w; asm volatile("" ::: "memory"); }
    }
};
struct EpiMoeDown {
    static constexpr bool PERM = true, AFTER_DRAIN = false;
    bf16_t* O; const float* gate;
    __device__ __forceinline__ void operator()(const f32x4 (&acc)[2][4][2], int ai, const Unit& u, int wr, int wc, int fr, int fq) const {
        const int col0 = u.ocol * BM + wc * 32 + 8 * fq;
#pragma unroll
            for (int m = 0; m < 4; ++m) { const int row = u.orow + ai * HALF + wr * 64 + m * 16 + fr; const float gt = gate[row]; bf16_t* rowp = O + (size_t)row * DM + col0;
#pragma unroll
                for (int bj = 0; bj < 2; ++bj) { const f32x4 v0 = acc[bj][m][0] * gt, v1 = acc[bj][m][1] * gt;
                    u32x4 w; w.x = pk2(v0[0], v0[1]); w.y = pk2(v0[2], v0[3]); w.z = pk2(v1[0], v1[1]); w.w = pk2(v1[2], v1[3]);
                    *(u32x4*)(rowp + bj * HALF) = w; } }
    }
};
__device__ __forceinline__ void row_sumsq_to_slab(const f32x4 (&v)[2][4][2], int ai, const Unit& u, int wr, int wc, int fr, int fq, LAS unsigned char* lds, float* slab) {
    LAS float* P = (LAS float*)lds;
#pragma unroll
    for (int m = 0; m < 4; ++m) { float s = 0.f;
#pragma unroll
        for (int bj = 0; bj < 2; ++bj)
#pragma unroll
            for (int n = 0; n < 2; ++n) { const f32x4 x = v[bj][m][n]; s += (x[0] * x[0] + x[1] * x[1]) + (x[2] * x[2] + x[3] * x[3]); }
        s += __shfl_xor(s, 16); s += __shfl_xor(s, 32);
        if (fq == 0) P[(wr * 64 + m * 16 + fr) * 4 + wc] = s; }
    __syncthreads();
    const int t = threadIdx.x;
    if (t < HALF) slab[(size_t)(u.orow + ai * HALF + t) * 4 + u.ocol] = (P[t * 4 + 0] + P[t * 4 + 1]) + (P[t * 4 + 2] + P[t * 4 + 3]);
    __syncthreads();
}
__device__ __forceinline__ void unpack8(const u32x4 w, f32x4& lo, f32x4& hi) { lo = (f32x4){bflo(w.x), bfhi(w.x), bflo(w.y), bfhi(w.y)}; hi = (f32x4){bflo(w.z), bfhi(w.z), bflo(w.w), bfhi(w.w)}; }
__device__ __forceinline__ u32x4 pack8(const f32x4 lo, const f32x4 hi) { u32x4 w; w.x = pk2(lo[0], lo[1]); w.y = pk2(lo[2], lo[3]); w.z = pk2(hi[0], hi[1]); w.w = pk2(hi[2], hi[3]); return w; }
struct EpiResid {
    static constexpr bool PERM = true, AFTER_DRAIN = true;
    bf16_t* hb; float* slab;
    __device__ __forceinline__ void fused(f32x4 (&acc)[2][4][2], int ai, const Unit& u, int wr, int wc, int fr, int fq, LAS unsigned char* lds) const {
        const int col0 = u.ocol * BM + wc * 32 + 8 * fq;
#pragma unroll
        for (int m = 0; m < 4; ++m) { bf16_t* rowp = hb + (size_t)(u.orow + ai * HALF + wr * 64 + m * 16 + fr) * DM + col0;
#pragma unroll
            for (int bj = 0; bj < 2; ++bj) { f32x4 lo, hi; unpack8(*(const u32x4*)(rowp + bj * HALF), lo, hi); lo += acc[bj][m][0]; hi += acc[bj][m][1];
                acc[bj][m][0] = lo; acc[bj][m][1] = hi; *(u32x4*)(rowp + bj * HALF) = pack8(lo, hi); }
            if (m & 1) asm volatile("" ::: "memory"); }
        if (slab) row_sumsq_to_slab(acc, ai, u, wr, wc, fr, fq, lds, slab);
    }
};
struct EpiPLE {
    static constexpr bool PERM = true, AFTER_DRAIN = true;
    const bf16_t* hin; const bf16_t* pp; bf16_t* hout; float* out32; float* slab;
    __device__ __forceinline__ void fused(f32x4 (&acc)[2][4][2], int ai, const Unit& u, int wr, int wc, int fr, int fq, LAS unsigned char* lds) const {
        const int col0 = u.ocol * BM + wc * 32 + 8 * fq;
#pragma unroll
        for (int m = 0; m < 4; ++m) { const size_t off = (size_t)(u.orow + ai * HALF + wr * 64 + m * 16 + fr) * DM + col0;
#pragma unroll
            for (int bj = 0; bj < 2; ++bj) { const size_t o2 = off + bj * HALF; f32x4 hl, hh, pl, ph; unpack8(*(const u32x4*)(hin + o2), hl, hh); unpack8(*(const u32x4*)(pp + o2), pl, ph);
                const f32x4 a0 = acc[bj][m][0], a1 = acc[bj][m][1];
#pragma unroll
                for (int j = 0; j < 4; ++j) { hl[j] += pl[j] * __builtin_amdgcn_rcpf(1.0f + __builtin_amdgcn_exp2f(-a0[j] * LOG2E)); hh[j] += ph[j] * __builtin_amdgcn_rcpf(1.0f + __builtin_amdgcn_exp2f(-a1[j] * LOG2E)); }
                acc[bj][m][0] = hl; acc[bj][m][1] = hh;
                if (out32) { *(f32x4*)(out32 + o2) = hl; *(f32x4*)(out32 + o2 + 4) = hh; } else *(u32x4*)(hout + o2) = pack8(hl, hh); }
            if (m & 1) asm volatile("" ::: "memory"); }
        if (slab) row_sumsq_to_slab(acc, ai, u, wr, wc, fr, fq, lds, slab);
    }
};

template <class Epi, class Sched>
__device__ __forceinline__ void gemm_simple(LAS unsigned char* lds, const Gemm g, const Sched& S, const Epi& E) {
    const int tid = threadIdx.x, wid = __builtin_amdgcn_readfirstlane(tid >> 6), lane = tid & 63, wr = wid >> 2, wc = wid & 3, fr = lane & 15, fq = lane >> 4;
    const int K = g.K, nt = K / BK;
    Unit u;
    for (int i = 0; S.next(i, u); ++i) {
        const int br0 = Epi::PERM ? perm32(fr) : fr, br1 = Epi::PERM ? perm32(16 + fr) : 16 + fr;
        const bf16_t* Bb = g.Bt + (size_t)(u.brow + wc * 32) * K + fq * 8;
#pragma unroll 1
        for (int ai = 0; ai < 2; ++ai) {
            f32x4 acc[2][4][2];
#pragma unroll
            for (int b = 0; b < 2; ++b)
#pragma unroll
                for (int m = 0; m < 4; ++m)
#pragma unroll
                    for (int n = 0; n < 2; ++n) acc[b][m][n] = (f32x4){0.f, 0.f, 0.f, 0.f};
            const bf16_t* Ab = g.A + (size_t)(u.arow + ai * HALF + wr * 64 + fr) * K + fq * 8;
#pragma unroll 1
            for (int t = 0; t < nt; ++t) {
                bf16x8 Af[4][2];
#pragma unroll
                for (int m = 0; m < 4; ++m)
#pragma unroll
                    for (int k = 0; k < 2; ++k) Af[m][k] = *(const bf16x8*)(Ab + (size_t)(m * 16) * K + t * BK + k * 32);
#pragma unroll
                for (int bj = 0; bj < 2; ++bj) {
                    bf16x8 Bf[2][2];
#pragma unroll
                    for (int k = 0; k < 2; ++k) { Bf[0][k] = *(const bf16x8*)(Bb + (size_t)(bj * HALF + br0) * K + t * BK + k * 32); Bf[1][k] = *(const bf16x8*)(Bb + (size_t)(bj * HALF + br1) * K + t * BK + k * 32); }
#pragma unroll
                    for (int m = 0; m < 4; ++m)
#pragma unroll
                        for (int n = 0; n < 2; ++n)
#pragma unroll
                            for (int k = 0; k < 2; ++k) acc[bj][m][n] = __builtin_amdgcn_mfma_f32_16x16x32_bf16(Bf[n][k], Af[m][k], acc[bj][m][n], 0, 0, 0);
                }
            }
            if constexpr (Epi::AFTER_DRAIN) { __syncthreads(); E.fused(acc, ai, u, wr, wc, fr, fq, lds); }
            else E(acc, ai, u, wr, wc, fr, fq);
        }
    }
}

constexpr int HTB = HALF * BK * 2  , STAGE_BYTES = 8 * HTB;
__host__ __device__ __forceinline__ int lds_byte(int r, int c) { const int st = (r >> 4) * 2 + (c >> 5), rr = r & 15, cc = c & 31, ob = rr * 64 + cc * 2; return st * 1024 + (ob ^ (((ob >> 9) & 1) << 5)); }
__host__ __device__ __forceinline__ void stage_rc(int b, int& R, int& C) { const int st = b / 1024, sb = b % 1024, swz = sb ^ (((sb >> 9) & 1) << 5); R = (st >> 1) * 16 + swz / 64; C = (st & 1) * 32 + (swz % 64) / 2; }
typedef int v8i32 __attribute__((ext_vector_type(8)));
template <class Epi, class Sched, bool ALIGN_EPI, bool FP8 = false>
__device__ __forceinline__ void gemm_fast(LAS unsigned char* lds, const Gemm g, const Sched& S, const Epi& E) {
    const int tid = threadIdx.x, wid = __builtin_amdgcn_readfirstlane(tid >> 6), lane = tid & 63, wr = wid >> 2, wc = wid & 3, fr = lane & 15, fq = lane >> 4;
    int K_ = g.K; asm volatile("" : "+s"(K_));
    const int K = K_, nt = K / BK;
    unsigned voffA[2], voffB[2];
#pragma unroll
    for (int i = 0; i < 2; ++i) { int R, C; stage_rc(tid * 16 + i * 8192, R, C); const int Rb = Epi::PERM ? ((R & ~31) + perm32(R & 31)) : R;
        voffA[i] = (unsigned)(R * K + C) * 2u; voffB[i] = (unsigned)(Rb * K + C) * 2u; }
    const size_t kstep = (size_t)(BK * 2);
    const size_t hstep = (size_t)HALF * K * 2;
    const size_t rstep = (size_t)K * 2;
    const unsigned ldsw = (unsigned)wid * 1024u;
    const int aoff = FP8 ? lds_byte(wr * 64 + fr, fq * 16) : lds_byte(wr * 64 + fr, fq * 8), boff = FP8 ? lds_byte(wc * 32 + fr, fq * 16) : lds_byte(wc * 32 + fr, fq * 8);

#define PG8_SA(b, h) (((b) * 2 + (h)) * HTB)
#define PG8_SB(b, h) ((4 + (b) * 2 + (h)) * HTB)
#define PG8_STAGE(bufoff, gbase, voff) do { _Pragma("unroll") for (int _i = 0; _i < 2; ++_i) \
        __builtin_amdgcn_global_load_lds((const unsigned*)((const char*)(gbase) + (voff)[_i]), (LAS unsigned*)(lds + (bufoff) + ldsw + _i * 8192), 16, 0, 0); } while (0)
#define PG8_LD8(addr) __builtin_bit_cast(v8i32, __builtin_shufflevector(*(const LAS u32x4*)(addr), *(const LAS u32x4*)((addr) + 16), 0, 1, 2, 3, 4, 5, 6, 7))
#define PG8_LDA(dst, b, h) do { if constexpr (FP8) { _Pragma("unroll") for (int m = 0; m < 4; ++m) dst##8[m] = PG8_LD8(lds + PG8_SA(b, h) + aoff + m * 2048); } \
        else { _Pragma("unroll") for (int m = 0; m < 4; ++m) _Pragma("unroll") for (int k = 0; k < 2; ++k) dst[FP8 ? 0 : m][k] = *(const LAS bf16x8*)(lds + PG8_SA(b, h) + aoff + m * 2048 + k * 1024); } } while (0)
#define PG8_LDB(dst, b, h) do { if constexpr (FP8) { _Pragma("unroll") for (int n = 0; n < 2; ++n) dst##8[n] = PG8_LD8(lds + PG8_SB(b, h) + boff + n * 2048); } \
        else { _Pragma("unroll") for (int n = 0; n < 2; ++n) _Pragma("unroll") for (int k = 0; k < 2; ++k) dst[FP8 ? 0 : n][k] = *(const LAS bf16x8*)(lds + PG8_SB(b, h) + boff + n * 2048 + k * 1024); } } while (0)
#define PG8_MMA(ai, bj, At, Bt) do { __builtin_amdgcn_s_setprio(1); _Pragma("unroll") for (int m = 0; m < 4; ++m) _Pragma("unroll") for (int n = 0; n < 2; ++n) { \
        if constexpr (FP8) asm volatile("v_mfma_scale_f32_16x16x128_f8f6f4 %0, %1, %2, %0, %3, %4 op_sel_hi:[0,0,0]" : "+v"(acc[ai][bj][m][n]) : "v"(Bt##8[n]), "v"(At##8[m]), "v"(sclW), "v"(sclX));   \
        else { _Pragma("unroll") for (int k = 0; k < 2; ++k) acc[ai][bj][m][n] = __builtin_amdgcn_mfma_f32_16x16x32_bf16(Bt[FP8 ? 0 : n][k], At[FP8 ? 0 : m][k], acc[ai][bj][m][n], 0, 0, 0); } } __builtin_amdgcn_s_setprio(0); } while (0)
#define PG8_WAIT_V(n) asm volatile("s_waitcnt vmcnt(" #n ")" ::: "memory")
#define PG8_WAIT_L(n) asm volatile("s_waitcnt lgkmcnt(" #n ")" ::: "memory")
#define PG8_BAR __builtin_amdgcn_s_barrier()
#define PG8_SCHED __builtin_amdgcn_sched_barrier(0)
    Unit cur, nxt; int ui = 0;
    if (!S.next(0, cur)) return;
    f32x4 acc[2][2][4][2];
#pragma unroll
    for (int a = 0; a < 2; ++a)
#pragma unroll
        for (int b = 0; b < 2; ++b)
#pragma unroll
            for (int m = 0; m < 4; ++m)
#pragma unroll
                for (int n = 0; n < 2; ++n) acc[a][b][m][n] = (f32x4){0.f, 0.f, 0.f, 0.f};
    int sclW = 0x7A7A7A7A, sclX = 0x7F7F7F7F; if constexpr (FP8) asm volatile("" : "+v"(sclW), "+v"(sclX));
    bf16x8 At[FP8 ? 1 : 4][2], B0[FP8 ? 1 : 2][2], B1[FP8 ? 1 : 2][2];
    v8i32 At8[FP8 ? 4 : 1], B08[FP8 ? 2 : 1], B18[FP8 ? 2 : 1];
    const char* cA = (const char*)g.A + (size_t)cur.arow * rstep; const char* cB = (const char*)g.Bt + (size_t)cur.brow * rstep;
    PG8_STAGE(PG8_SB(0, 0), cB, voffB); PG8_STAGE(PG8_SB(0, 1), cB + hstep, voffB); PG8_STAGE(PG8_SA(0, 0), cA, voffA); PG8_STAGE(PG8_SA(0, 1), cA + hstep, voffA);
    if (wr == 1) PG8_BAR;
    PG8_WAIT_V(2); PG8_BAR;
    PG8_STAGE(PG8_SB(1, 0), cB + kstep, voffB); PG8_STAGE(PG8_SA(1, 0), cA + kstep, voffA); PG8_STAGE(PG8_SB(1, 1), cB + hstep + kstep, voffB);
    PG8_WAIT_V(6); PG8_BAR;
    for (;;) {
        const bool has_next = S.next(ui + 1, nxt);
        const char* nA = has_next ? (const char*)g.A + (size_t)nxt.arow * rstep : cA; const char* nB = has_next ? (const char*)g.Bt + (size_t)nxt.brow * rstep : cB;
        for (int t = 0; t < nt; t += 2) {
            const bool last = (t == nt - 2);
            const char* a1 = cA + (size_t)(t + 1) * kstep;
            const char* a2 = last ? nA : cA + (size_t)(t + 2) * kstep; const char* b2 = last ? nB : cB + (size_t)(t + 2) * kstep;
            const char* a3 = a2 + kstep; const char* b3 = b2 + kstep;
            PG8_LDB(B0, 0, 0); PG8_LDB(B1, 0, 1); PG8_SCHED; PG8_LDA(At, 0, 0); PG8_STAGE(PG8_SA(1, 1), a1 + hstep, voffA);
            PG8_WAIT_V(8); PG8_WAIT_L(0); PG8_BAR; PG8_MMA(0, 0, At, B0); PG8_MMA(0, 1, At, B1); PG8_BAR; PG8_SCHED;
            PG8_LDA(At, 0, 1); PG8_STAGE(PG8_SB(0, 0), b2, voffB); PG8_STAGE(PG8_SB(0, 1), b2 + hstep, voffB); PG8_STAGE(PG8_SA(0, 0), a2, voffA);
            PG8_WAIT_V(8); PG8_WAIT_L(0); PG8_BAR; PG8_MMA(1, 0, At, B0); PG8_MMA(1, 1, At, B1); PG8_BAR; PG8_SCHED;
            PG8_LDB(B0, 1, 0); PG8_LDB(B1, 1, 1); PG8_SCHED; PG8_LDA(At, 1, 0); PG8_STAGE(PG8_SA(0, 1), a2 + hstep, voffA);
            PG8_WAIT_V(8); PG8_WAIT_L(0); PG8_BAR; PG8_MMA(0, 0, At, B0); PG8_MMA(0, 1, At, B1); PG8_BAR; PG8_SCHED;
            PG8_LDA(At, 1, 1); PG8_STAGE(PG8_SB(1, 0), b3, voffB); PG8_STAGE(PG8_SB(1, 1), b3 + hstep, voffB); PG8_STAGE(PG8_SA(1, 0), a3, voffA);
            PG8_WAIT_V(8); PG8_WAIT_L(0); PG8_BAR; PG8_MMA(1, 0, At, B0); PG8_MMA(1, 1, At, B1); PG8_BAR; PG8_SCHED;
        }
        if constexpr (ALIGN_EPI) { if (wr == 0) PG8_BAR; }
        if constexpr (FP8) asm volatile("s_nop 15\n\ts_nop 15" ::: "memory");
        if constexpr (!Epi::AFTER_DRAIN) { E(acc[0], 0, cur, wr, wc, fr, fq); E(acc[1], 1, cur, wr, wc, fr, fq); }
        if (!has_next) break;
#pragma unroll
        for (int a = 0; a < 2; ++a)
#pragma unroll
            for (int b = 0; b < 2; ++b)
#pragma unroll
                for (int m = 0; m < 4; ++m)
#pragma unroll
                    for (int n = 0; n < 2; ++n) acc[a][b][m][n] = (f32x4){0.f, 0.f, 0.f, 0.f};
        cur = nxt; cA = nA; cB = nB; ++ui;
        if constexpr (ALIGN_EPI) { if (wr == 1) PG8_BAR; }
    }
    PG8_WAIT_V(0);
    if constexpr (!ALIGN_EPI) { if (wr == 0) PG8_BAR; }
    PG8_BAR;
    if constexpr (Epi::AFTER_DRAIN) { E.fused(acc[0], 0, cur, wr, wc, fr, fq, lds); E.fused(acc[1], 1, cur, wr, wc, fr, fq, lds); }
#undef PG8_SA
#undef PG8_SB
#undef PG8_STAGE
#undef PG8_LDA
#undef PG8_LDB
#undef PG8_MMA
#undef PG8_LD8
#undef PG8_WAIT_V
#undef PG8_WAIT_L
#undef PG8_BAR
#undef PG8_SCHED
}
template <class Epi, class Sched>
__device__ __forceinline__ void gemm_phase(LAS unsigned char* lds, const Gemm g, const Sched& S, const Epi& E) {
#if defined(SIMPLE_GEMM)
    gemm_simple(lds, g, S, E);
#else
    gemm_fast<Epi, Sched, !Epi::AFTER_DRAIN>(lds, g, S, E);
    __syncthreads();
#endif
}
template <class Epi, class Sched>
__device__ __forceinline__ void gemm_phase_fp8(LAS unsigned char* lds, const Gemm g, const Sched& S, const Epi& E) {
    gemm_fast<Epi, Sched, !Epi::AFTER_DRAIN, true>(lds, g, S, E);
    __syncthreads();
}
}

namespace fox_body {
using bf16=__hip_bfloat16;
using bf16x8=__attribute__((ext_vector_type(8)))short;
using s16x4=__attribute__((ext_vector_type(4)))short;
using f32x16=__attribute__((ext_vector_type(16)))float;
using u32x4=__attribute__((ext_vector_type(4)))unsigned;
using f32x4v=__attribute__((ext_vector_type(4)))float;
constexpr int BATCH=8,NHEAD=16,SEQ=2048,D=64,DM=NHEAD*D;
constexpr int NW=8,QBLK=32,QB=QBLK*NW,KVBLK=64,NQB=SEQ/QB;
constexpr int ATTN_PITCH=DM, ATTN_UNIT_ROWS=QB;
__device__ __forceinline__ int crow(int r,int hi){return (r&3)+8*(r>>2)+4*hi;}
#define SBAR() __builtin_amdgcn_sched_barrier(0)
__device__ __forceinline__ void cmask(f32x16&p0,f32x16&p1,int jb,int qrel,int hi){
  const float NEG=-INFINITY; int kb=64*jb+4*hi;
  #pragma unroll
  for(int r=0;r<16;++r){int kv=kb+(r&3)+8*(r>>2); if(kv>qrel)p0[r]=NEG; if(kv+32>qrel)p1[r]=NEG;}
}

constexpr int NSLOT=3, SLOTB=8192;
constexpr int LDS_K=0, LDS_V=NSLOT*SLOTB, LDS_WS=2*NSLOT*SLOTB, LDS_OST=LDS_WS+NW*64*4, LDS_CS=LDS_OST+NW*4096, LDS_BYTES=LDS_CS+SEQ*4;
constexpr float C2=0.125f*1.4426950408889634f;
__device__ __forceinline__ void glds16(const void*gsrc,unsigned lds_dst){unsigned keep;
  asm volatile("s_mov_b32 %0, m0\n\ts_mov_b32 m0, %2\n\ts_nop 0\n\tglobal_load_lds_dwordx4 %1, off\n\ts_mov_b32 m0, %0":"=&s"(keep):"v"(gsrc),"s"(lds_dst):"memory");}
__device__ __forceinline__ float max3f(float a,float b,float c){float r;asm("v_max3_f32 %0, %1, %2, %3":"=v"(r):"v"(a),"v"(b),"v"(c));return r;}
__device__ __forceinline__ float max2f(float a,float b){float r;asm("v_max_f32_e32 %0, %1, %2":"=v"(r):"v"(a),"v"(b));return r;}
__device__ __forceinline__ float fadd_s(float a,float b){float r;asm("v_add_f32_e32 %0, %1, %2":"=v"(r):"v"(a),"v"(b));return r;}
__device__ __forceinline__ float fsub_s(float a,float b){float r;asm("v_sub_f32_e32 %0, %1, %2":"=v"(r):"v"(a),"v"(b));return r;}
typedef float f32x2_t __attribute__((ext_vector_type(2))); typedef __bf16 bf16x2_t __attribute__((ext_vector_type(2)));
__device__ __forceinline__ unsigned cvtpk_s(float lo,float hi){f32x2_t v={lo,hi};bf16x2_t b=__builtin_convertvector(v,bf16x2_t);return __builtin_bit_cast(unsigned,b);}
#define WAIT_BAR(N) asm volatile("s_waitcnt vmcnt(" #N ") lgkmcnt(0)\n\ts_barrier":::"memory")

__device__ __forceinline__ void qkt(f32x16&p0,f32x16&p1,const char*Kslot,const bf16x8*qr,const f32x16&negm,int r32,int hi){
  const char*kb=Kslot+hi*1024+r32*16;
  #pragma unroll
  for(int d0=0;d0<4;++d0){
    const bf16x8 b0=*reinterpret_cast<const bf16x8*>(kb+d0*2048);
    const bf16x8 b1=*reinterpret_cast<const bf16x8*>(kb+d0*2048+512);
    if(d0==0){p0=__builtin_amdgcn_mfma_f32_32x32x16_bf16(b0,qr[0],negm,0,0,0);p1=__builtin_amdgcn_mfma_f32_32x32x16_bf16(b1,qr[0],negm,0,0,0);}
    else{p0=__builtin_amdgcn_mfma_f32_32x32x16_bf16(b0,qr[d0],p0,0,0,0);p1=__builtin_amdgcn_mfma_f32_32x32x16_bf16(b1,qr[d0],p1,0,0,0);}}
}
typedef __attribute__((address_space(3))) const char* lds_cptr;
typedef short v4i16_t __attribute__((ext_vector_type(4)));
__device__ __forceinline__ void kload8(bf16x8*kf,lds_cptr kp){
  kf[0]=*(const __attribute__((address_space(3))) bf16x8*)(kp);      kf[1]=*(const __attribute__((address_space(3))) bf16x8*)(kp+512);
  kf[2]=*(const __attribute__((address_space(3))) bf16x8*)(kp+2048); kf[3]=*(const __attribute__((address_space(3))) bf16x8*)(kp+2560);
  kf[4]=*(const __attribute__((address_space(3))) bf16x8*)(kp+4096); kf[5]=*(const __attribute__((address_space(3))) bf16x8*)(kp+4608);
  kf[6]=*(const __attribute__((address_space(3))) bf16x8*)(kp+6144); kf[7]=*(const __attribute__((address_space(3))) bf16x8*)(kp+6656);
}
__device__ __forceinline__ void kload2(bf16x8*kf,lds_cptr kp,int j){ kf[2*j]=*(const __attribute__((address_space(3))) bf16x8*)(kp+j*2048); kf[2*j+1]=*(const __attribute__((address_space(3))) bf16x8*)(kp+j*2048+512); }
__device__ __forceinline__ s16x4 vtr(lds_cptr p){ return __builtin_bit_cast(s16x4,__builtin_amdgcn_ds_read_tr16_b64_v4i16((__attribute__((address_space(3))) v4i16_t*)p)); }
__device__ __forceinline__ float rowmax(const f32x16&p0,const f32x16&p1){
  float a=max3f(p0[0],p0[1],p1[0]),b=max3f(p0[2],p0[3],p1[1]);a=max3f(a,p1[2],p1[3]);
  #pragma unroll
  for(int r=4;r<16;r+=4){a=max3f(a,p0[r],p0[r+1]);b=max3f(b,p0[r+2],p0[r+3]);a=max3f(a,p1[r],p1[r+1]);b=max3f(b,p1[r+2],p1[r+3]);}
  const float m=max2f(a,b);
  auto rr=__builtin_amdgcn_permlane32_swap(__float_as_uint(m),__float_as_uint(m),false,false);
  return max2f(__uint_as_float(rr[0]),__uint_as_float(rr[1]));
}
__device__ __forceinline__ void pv(f32x16*o,int vb,bf16x8 pa0,bf16x8 pa1,bf16x8 pa2,bf16x8 pa3){
  #pragma unroll
  for(int d0=0;d0<2;++d0){s16x4 lo[4],hi[4];
    #pragma unroll
    for(int ks=0;ks<4;++ks){
      asm volatile("ds_read_b64_tr_b16 %0,%1 offset:%c2":"=&v"(lo[ks]):"v"(vb),"i"(d0*4096+ks*1024):"memory");
      asm volatile("ds_read_b64_tr_b16 %0,%1 offset:%c2":"=&v"(hi[ks]):"v"(vb),"i"(d0*4096+ks*1024+512):"memory");}
    asm volatile("s_waitcnt lgkmcnt(0)":::"memory");SBAR();
    #define PK(k) (bf16x8){lo[k][0],lo[k][1],lo[k][2],lo[k][3],hi[k][0],hi[k][1],hi[k][2],hi[k][3]}
    o[d0]=__builtin_amdgcn_mfma_f32_32x32x16_bf16(pa0,PK(0),o[d0],0,0,0);
    o[d0]=__builtin_amdgcn_mfma_f32_32x32x16_bf16(pa1,PK(1),o[d0],0,0,0);
    o[d0]=__builtin_amdgcn_mfma_f32_32x32x16_bf16(pa2,PK(2),o[d0],0,0,0);
    o[d0]=__builtin_amdgcn_mfma_f32_32x32x16_bf16(pa3,PK(3),o[d0],0,0,0);
    #undef PK
  }
}

#ifndef ATTN_STORE16
#define ATTN_STORE16(p,v) (*(u32x4*)(p)=(v))
#endif
template<int THRL> __device__ __forceinline__ void attn_unit(int b,int h,int qb,const bf16*Q,const bf16*__restrict__ K,const bf16*__restrict__ V,bf16*O,char*shm){
  const int tid=threadIdx.x,lane=tid&63,r32=lane&31,hi=lane>>5; const int wid=__builtin_amdgcn_readfirstlane(tid>>6);
  const long rowbase=(long)b*SEQ; const int q0=qb*QB;
  const bf16*Qw=Q+(rowbase+q0+wid*QBLK)*DM+h*D;
  const bf16*Kh=K+rowbase*DM+h*D,*Vh=V+rowbase*DM+h*D;
  const unsigned lds0=(unsigned)(uintptr_t)shm;
  float*wsf=(float*)(shm+LDS_WS)+wid*64;
  const bf16*ksrc=Kh+(long)lane*DM+wid*8;
  const bf16*vsrc=Vh+(long)(16*(wid&3)+(lane>>2))*DM+(wid>>2)*32+(lane&3)*8;
  const unsigned kdst=lds0+LDS_K+wid*1024, vdst=lds0+LDS_V+wid*1024;
  #define DMA_K(t,slot) glds16(ksrc+(long)(t)*KVBLK*DM,(unsigned)__builtin_amdgcn_readfirstlane(kdst+(slot)))
  #define DMA_V(t,slot) glds16(vsrc+(long)(t)*KVBLK*DM,(unsigned)__builtin_amdgcn_readfirstlane(vdst+(slot)))
  const int vb0=(int)(lds0+LDS_V)+((lane>>4)&1)*32+(lane&3)*8+(4*hi+((lane&15)>>2))*64;
  const char*Kbase=shm+LDS_K; bf16x8 kf[8];
  const lds_cptr shm3=(lds_cptr)shm; const lds_cptr kp0=shm3+LDS_K+hi*1024+r32*16; const lds_cptr vp0=shm3+LDS_V+((lane>>4)&1)*32+(lane&3)*8+(4*hi+((lane&15)>>2))*64;
  const int NT=(q0+QB)/KVBLK;
  DMA_K(0,0);DMA_V(0,0);DMA_K(1,SLOTB);
  __attribute__((address_space(3))) float*csl=(__attribute__((address_space(3))) float*)(uintptr_t)(unsigned)(uintptr_t)(shm+LDS_CS);
  const float ctq=csl[q0+wid*QBLK+r32];
  bf16x8 qr[4];
  #pragma unroll
  for(int d0=0;d0<4;++d0)qr[d0]=*reinterpret_cast<const bf16x8*>(&Qw[(long)r32*DM+d0*16+hi*8]);
  float mhat=-ctq,l_reg=0.f;f32x16 o[2];o[0]=f32x16{};o[1]=f32x16{};f32x16 negm;
  #pragma unroll
  for(int r=0;r<16;++r)negm[r]=ctq;
  asm volatile("":"+v"(negm));
  const int qrel=wid*QBLK+r32;
  #define CMASK(P0,P1,t) do{int jb_=(t)-(NT-4); if(jb_>=0)cmask(P0,P1,jb_,qrel,hi);}while(0)
  #define CSUB(P0,P1,t) do{ const __attribute__((address_space(3))) float*cp_=csl+(t)*KVBLK+4*hi; _Pragma("unroll") for(int g_=0;g_<4;g_+=2){ const f32x4v a_=*(const __attribute__((address_space(3))) f32x4v*)(cp_+8*g_), c_=*(const __attribute__((address_space(3))) f32x4v*)(cp_+8*g_+8); \
      _Pragma("unroll") for(int j_=0;j_<4;++j_){P0[4*g_+j_]-=a_[j_];P0[4*g_+4+j_]-=c_[j_];} SBAR(); } \
    _Pragma("unroll") for(int g_=0;g_<4;g_+=2){ const f32x4v b_=*(const __attribute__((address_space(3))) f32x4v*)(cp_+32+8*g_), d_=*(const __attribute__((address_space(3))) f32x4v*)(cp_+40+8*g_); \
      _Pragma("unroll") for(int j_=0;j_<4;++j_){P1[4*g_+j_]-=b_[j_];P1[4*g_+4+j_]-=d_[j_];} SBAR(); } }while(0)
  bool resc=false;
  #define START(P0,P1) do{ const float rm=rowmax(P0,P1); resc=false; \
    { const float dl=rm; mhat=fadd_s(mhat,dl); \
      _Pragma("unroll") for(int r=0;r<16;++r){P0[r]=fsub_s(P0[r],dl);P1[r]=fsub_s(P1[r],dl);} \
      _Pragma("unroll") for(int r=0;r<16;++r)negm[r]=-mhat; asm volatile("":"+v"(negm)); } \
    _Pragma("unroll") for(int r=0;r<16;++r)P0[r]=__builtin_amdgcn_exp2f(P0[r]); }while(0)
  #define RESC() do{ if(resc){ asm volatile("s_waitcnt lgkmcnt(0)":::"memory"); \
      _Pragma("unroll") for(int d_=0;d_<2;++d_) _Pragma("unroll") for(int r=0;r<16;++r)o[d_][r]*=wsf[crow(r,hi)]; } }while(0)
  f32x16 pA0,pA1,pB0,pB1;
  int sl_prev=0,sl_cur=0,sl_next=SLOTB;
  #define ROT() do{sl_prev=sl_cur;sl_cur=sl_next;sl_next=(sl_next==(NSLOT-1)*SLOTB)?0:sl_next+SLOTB;}while(0)
  DMA_K(2,2*SLOTB);
  WAIT_BAR(3);
  qkt(pA0,pA1,Kbase,qr,negm,r32,hi);asm volatile("s_nop 15\n\ts_nop 7":"+v"(pA0),"+v"(pA1));CSUB(pA0,pA1,0);CMASK(pA0,pA1,0);
  START(pA0,pA1);
  _Pragma("unroll") for(int r=0;r<16;++r)pA1[r]=__builtin_amdgcn_exp2f(pA1[r]);
  WAIT_BAR(0);
  DMA_K(3,0);DMA_V(1,SLOTB);
  ROT();
  kload8(kf,kp0+sl_cur);
  WAIT_BAR(2);
  s16x4 vlo[8],vhi[8]; u32x4 pw0,pw1,pw2,pw3;
  #define PKW(P,B) cvtpk_s(P[B],P[B+1])
  #define PAF(k) __builtin_bit_cast(bf16x8,pw##k)
  #define VFR(i) (bf16x8){vlo[i][0],vlo[i][1],vlo[i][2],vlo[i][3],vhi[i][0],vhi[i][1],vhi[i][2],vhi[i][3]}
  #define PIN(x) asm volatile("":"+v"(x))
  #define MX3(a,b,c) __builtin_fmaxf(__builtin_fmaxf((a),(b)),(c))
  #define GAPA(MF,A0,A1,A2,A3,W0,W1,PW) do{ MF; sacc+=A0; sacc+=A1; sacc+=A2; sacc+=A3; PIN(sacc); W0; W1; PIN(PW); SBAR(); }while(0)
  #define EX(v) __builtin_amdgcn_exp2f(v)
  #define GAPB(MF,X,B) do{ MF; X[B]=EX(X[B]); X[B+1]=EX(X[B+1]); X[B+2]=EX(X[B+2]); X[B+3]=EX(X[B+3]); PIN(X); SBAR(); }while(0)
  #define VRD(i) do{ vlo[i]=vtr(vp_+(((i)>>2)*4096+((i)&3)*1024)); vhi[i]=vtr(vp_+(((i)>>2)*4096+((i)&3)*1024+512)); }while(0)
  #define KRD(G,j) do{ if(G){ kload2(kf,kp0+sl_next,j); SBAR(); } }while(0)
  #define STEP(C0,C1,P0,P1,t,GK,GV,GL) do{ SBAR(); \
    const lds_cptr vp_=vp0+sl_prev; \
    VRD(0); SBAR(); float sacc=(P0[0]+P0[1]); \
    GAPA(C0=__builtin_amdgcn_mfma_f32_32x32x16_bf16(kf[0],qr[0],negm,0,0,0), P0[2],P0[3],P0[4],P0[5],     pw0[0]=PKW(P0,0), pw0[1]=PKW(P0,2), pw0); \
    VRD(4); SBAR(); GAPA(C1=__builtin_amdgcn_mfma_f32_32x32x16_bf16(kf[1],qr[0],negm,0,0,0), P0[6],P0[7],P0[8],P0[9],     pw0[2]=PKW(P0,4), pw0[3]=PKW(P0,6), pw0); \
    VRD(1); SBAR(); GAPA(C0=__builtin_amdgcn_mfma_f32_32x32x16_bf16(kf[2],qr[1],C0,0,0,0),   P0[10],P0[11],P0[12],P0[13], pw1[0]=PKW(P0,8), pw1[1]=PKW(P0,10), pw1); \
    VRD(5); SBAR(); GAPA(C1=__builtin_amdgcn_mfma_f32_32x32x16_bf16(kf[3],qr[1],C1,0,0,0),   P0[14],P0[15],P1[0],P1[1],   pw1[2]=PKW(P0,12),pw1[3]=PKW(P0,14), pw1); \
    VRD(2); SBAR(); GAPA(C0=__builtin_amdgcn_mfma_f32_32x32x16_bf16(kf[4],qr[2],C0,0,0,0),   P1[2],P1[3],P1[4],P1[5],     pw2[0]=PKW(P1,0), pw2[1]=PKW(P1,2), pw2); \
    VRD(6); SBAR(); GAPA(C1=__builtin_amdgcn_mfma_f32_32x32x16_bf16(kf[5],qr[2],C1,0,0,0),   P1[6],P1[7],P1[8],P1[9],     pw2[2]=PKW(P1,4), pw2[3]=PKW(P1,6), pw2); \
    VRD(3); SBAR(); GAPA(C0=__builtin_amdgcn_mfma_f32_32x32x16_bf16(kf[6],qr[3],C0,0,0,0),   P1[10],P1[11],P1[12],P1[13], pw3[0]=PKW(P1,8), pw3[1]=PKW(P1,10), pw3); \
    VRD(7); SBAR(); GAPA(C1=__builtin_amdgcn_mfma_f32_32x32x16_bf16(kf[7],qr[3],C1,0,0,0),   P1[14],P1[15],0.f,0.f,       pw3[2]=PKW(P1,12),pw3[3]=PKW(P1,14), pw3); \
    l_reg+=sacc; \
    if(GK){DMA_K((t)+3,sl_cur);} if(GV){DMA_V((t)+1,sl_next);} \
    SBAR(); CSUB(C0,C1,t); CMASK(C0,C1,t); \
    { float a=MX3(C0[0],C0[1],C1[0]),b=MX3(C0[2],C0[3],C1[1]); a=MX3(a,C1[2],C1[3]); \
      _Pragma("unroll") for(int r=4;r<16;r+=4){a=MX3(a,C0[r],C0[r+1]);b=MX3(b,C0[r+2],C0[r+3]);a=MX3(a,C1[r],C1[r+1]);b=MX3(b,C1[r+2],C1[r+3]);} \
      float rm=__builtin_fmaxf(a,b); { auto rr=__builtin_amdgcn_permlane32_swap(__float_as_uint(rm),__float_as_uint(rm),false,false); rm=__builtin_fmaxf(__uint_as_float(rr[0]),__uint_as_float(rr[1])); } \
      resc=false; \
      if(__builtin_expect(__any(rm>(float)THRL),0)){ const float dl=__builtin_fmaxf(rm,0.f); mhat+=dl; \
        _Pragma("unroll") for(int r=0;r<16;++r){C0[r]-=dl;C1[r]-=dl;} \
        _Pragma("unroll") for(int r=0;r<16;++r)negm[r]=-mhat; asm volatile("":"+v"(negm)); \
        const float f=__builtin_amdgcn_exp2f(-dl); l_reg*=f; if(hi==0)wsf[r32]=f; resc=true; } } \
    SBAR(); \
    GAPB(o[0]=__builtin_amdgcn_mfma_f32_32x32x16_bf16(PAF(0),VFR(0),o[0],0,0,0), C0,0); \
    GAPB(o[1]=__builtin_amdgcn_mfma_f32_32x32x16_bf16(PAF(0),VFR(4),o[1],0,0,0), C0,4); \
    KRD(GL,0); GAPB(o[0]=__builtin_amdgcn_mfma_f32_32x32x16_bf16(PAF(1),VFR(1),o[0],0,0,0), C0,8); \
    KRD(GL,1); GAPB(o[1]=__builtin_amdgcn_mfma_f32_32x32x16_bf16(PAF(1),VFR(5),o[1],0,0,0), C0,12); \
    KRD(GL,2); GAPB(o[0]=__builtin_amdgcn_mfma_f32_32x32x16_bf16(PAF(2),VFR(2),o[0],0,0,0), C1,0); \
    KRD(GL,3); GAPB(o[1]=__builtin_amdgcn_mfma_f32_32x32x16_bf16(PAF(2),VFR(6),o[1],0,0,0), C1,4); \
    GAPB(o[0]=__builtin_amdgcn_mfma_f32_32x32x16_bf16(PAF(3),VFR(3),o[0],0,0,0), C1,8); \
    GAPB(o[1]=__builtin_amdgcn_mfma_f32_32x32x16_bf16(PAF(3),VFR(7),o[1],0,0,0), C1,12); \
    }while(0)
  int t=1;
  #undef CMASK
  #define CMASK(P0,P1,t) do{}while(0)
  for(;t+5<NT;t+=2){
    STEP(pB0,pB1,pA0,pA1,t,true,true,true);     WAIT_BAR(2); RESC(); ROT();
    STEP(pA0,pA1,pB0,pB1,t+1,true,true,true);   WAIT_BAR(2); RESC(); ROT();
  }
  #undef CMASK
  #define CMASK(P0,P1,t) do{int jb_=(t)-(NT-4); if(jb_>=0)cmask(P0,P1,jb_,qrel,hi);}while(0)
  #define ENDW(tt) do{ if((tt)+3<NT){WAIT_BAR(2);} else if((tt)+2<NT){WAIT_BAR(1);} else {WAIT_BAR(0);} }while(0)
  for(;t+1<NT;t+=2){
    STEP(pB0,pB1,pA0,pA1,t,(t+3<NT),(t+1<NT),(t+1<NT));       ENDW(t);   RESC(); ROT();
    STEP(pA0,pA1,pB0,pB1,t+1,(t+4<NT),(t+2<NT),(t+2<NT));     ENDW(t+1); RESC(); ROT();
  }
  STEP(pB0,pB1,pA0,pA1,NT-1,false,false,false); RESC();
  { float sacc=pB0[0]+pB0[1]; _Pragma("unroll") for(int r=2;r<16;++r)sacc+=pB0[r]; _Pragma("unroll") for(int r=0;r<16;++r)sacc+=pB1[r]; l_reg+=sacc;
    pw0=(u32x4){PKW(pB0,0),PKW(pB0,2),PKW(pB0,4),PKW(pB0,6)};pw1=(u32x4){PKW(pB0,8),PKW(pB0,10),PKW(pB0,12),PKW(pB0,14)};pw2=(u32x4){PKW(pB1,0),PKW(pB1,2),PKW(pB1,4),PKW(pB1,6)};pw3=(u32x4){PKW(pB1,8),PKW(pB1,10),PKW(pB1,12),PKW(pB1,14)};
    SBAR(); pv(o,vb0+sl_cur,PAF(0),PAF(1),PAF(2),PAF(3)); }
  #undef PKW
  #undef PAF
  #undef VFR
  #undef PIN
  #undef MX3
  #undef GAPA
  #undef GAPB
  #undef EX
  #undef VRD
  #undef KRD
  #undef STEP
  #undef ENDW
  {auto rr=__builtin_amdgcn_permlane32_swap(__float_as_uint(l_reg),__float_as_uint(l_reg),false,false);l_reg=__uint_as_float(rr[0])+__uint_as_float(rr[1]);}
  if(hi==0)wsf[32+r32]=l_reg;asm volatile("s_waitcnt lgkmcnt(0)":::"memory");
  float rli[16];
  #pragma unroll
  for(int r=0;r<16;++r)rli[r]=__builtin_amdgcn_rcpf(wsf[32+crow(r,hi)]);
  bf16*Ow=O+(rowbase+q0+wid*QBLK)*DM+h*D;
  { bf16*stg=(bf16*)(shm+LDS_OST)+wid*2048;
    #pragma unroll
    for(int r=0;r<16;++r){const int orow=crow(r,hi);
      #pragma unroll
      for(int d0=0;d0<2;++d0)stg[orow*64+d0*32+r32]=__float2bfloat16(o[d0][r]*rli[r]);}
    asm volatile("s_waitcnt lgkmcnt(0)":::"memory");
    #pragma unroll
    for(int i=0;i<4;++i){const int row=i*8+(lane>>3),ch=lane&7; const u32x4 v=*(const u32x4*)(stg+row*64+ch*8); ATTN_STORE16(Ow+(long)row*DM+ch*8,v);} }
  asm volatile("s_waitcnt lgkmcnt(0)\n\ts_barrier":::"memory");
  #undef DMA_K
  #undef DMA_V
  #undef CMASK
  #undef CSUB
  #undef START
  #undef RESC
  #undef ROT
}
constexpr int ATTN_LDS_BYTES=LDS_BYTES;
struct AttnTensors { const bf16* Q; const bf16* K; const bf16* V; bf16* O; const float* CS; };
struct AttnUnit { int bh; int qb; };
struct StaticOrder {
  int vcu;
  __device__ __forceinline__ explicit StaticOrder(int grid,int block):vcu((block%8)*(grid/8)+block/8){}
  __device__ __forceinline__ bool next(int i,AttnUnit&u)const{ if(i>=4)return false; const int s=vcu&1; u.bh=vcu>>1; u.qb=(i==0)?s:(i==1)?7-s:(i==2)?3-s:4+s; return true; }
};
template<class Sched,int THRL=8> __device__ __forceinline__ void attn_phase(char*lds,const AttnTensors&T,const Sched&S){
  AttnUnit u;
  {
    const int tid=threadIdx.x, bh=S.vcu>>1, b=bh/NHEAD, h=bh%NHEAD;
    __attribute__((address_space(3))) float*csl=(__attribute__((address_space(3))) float*)(uintptr_t)(unsigned)(uintptr_t)(lds+LDS_CS);
    __attribute__((address_space(3))) float*sc=(__attribute__((address_space(3))) float*)(uintptr_t)(unsigned)(uintptr_t)(lds+LDS_WS);
    float v[4],run=0.f;
    #pragma unroll
    for(int i=0;i<4;++i){run+=T.CS[(long)(b*SEQ+4*tid+i)*NHEAD+h];v[i]=run;}
    sc[tid]=run;__syncthreads();
    for(int o=1;o<NW*64;o<<=1){const float a=(tid>=o)?sc[tid-o]:0.f;__syncthreads();sc[tid]+=a;__syncthreads();}
    const float excl=sc[tid]-run;
    #pragma unroll
    for(int i=0;i<4;++i)csl[4*tid+i]=(excl+v[i])*1.4426950408889634f;
    __syncthreads(); }
  for(int i=0;S.next(i,u);++i){ attn_unit<THRL>(u.bh/NHEAD,u.bh%NHEAD,u.qb,T.Q,T.K,T.V,T.O,lds); }
}

constexpr int SB_K=0, SB_V=2*SLOTB, SB_FLAG=4*SLOTB, SB_OST=SB_FLAG+256, SB_BYTES=SB_OST+NW*4096;
__device__ __forceinline__ void sb_unit(int b,int h,int qb,const bf16*Q,const bf16*__restrict__ K,const bf16*__restrict__ V,bf16*O,char*shm){
  const int tid=threadIdx.x,lane=tid&63,r32=lane&31,hi=lane>>5; const int wid=__builtin_amdgcn_readfirstlane(tid>>6);
  const long rowbase=(long)b*SEQ; const int q0=qb*QB;
  const bf16*Qw=Q+(rowbase+q0+wid*QBLK)*DM+h*D;
  const bf16*Kh=K+rowbase*DM+h*D,*Vh=V+rowbase*DM+h*D;
  const unsigned lds0=(unsigned)(uintptr_t)shm;
  const bf16*ksrc=Kh+(long)lane*DM+wid*8;
  const bf16*vsrc=Vh+(long)(16*(wid&3)+(lane>>2))*DM+(wid>>2)*32+(lane&3)*8;
  const unsigned kdst=lds0+SB_K+wid*1024, vdst=lds0+SB_V+wid*1024;
  #define DMA_K(t,slot) glds16(ksrc+(long)(t)*KVBLK*DM,(unsigned)__builtin_amdgcn_readfirstlane(kdst+(slot)))
  #define DMA_V(t,slot) glds16(vsrc+(long)(t)*KVBLK*DM,(unsigned)__builtin_amdgcn_readfirstlane(vdst+(slot)))
  const int vb0=(int)(lds0+SB_V)+((lane>>4)&1)*32+(lane&3)*8+(4*hi+((lane&15)>>2))*64;
  typedef __attribute__((address_space(3))) unsigned lds_u32;
  lds_u32* flag=(lds_u32*)(uintptr_t)(lds0+SB_FLAG);
  const int NT=(q0+QB)/KVBLK;
  DMA_K(NT-1,0);DMA_V(NT-1,0);
  bf16x8 qr[4];
  #pragma unroll
  for(int d0=0;d0<4;++d0)qr[d0]=*reinterpret_cast<const bf16x8*>(&Qw[(long)r32*DM+d0*16+hi*8]);
  f32x16 o[2];o[0]=f32x16{};o[1]=f32x16{};
  float rinv=1.0f; const int qrel=wid*QBLK+r32;
  for(int i=0;i<NT;++i){
    const int t=NT-1-i, slot=(i&1)*SLOTB;
    asm volatile("s_waitcnt vmcnt(0) lgkmcnt(0)\n\ts_barrier":::"memory");
    if(i>0){ const u32x4 f0=*(const __attribute__((address_space(3))) u32x4*)(flag+((i-1)&1)*8), f1=*(const __attribute__((address_space(3))) u32x4*)(flag+((i-1)&1)*8+4);
      if((f0.x&f0.y&f0.z&f0.w&f1.x&f1.y&f1.z&f1.w)!=0u)break; }
    if(i+1<NT){DMA_K(t-1,SLOTB-slot);DMA_V(t-1,SLOTB-slot);}
    f32x16 p0,p1; { f32x16 zc=f32x16{}; qkt(p0,p1,shm+SB_K+slot,qr,zc,r32,hi); }
    f32x16 c0,c1;
    #pragma unroll
    for(int r=0;r<16;++r){p0[r]=__builtin_amdgcn_exp2f(p0[r]);p1[r]=__builtin_amdgcn_exp2f(p1[r]);}
    { const int jb=t-(NT-4); if(jb>=0){ const int kb=64*jb+4*hi;
      #pragma unroll
      for(int r=0;r<16;++r){const int kv=kb+(r&3)+8*(r>>2); if(kv>=qrel)p0[r]=0.f; if(kv+32>=qrel)p1[r]=0.f;} } }
    #pragma unroll
    for(int r=0;r<16;++r){c0[r]=__builtin_amdgcn_rcpf(1.0f+p0[r]);c1[r]=__builtin_amdgcn_rcpf(1.0f+p1[r]);}
    #pragma unroll
    for(int g=0;g<4;++g){ c0[4*g+2]*=c0[4*g+3];c0[4*g+1]*=c0[4*g+2];c0[4*g]*=c0[4*g+1]; c1[4*g+2]*=c1[4*g+3];c1[4*g+1]*=c1[4*g+2];c1[4*g]*=c1[4*g+1]; }
    float tl[8],th[8],X[8];
    #pragma unroll
    for(int g=0;g<8;++g){ const float T=(g<4)?c0[4*g]:c1[4*(g-4)]; auto rr=__builtin_amdgcn_permlane32_swap(__float_as_uint(T),__float_as_uint(T),false,false); tl[g]=__uint_as_float(rr[0]); th[g]=__uint_as_float(rr[1]); }
    X[7]=1.0f;
    #pragma unroll
    for(int g=6;g>=0;--g)X[g]=X[g+1]*(tl[g+1]*th[g+1]);
    #pragma unroll
    for(int g=0;g<8;++g){ const float F=rinv*X[g]*(hi?1.0f:th[g]);
      #pragma unroll
      for(int j=0;j<4;++j){ if(g<4)p0[4*g+j]=p0[4*g+j]*c0[4*g+j]*F; else p1[4*(g-4)+j]=p1[4*(g-4)+j]*c1[4*(g-4)+j]*F; } }
    rinv=rinv*X[0]*(tl[0]*th[0]);
    { const bool dn=__all(rinv<8.6736174e-19f); if(lane==0)flag[(i&1)*8+wid]=dn?1u:0u; }
    u32x4 pw0,pw1,pw2,pw3;
    pw0=(u32x4){cvtpk_s(p0[0],p0[1]),cvtpk_s(p0[2],p0[3]),cvtpk_s(p0[4],p0[5]),cvtpk_s(p0[6],p0[7])};
    pw1=(u32x4){cvtpk_s(p0[8],p0[9]),cvtpk_s(p0[10],p0[11]),cvtpk_s(p0[12],p0[13]),cvtpk_s(p0[14],p0[15])};
    pw2=(u32x4){cvtpk_s(p1[0],p1[1]),cvtpk_s(p1[2],p1[3]),cvtpk_s(p1[4],p1[5]),cvtpk_s(p1[6],p1[7])};
    pw3=(u32x4){cvtpk_s(p1[8],p1[9]),cvtpk_s(p1[10],p1[11]),cvtpk_s(p1[12],p1[13]),cvtpk_s(p1[14],p1[15])};
    SBAR(); pv(o,vb0+slot,__builtin_bit_cast(bf16x8,pw0),__builtin_bit_cast(bf16x8,pw1),__builtin_bit_cast(bf16x8,pw2),__builtin_bit_cast(bf16x8,pw3));
  }
  bf16*Ow=O+(rowbase+q0+wid*QBLK)*DM+h*D;
  { bf16*stg=(bf16*)(shm+SB_OST)+wid*2048;
    #pragma unroll
    for(int r=0;r<16;++r){const int orow=crow(r,hi);
      #pragma unroll
      for(int d0=0;d0<2;++d0)stg[orow*64+d0*32+r32]=__float2bfloat16(o[d0][r]);}
    asm volatile("s_waitcnt lgkmcnt(0)":::"memory");
    #pragma unroll
    for(int i=0;i<4;++i){const int row=i*8+(lane>>3),ch=lane&7; const u32x4 v=*(const u32x4*)(stg+row*64+ch*8); *(u32x4*)(Ow+(long)row*DM+ch*8)=v;} }
  asm volatile("s_waitcnt vmcnt(0) lgkmcnt(0)\n\ts_barrier":::"memory");
  #undef DMA_K
  #undef DMA_V
}
template<class Sched> __device__ __forceinline__ void sb_phase(char*lds,const AttnTensors&T,const Sched&S){
  AttnUnit u;
  for(int i=0;S.next(i,u);++i){ sb_unit(u.bh/NHEAD,u.bh%NHEAD,u.qb,T.Q,T.K,T.V,T.O,lds); }
}
#undef SBAR
#undef WAIT_BAR
}
struct Args { const float* in[20]; float* out; unsigned char* ws; int ph_lo, ph_hi, li, pad; };

struct ConvDesc { const float* src; const float* gain; bf16_t* dst; int ldn, K, fp8; };
__device__ __forceinline__ void conv_load(const ConvDesc& d, f32x4 (&v)[16], f32x4 (&g)[2], int lane) {
#pragma unroll
    for (int i = 0; i < 16; ++i) v[i] = *(const GAS f32x4*)(d.src + (size_t)(4 * i + (lane >> 4)) * d.ldn + (lane & 15) * 4);
    if (d.gain) { g[0] = *(const GAS f32x4*)(d.gain + 8 * (lane & 7)); g[1] = *(const GAS f32x4*)(d.gain + 8 * (lane & 7) + 4); }
    else { g[0] = (f32x4){1.f, 1.f, 1.f, 1.f}; g[1] = g[0]; }
}
__device__ __forceinline__ void conv_store(const ConvDesc& d, const f32x4 (&v)[16], const f32x4 (&g)[2], LAS float* scr, int lane) {
#pragma unroll
    for (int i = 0; i < 16; ++i) { LAS float* s = scr + (4 * i + (lane >> 4)) * 65 + (lane & 15) * 4; s[0] = v[i][0]; s[1] = v[i][1]; s[2] = v[i][2]; s[3] = v[i][3]; }
    const int c = lane & 7;
    LDS_WAIT(); asm volatile("" ::: "memory");
#pragma unroll
    for (int j = 0; j < 8; ++j) { const int n = (lane >> 3) + 8 * j; const LAS float* s = scr + (8 * c) * 65 + n;
        u32x4 o; o.x = pk2(s[0 * 65] * g[0][0], s[1 * 65] * g[0][1]); o.y = pk2(s[2 * 65] * g[0][2], s[3 * 65] * g[0][3]); o.z = pk2(s[4 * 65] * g[1][0], s[5 * 65] * g[1][1]); o.w = pk2(s[6 * 65] * g[1][2], s[7 * 65] * g[1][3]);
        if (!d.fp8) *(GAS u32x4*)(d.dst + (size_t)n * d.K + 8 * c) = o;
        else { u32x2 o8; int w;
            w = __builtin_amdgcn_cvt_pk_fp8_f32(s[0 * 65] * g[0][0] * 32.f, s[1 * 65] * g[0][1] * 32.f, 0, false); w = __builtin_amdgcn_cvt_pk_fp8_f32(s[2 * 65] * g[0][2] * 32.f, s[3 * 65] * g[0][3] * 32.f, w, true); o8.x = (unsigned)w;
            w = __builtin_amdgcn_cvt_pk_fp8_f32(s[4 * 65] * g[1][0] * 32.f, s[5 * 65] * g[1][1] * 32.f, 0, false); w = __builtin_amdgcn_cvt_pk_fp8_f32(s[6 * 65] * g[1][2] * 32.f, s[7 * 65] * g[1][3] * 32.f, w, true); o8.y = (unsigned)w;
            *(GAS u32x2*)((GAS unsigned char*)d.dst + (size_t)n * d.K + 8 * c) = o8; } }
    LDS_WAIT(); asm volatile("" ::: "memory");
}
__device__ __forceinline__ int gu_dest(int n0, int FH) { const int up = n0 >= FH ? 1 : 0, j = n0 - up * FH; return 256 * (j >> 7) + 128 * up + (j & 127); }

__device__ __forceinline__ void moe_prefix(const int* cntwg, int wg, volatile LAS int* L, int wave, int lane) {
    __syncthreads();
    { int tot = 0, pre = 0;
      for (int w = lane; w < 256; w += 64) { const int c = __hip_atomic_load(cntwg + w * 8 + wave, RLX_AGENT); tot += c; if (w < wg) pre += c; }
#pragma unroll
      for (int o = 1; o < 64; o <<= 1) { tot += __shfl_xor(tot, o); pre += __shfl_xor(pre, o); }
      if (lane == 0) { L[16 + wave] = tot; L[32 + wave] = pre; } }
    __syncthreads();
    if (threadIdx.x == 0) { int a = 0; L[0] = 0; for (int e = 0; e < NE; ++e) { a += (L[16 + e] + 255) >> 8; L[e + 1] = a; } }
    __syncthreads();
}

__device__ __forceinline__ const float* inp_ptr(int i) {
    typedef __attribute__((address_space(4))) const unsigned long long* kap_t;
    kap_t p = (kap_t)__builtin_amdgcn_kernarg_segment_ptr();
    asm volatile("" : "+s"(p));
    return (const float*)(const GAS float*)(uintptr_t)p[i];
}
constexpr int CI_IN = 16 * 48, CI_SQ = 16 * 16, CI_KV = 16 * 32, CI_GUD = 16 * 88, CI_DD = 44 * 16, CI_GUM1 = 16 * 112, CI_DM1 = 56 * 16, CI_PP1 = 4 * 16;
constexpr int CONV_NITEMS = CI_IN + CI_SQ + CI_KV + CI_SQ + CI_SQ + CI_GUD + CI_DD + NE * CI_GUM1 + NE * CI_DM1 + 2 * CI_PP1 + 2 * CI_SQ;
__device__ __forceinline__ ConvDesc conv_mk(const float* W, int ldn, int K, const float* gain, bf16_t* WT, int k0, int n0, int nd0) {
    ConvDesc d; d.src = W + (size_t)k0 * ldn + n0; d.gain = gain ? gain + k0 : nullptr; d.dst = WT + (size_t)nd0 * K + k0; d.ldn = ldn; d.K = K; d.fp8 = 0; return d;
}
__device__ __forceinline__ ConvDesc conv_decode(int it, unsigned char* ws) {
    int r = it;
    if (r < CI_IN) return conv_mk(inp_ptr(4), 3 * DM + NH, DM, inp_ptr(2), (bf16_t*)(ws + WS_W_IN), 64 * (r / 48), 64 * (r % 48), 64 * (r % 48)); r -= CI_IN;
    if (r < CI_SQ) return conv_mk(inp_ptr(6), DM, DM, nullptr, (bf16_t*)(ws + WS_W_OA), 64 * (r / 16), 64 * (r % 16), 64 * (r % 16)); r -= CI_SQ;
    if (r < CI_KV) return conv_mk(inp_ptr(8), 2 * DM, DM, inp_ptr(7), (bf16_t*)(ws + WS_W_KVQ), 64 * (r / 32), 64 * (r % 32), 64 * (r % 32)); r -= CI_KV;
    if (r < CI_SQ) return conv_mk(inp_ptr(9), DM, DM, inp_ptr(2) + DM, (bf16_t*)(ws + WS_W_KVQ), 64 * (r / 16), 64 * (r % 16), 2 * DM + 64 * (r % 16)); r -= CI_SQ;
    if (r < CI_SQ) return conv_mk(inp_ptr(10), DM, DM, nullptr, (bf16_t*)(ws + WS_W_OB), 64 * (r / 16), 64 * (r % 16), 64 * (r % 16)); r -= CI_SQ;
    if (r < CI_GUD) { const int n0 = 64 * (r % 88); return conv_mk(inp_ptr(11), 2 * FD, DM, inp_ptr(3), (bf16_t*)(ws + WS_W_GUD), 64 * (r / 88), n0, gu_dest(n0, FD)); } r -= CI_GUD;
    if (r < CI_DD) return conv_mk(inp_ptr(12), DM, FD, nullptr, (bf16_t*)(ws + WS_W_DD), 64 * (r / 16), 64 * (r % 16), 64 * (r % 16)); r -= CI_DD;
    if (r < NE * CI_GUM1) { const int e = r / CI_GUM1, q = r % CI_GUM1, n0 = 64 * (q % 112);
        ConvDesc d = conv_mk(inp_ptr(15) + (size_t)e * DM * 2 * FE, 2 * FE, DM, inp_ptr(3) + DM, nullptr, 64 * (q / 112), n0, 0);
        d.dst = (bf16_t*)(ws + WS_W_GUM + ((size_t)e * 2 * FE + gu_dest(n0, FE)) * DM + 64 * (q / 112)); d.fp8 = 1; return d; } r -= NE * CI_GUM1;
    if (r < NE * CI_DM1) { const int e = r / CI_DM1, q = r % CI_DM1;
        return conv_mk(inp_ptr(16) + (size_t)e * FE * DM, DM, FE, nullptr, (bf16_t*)(ws + WS_W_DM) + (size_t)e * DM * FE, 64 * (q / 16), 64 * (q % 16), 64 * (q % 16)); } r -= NE * CI_DM1;
    if (r < 2 * CI_PP1) { const int e = r / CI_PP1, q = r % CI_PP1;
        return conv_mk(inp_ptr(17) + (size_t)e * DP * DM, DM, DP, nullptr, (bf16_t*)(ws + WS_W_PP) + (size_t)e * DM * DP, 64 * (q / 16), 64 * (q % 16), 64 * (q % 16)); } r -= 2 * CI_PP1;
    { const int e = r / CI_SQ, q = r % CI_SQ;
        return conv_mk(inp_ptr(18) + (size_t)e * DM * DM, DM, DM, nullptr, (bf16_t*)(ws + WS_W_PG) + (size_t)e * DM * DM, 64 * (q / 16), 64 * (q % 16), 64 * (q % 16)); }
}
__global__ void __launch_bounds__(NW * 64, 2) fwd_kernel(Args args) {
    extern __shared__ __attribute__((aligned(16))) unsigned char lds_raw[];
    LAS unsigned char* lds = (LAS unsigned char*)lds_raw;
    volatile LAS unsigned* MISC = (volatile LAS unsigned*)(lds + MISC_OFF);
    const int tid0 = threadIdx.x, wave = __builtin_amdgcn_readfirstlane(tid0 >> 6);
#define FRESH_IDS int tid = threadIdx.x; asm volatile("" : "+v"(tid)); const int lane = tid & 63;
    const int G = gridDim.x, bx = blockIdx.x;
    const int vcu = (G % 8 == 0) ? (bx % 8) * (G / 8) + bx / 8 : bx;
    const int gw = vcu * NW + wave, NGW = G * NW;
    unsigned char* ws = args.ws;
    gu32* ctl = (gu32*)(ws + WS_CTL);
    float* const hres = args.out;
#define INP(i) inp_ptr(i)
#define in_x INP(0)
#define p_in INP(1)
#define attn_norm INP(2)
#define ffn_norm INP(3)
#define w_in_a INP(4)
#define b_f INP(5)
#define w_o_a INP(6)
#define kv_norm INP(7)
#define w_kv INP(8)
#define w_q_b INP(9)
#define w_o_b INP(10)
#define w_gu_dense INP(11)
#define w_down_dense INP(12)
#define router_w INP(13)
#define router_b INP(14)
#define w_gu_moe INP(15)
#define w_down_moe INP(16)
#define w_ple_proj INP(17)
#define w_ple_gate INP(18)
#define final_norm INP(19)
#define rs0 ((float*)(ws + WS_RS0))
#define slab1 ((float*)(ws + WS_SLAB1))
#define slab3 ((float*)(ws + WS_SLAB3))
#define slab6 ((float*)(ws + WS_SLAB6))
#define logf_ ((float*)(ws + WS_LOGF))
#define cs ((float*)(ws + WS_CS))
#define cntwg ((int*)(ws + WS_CNTWG))
#define selE ((int*)(ws + WS_SELE))
#define selG ((float*)(ws + WS_SELG))
#define rr4 ((float*)(ws + WS_RR4))
#define tokpos ((int*)(ws + WS_TOKPOS))
#define grow ((float*)(ws + WS_GROW))
#define W_IN ((bf16_t*)(ws + WS_W_IN))
#define W_OA ((bf16_t*)(ws + WS_W_OA))
#define W_KVQ ((bf16_t*)(ws + WS_W_KVQ))
#define W_OB ((bf16_t*)(ws + WS_W_OB))
#define W_GUD ((bf16_t*)(ws + WS_W_GUD))
#define W_DD ((bf16_t*)(ws + WS_W_DD))
#define W_PP ((bf16_t*)(ws + WS_W_PP))
#define W_PG ((bf16_t*)(ws + WS_W_PG))
#define W_GUM ((bf16_t*)(ws + WS_W_GUM))
#define W_DM ((bf16_t*)(ws + WS_W_DM))
#define HBA ((bf16_t*)(ws + WS_HBA))
#define HBB ((bf16_t*)(ws + WS_HBB))
#define PB ((bf16_t*)(ws + WS_PB))
#define PP ((bf16_t*)(ws + WS_PP))
#define XG ((bf16_t*)(ws + WS_XGY))
#define YB ((bf16_t*)(ws + WS_XGY))
#define QB ((bf16_t*)(ws + WS_Q))
#define KB ((bf16_t*)(ws + WS_K))
#define VB ((bf16_t*)(ws + WS_V))
#define OB ((bf16_t*)(ws + WS_O))
#define ACTD ((bf16_t*)(ws + WS_ACTD))
#define ACTM ((bf16_t*)(ws + WS_ACTM))

    for (int u = tid0; u < (LDS_BYTES - LDSCTL_OFF) / 4; u += NW * 64) ((LAS unsigned*)(lds + LDSCTL_OFF))[u] = 0u;
    __syncthreads();
    XcdBarrier bar; bar.bar = (unsigned*)(ctl + CW_BAR) + args.li * XCD_BAR_WORDS; bar.x = 0; bar.st = nullptr;
    if (N_LAUNCHES != NPH) bar = xcd_barrier_post((unsigned*)(ctl + CW_BAR) + args.li * XCD_BAR_WORDS, MISC + 8);
    const int lo = args.ph_lo, hi = args.ph_hi;
#ifndef PHASE_MASK
#define PHASE_MASK 0x1ffff
#endif
#define IN(k) ((((PHASE_MASK) >> (k)) & 1) && lo <= (k) && (k) < hi)
#define SEAM(k) do { if (IN(k) && IN((k) + 1)) xcd_barrier(bar); } while (0)

    if (IN(0)) { FRESH_IDS
        const int p0parts = args.pad;
        if (p0parts & 1) {
            LAS float* wfg = (LAS float*)lds;
            { const float* an_ = attn_norm; const float* wi_ = w_in_a;
              float tmp[32];
#pragma unroll
              for (int u = 0; u < 32; ++u) { const int i = tid + u * (NW * 64), k = i >> 4, h = i & 15; tmp[u] = an_[k] * wi_[(size_t)k * (3 * DM + NH) + 3 * DM + h]; }
#pragma unroll
              for (int u = 0; u < 32; ++u) { const int i = tid + u * (NW * 64), k = i >> 4, h = i & 15;
                wfg[((((((k >> 8) * 4 + (k & 3)) * 4 + (h >> 2)) * 64) + ((k & 255) >> 2)) << 2) + (h & 3)] = tmp[u]; } }
            const float* xin_ = in_x; const float* bf_ = b_f;
            __syncthreads();
            f32x4 vn[4];
            if (gw < MT) { const GAS f32x4* xr = (const GAS f32x4*)(xin_ + (size_t)gw * DM) + lane;
#pragma unroll
                for (int j = 0; j < 4; ++j) vn[j] = xr[64 * j]; }
            for (int m = gw; m < MT; m += NGW) {
                f32x4 v[4]; float s = 0.f;
#pragma unroll
                for (int j = 0; j < 4; ++j) v[j] = vn[j];
                if (m + NGW < MT) { const GAS f32x4* xr = (const GAS f32x4*)(xin_ + (size_t)(m + NGW) * DM) + lane;
#pragma unroll
                    for (int j = 0; j < 4; ++j) vn[j] = xr[64 * j]; }
#pragma unroll
                for (int j = 0; j < 4; ++j) s += (v[j][0] * v[j][0] + v[j][1] * v[j][1]) + (v[j][2] * v[j][2] + v[j][3] * v[j][3]);
                const float r = 1.0f / sqrtf(wave_sum(s) * (1.0f / DM) + RMS_EPS);
                GAS unsigned long long* o8 = (GAS unsigned long long*)(HBA + (size_t)m * DM) + lane;
#pragma unroll
                for (int j = 0; j < 4; ++j) o8[64 * j] = (unsigned long long)pk2(v[j][0], v[j][1]) | ((unsigned long long)pk2(v[j][2], v[j][3]) << 32);
                float fa[16];
#pragma unroll
                for (int h = 0; h < 16; ++h) fa[h] = 0.f;
#pragma unroll
                for (int j = 0; j < 4; ++j) {
#pragma unroll
                    for (int i = 0; i < 4; ++i) { const LAS f32x4* wp = (const LAS f32x4*)wfg + ((j * 4 + i) * 4) * 64 + lane; const float xv = v[j][i];
#pragma unroll
                        for (int q = 0; q < 4; ++q) { const f32x4 w4 = wp[q * 64]; fa[4 * q + 0] += xv * w4[0]; fa[4 * q + 1] += xv * w4[1]; fa[4 * q + 2] += xv * w4[2]; fa[4 * q + 3] += xv * w4[3]; } }
                    asm volatile("" ::: "memory"); }
#pragma unroll
                for (int h = 0; h < 16; ++h) fa[h] = wave_sum(fa[h]);
                if (lane == 0) rs0[m] = r;
                if (lane < 16) { float fv = 0.f;
#pragma unroll
                    for (int h = 0; h < 16; ++h) fv = (lane == h) ? fa[h] : fv;
                    const float z = fv * r + bf_[lane];
                    logf_[(size_t)m * NH + lane] = fminf(z, 0.f) - log1pf(expf(-fabsf(z))); }
            }
            __syncthreads();
        }
        const float* pin_ = p_in;
        if (p0parts & 1) {
            const size_t nth = (size_t)NGW * 64, i0 = (size_t)gw * 64 + lane, tot = (size_t)2 * MT * DP / 4;
            for (size_t ib = i0; ib < tot; ib += 8 * nth) { f32x4 v[8];
#pragma unroll
                for (int u = 0; u < 8; ++u) if (ib + u * nth < tot) v[u] = ((const GAS f32x4*)pin_)[ib + u * nth];
#pragma unroll
                for (int u = 0; u < 8; ++u) if (ib + u * nth < tot) { u32x2 w; w.x = pk2(v[u][0], v[u][1]); w.y = pk2(v[u][2], v[u][3]); ((GAS u32x2*)PB)[ib + u * nth] = w; } }
        }
        LAS float* scr = (LAS float*)(lds + wave * 16640);
        if (p0parts & 2) {
            ConvDesc dA, dB; f32x4 vA[16], vB[16], gA[2], gB[2];
            int it = gw;
            if (it < CONV_NITEMS) { dA = conv_decode(it, ws); conv_load(dA, vA, gA, lane); }
            while (it < CONV_NITEMS) {
                const bool hb = it + NGW < CONV_NITEMS;
                if (hb) { dB = conv_decode(it + NGW, ws); conv_load(dB, vB, gB, lane); }
                conv_store(dA, vA, gA, scr, lane);
                if (!hb) break;
                const bool ha = it + 2 * NGW < CONV_NITEMS;
                if (ha) { dA = conv_decode(it + 2 * NGW, ws); conv_load(dA, vA, gA, lane); }
                conv_store(dB, vB, gB, scr, lane);
                it += 2 * NGW;
                if (!ha) break;
            }
        }
    }
    SEAM(0);

    if (IN(1)) { FRESH_IDS
        pg8::Gemm g{HBA, W_IN, DM}; pg8::StaticOrder S; S.init(MT, 3 * DM, G, bx);
        pg8::EpiQKV E{QB, (size_t)(WS_K - WS_Q) / 2, 0, pg8::RowScale{rs0, 0}};
        pg8::gemm_phase(lds, g, S, E);
    }
    SEAM(1);

    if (IN(2)) { FRESH_IDS
#if !defined(NAIVE_FOX)
        static_assert(fox_body::LDS_BYTES <= RING_BYTES, "attention scratch vs LDS ring");
        const fox_body::AttnTensors AT{(const fox_body::bf16*)QB, (const fox_body::bf16*)KB, (const fox_body::bf16*)VB, (fox_body::bf16*)OB, logf_};
        const fox_body::StaticOrder S(G, bx);
        fox_body::attn_phase<fox_body::StaticOrder>((char*)lds_raw, AT, S);
        __syncthreads();
    }
#else
        const int zero = opaque_zero();
        for (int j = 0; j < 2; ++j) {
            const int it = gw + j * NGW; if (it >= NB * NH * 32) break;
            const int bh = it & 127, qq = it >> 7, qb = (j == 0) ? qq : 31 - (qq - 16);
            const int b = bh >> 4, h = bh & 15, t = qb * 64 + lane; const size_t row = (size_t)b * SEQ + t;
            float q[64], o[64];
            { const u32x4* qp = (const u32x4*)(QB + row * DM + h * HD);
#pragma unroll
              for (int c = 0; c < 8; ++c) { const u32x4 w = qp[c]; q[8 * c + 0] = bflo(w.x); q[8 * c + 1] = bfhi(w.x); q[8 * c + 2] = bflo(w.y); q[8 * c + 3] = bfhi(w.y); q[8 * c + 4] = bflo(w.z); q[8 * c + 5] = bfhi(w.z); q[8 * c + 6] = bflo(w.w); q[8 * c + 7] = bfhi(w.w); } }
#pragma unroll
            for (int d = 0; d < 64; ++d) o[d] = 0.f;
            const float* csb = cs + (size_t)bh * SEQ; const float ct = csb[t];
            float mx = -1e30f, l = 0.f;
            const int smax = qb * 64 + 63;
            for (int s = 0; s <= smax; ++s) {
                const size_t kro = ((size_t)b * SEQ + s) * DM + h * HD + zero;
                const u32x4* kp = (const u32x4*)(KB + kro); float dot = 0.f;
#pragma unroll
                for (int c = 0; c < 8; ++c) { const u32x4 w = kp[c]; dot += q[8 * c + 0] * bflo(w.x) + q[8 * c + 1] * bfhi(w.x) + q[8 * c + 2] * bflo(w.y) + q[8 * c + 3] * bfhi(w.y) + q[8 * c + 4] * bflo(w.z) + q[8 * c + 5] * bfhi(w.z) + q[8 * c + 6] * bflo(w.w) + q[8 * c + 7] * bfhi(w.w); }
                const float scv = dot + ct - csb[s + zero];
                if (s <= t) {
                    const float mn = fmaxf(mx, scv), a = __builtin_amdgcn_exp2f(mx - mn), pw = __builtin_amdgcn_exp2f(scv - mn);
                    l = l * a + pw; mx = mn;
                    const u32x4* vp = (const u32x4*)(VB + kro);
#pragma unroll
                    for (int c = 0; c < 8; ++c) { const u32x4 w = vp[c];
                        o[8 * c + 0] = o[8 * c + 0] * a + pw * bflo(w.x); o[8 * c + 1] = o[8 * c + 1] * a + pw * bfhi(w.x); o[8 * c + 2] = o[8 * c + 2] * a + pw * bflo(w.y); o[8 * c + 3] = o[8 * c + 3] * a + pw * bfhi(w.y);
                        o[8 * c + 4] = o[8 * c + 4] * a + pw * bflo(w.z); o[8 * c + 5] = o[8 * c + 5] * a + pw * bfhi(w.z); o[8 * c + 6] = o[8 * c + 6] * a + pw * bflo(w.w); o[8 * c + 7] = o[8 * c + 7] * a + pw * bfhi(w.w); }
                }
            }
            const float il = 1.0f / l; u32x4* op = (u32x4*)(OB + row * DM + h * HD);
#pragma unroll
            for (int c = 0; c < 8; ++c) { u32x4 w; w.x = pk2(o[8 * c + 0] * il, o[8 * c + 1] * il); w.y = pk2(o[8 * c + 2] * il, o[8 * c + 3] * il); w.z = pk2(o[8 * c + 4] * il, o[8 * c + 5] * il); w.w = pk2(o[8 * c + 6] * il, o[8 * c + 7] * il); op[c] = w; }
        }
    }
#endif
    SEAM(2);

    if (IN(3)) { FRESH_IDS
        pg8::Gemm g{OB, W_OA, DM}; pg8::StaticOrder S; S.init(MT, DM, G, bx);
        pg8::EpiResid E{HBA, slab1};
        pg8::gemm_phase(lds, g, S, E);
    }
    SEAM(3);

    if (IN(4)) { FRESH_IDS
        { pg8::Gemm g{HBA, W_GUD, DM}; pg8::StaticOrder S; S.init(MT, 2 * FD, G, bx);
          pg8::EpiSwiGLU E{ACTD, FD, pg8::RowScale{slab1, 1}};
          pg8::gemm_phase(lds, g, S, E); }
        {
          pg8::StaticOrder S; S.init(MT, DM, G / 2, bx >= G / 2 ? bx - G / 2 : (1 << 28));
          pg8::Gemm g{PB, W_PP, DP}; pg8::EpiBf16 E{PP, DM};
          pg8::gemm_phase(lds, g, S, E); }
    }
    SEAM(4);

    if (IN(5)) { FRESH_IDS
        pg8::Gemm g{ACTD, W_DD, FD}; pg8::StaticOrder S; S.init(MT, DM, G, bx);
        pg8::EpiResid E{HBA, nullptr};
        pg8::gemm_phase(lds, g, S, E);
    }
    SEAM(5);

    if (IN(6)) { FRESH_IDS
        pg8::Gemm g{HBA, W_PG, DM}; pg8::StaticOrder S; S.init(MT, DM, G, bx);
        pg8::EpiPLE E{HBA, PP, HBB, nullptr, slab3};
        pg8::gemm_phase(lds, g, S, E);
    }
    SEAM(6);

    if (IN(7)) { FRESH_IDS
        pg8::Gemm g{HBB, W_KVQ, DM}; pg8::StaticOrder S; S.init(MT, 3 * DM, G, bx);
        pg8::EpiQKV E{QB, (size_t)(WS_K - WS_Q) / 2, 1, pg8::RowScale{slab3, 1}};
        pg8::gemm_phase(lds, g, S, E);
    }
    SEAM(7);

    if (IN(8)) { FRESH_IDS
#if !defined(NAIVE_SB)
        static_assert(fox_body::SB_BYTES <= RING_BYTES, "attention scratch vs LDS ring");
        const fox_body::AttnTensors AT{(const fox_body::bf16*)QB, (const fox_body::bf16*)KB, (const fox_body::bf16*)VB, (fox_body::bf16*)OB, nullptr};
        const fox_body::StaticOrder S(G, bx);
        fox_body::sb_phase<fox_body::StaticOrder>((char*)lds_raw, AT, S);
        __syncthreads();
    }
#else
        const int zero = opaque_zero();
        for (int j = 0; j < 2; ++j) {
            const int it = gw + j * NGW; if (it >= NB * NH * 32) break;
            const int bh = it & 127, qq = it >> 7, qb = (j == 0) ? qq : 31 - (qq - 16);
            const int b = bh >> 4, h = bh & 15, t = qb * 64 + lane; const size_t row = (size_t)b * SEQ + t;
            float q[64], o[64];
            { const u32x4* qp = (const u32x4*)(QB + row * DM + h * HD);
#pragma unroll
              for (int c = 0; c < 8; ++c) { const u32x4 w = qp[c]; q[8 * c + 0] = bflo(w.x); q[8 * c + 1] = bfhi(w.x); q[8 * c + 2] = bflo(w.y); q[8 * c + 3] = bfhi(w.y); q[8 * c + 4] = bflo(w.z); q[8 * c + 5] = bfhi(w.z); q[8 * c + 6] = bflo(w.w); q[8 * c + 7] = bfhi(w.w); } }
#pragma unroll
            for (int d = 0; d < 64; ++d) o[d] = 0.f;
            float rem = 1.0f;
            for (int s = qb * 64 + 62; s >= 0; --s) {
                const size_t kro = ((size_t)b * SEQ + s) * DM + h * HD + zero;
                const u32x4* kp = (const u32x4*)(KB + kro); float dot = 0.f;
#pragma unroll
                for (int c = 0; c < 8; ++c) { const u32x4 w = kp[c]; dot += q[8 * c + 0] * bflo(w.x) + q[8 * c + 1] * bfhi(w.x) + q[8 * c + 2] * bflo(w.y) + q[8 * c + 3] * bfhi(w.y) + q[8 * c + 4] * bflo(w.z) + q[8 * c + 5] * bfhi(w.z) + q[8 * c + 6] * bflo(w.w) + q[8 * c + 7] * bfhi(w.w); }
                if (s < t) {
                    const float uu = __builtin_amdgcn_exp2f(dot), inv = 1.0f / (1.0f + uu), a = uu * inv * rem; rem *= inv;
                    const u32x4* vp = (const u32x4*)(VB + kro);
#pragma unroll
                    for (int c = 0; c < 8; ++c) { const u32x4 w = vp[c];
                        o[8 * c + 0] += a * bflo(w.x); o[8 * c + 1] += a * bfhi(w.x); o[8 * c + 2] += a * bflo(w.y); o[8 * c + 3] += a * bfhi(w.y);
                        o[8 * c + 4] += a * bflo(w.z); o[8 * c + 5] += a * bfhi(w.z); o[8 * c + 6] += a * bflo(w.w); o[8 * c + 7] += a * bfhi(w.w); }
                }
            }
            u32x4* op = (u32x4*)(OB + row * DM + h * HD);
#pragma unroll
            for (int c = 0; c < 8; ++c) { u32x4 w; w.x = pk2(o[8 * c + 0], o[8 * c + 1]); w.y = pk2(o[8 * c + 2], o[8 * c + 3]); w.z = pk2(o[8 * c + 4], o[8 * c + 5]); w.w = pk2(o[8 * c + 6], o[8 * c + 7]); op[c] = w; }
        }
    }
#endif
    SEAM(8);

    if (IN(9)) { FRESH_IDS
        pg8::Gemm g{OB, W_OB, DM}; pg8::StaticOrder S; S.init(MT, DM, G, bx);
        pg8::EpiResid E{HBB, nullptr};
        pg8::gemm_phase(lds, g, S, E);
    }
    SEAM(9);

    if (IN(10)) { FRESH_IDS
        LAS float* wrg = (LAS float*)lds;
        LAS int* lsel = (LAS int*)(lds + 32768);
        { const float* fn_ = ffn_norm; const float* rw_ = router_w;
          float tmp[16];
#pragma unroll
          for (int u = 0; u < 16; ++u) { const int i = tid + u * (NW * 64); tmp[u] = fn_[DM + (i >> 3)] * rw_[i]; }
#pragma unroll
          for (int u = 0; u < 16; ++u) { const int i = tid + u * (NW * 64), k = i >> 3, e = i & 7;
              wrg[((((((k >> 8) * 4 + (k & 3)) * 2 + (e >> 2)) * 64) + ((k & 255) >> 2)) << 2) + (e & 3)] = tmp[u]; } }
        const float* rb_ = router_b;
        __syncthreads();
        u32x2 vn[4];
        { const GAS u32x2* hr = (const GAS u32x2*)(HBB + (size_t)(vcu * 64 + wave * 8) * DM) + lane;
#pragma unroll
          for (int q = 0; q < 4; ++q) vn[q] = hr[64 * q]; }
        for (int j = 0; j < 8; ++j) {
            const int rl = wave * 8 + j, row = vcu * 64 + rl;
            f32x4 v[4]; float s = 0.f;
#pragma unroll
            for (int q = 0; q < 4; ++q) v[q] = (f32x4){bflo(vn[q].x), bfhi(vn[q].x), bflo(vn[q].y), bfhi(vn[q].y)};
            if (j < 7) { const GAS u32x2* hr = (const GAS u32x2*)(HBB + (size_t)(row + 1) * DM) + lane;
#pragma unroll
                for (int q = 0; q < 4; ++q) vn[q] = hr[64 * q]; }
#pragma unroll
            for (int q = 0; q < 4; ++q) s += (v[q][0] * v[q][0] + v[q][1] * v[q][1]) + (v[q][2] * v[q][2] + v[q][3] * v[q][3]);
            const float r = 1.0f / sqrtf(wave_sum(s) * (1.0f / DM) + RMS_EPS);
            float la[8];
#pragma unroll
            for (int e = 0; e < 8; ++e) la[e] = 0.f;
#pragma unroll
            for (int q = 0; q < 4; ++q)
#pragma unroll
                for (int i = 0; i < 4; ++i) { const LAS f32x4* wp = (const LAS f32x4*)wrg + ((q * 4 + i) * 2) * 64 + lane; const float xv = v[q][i]; const f32x4 w0 = wp[0], w1 = wp[64];
                    la[0] += xv * w0[0]; la[1] += xv * w0[1]; la[2] += xv * w0[2]; la[3] += xv * w0[3]; la[4] += xv * w1[0]; la[5] += xv * w1[1]; la[6] += xv * w1[2]; la[7] += xv * w1[3]; }
#pragma unroll
            for (int e = 0; e < 8; ++e) la[e] = wave_sum(la[e]) * r + rb_[e];
            int e1 = 0; float v1 = la[0];
#pragma unroll
            for (int e = 1; e < 8; ++e) if (la[e] > v1) { v1 = la[e]; e1 = e; }
            int e2 = -1; float v2 = -3.0e38f;
#pragma unroll
            for (int e = 0; e < 8; ++e) if (e != e1 && la[e] > v2) { v2 = la[e]; e2 = e; }
            if (lane == 0) { const float g1 = 1.0f / (1.0f + expf(v2 - v1)); lsel[rl] = e1 | (e2 << 8); selE[row] = e1 | (e2 << 8); selG[row] = g1; rr4[row] = r; }
        }
        __syncthreads();
        if (tid < NE) { int c = 0; for (int i = 0; i < 64; ++i) { const int se = lsel[i]; c += ((se & 255) == tid) + ((se >> 8) == tid); } __hip_atomic_store(cntwg + vcu * 8 + tid, c, RLX_AGENT); }
        __syncthreads();
    }
    SEAM(10);

    if (IN(11)) { FRESH_IDS
        volatile LAS int* L = (volatile LAS int*)(lds + 65536);
        LAS int* lsel = (LAS int*)(lds + 32768); LAS int* lpos = (LAS int*)(lds + 33024);
        moe_prefix(cntwg, vcu, L, wave, lane);
        if (tid < 64) lsel[tid] = selE[vcu * 64 + tid];
        __syncthreads();
        if (tid < 128) { const int i = tid >> 1, k = tid & 1; const int se = lsel[i]; const int e = k ? (se >> 8) : (se & 255); int rank = 0;
            for (int i2 = 0; i2 <= i; ++i2) { const int s2 = lsel[i2]; if ((s2 & 255) == e && (i2 < i || k == 1)) ++rank; if ((s2 >> 8) == e && i2 < i) ++rank; }
            const int pos = 256 * L[e] + L[32 + e] + rank; lpos[tid] = pos; tokpos[(vcu * 64 + i) * 2 + k] = pos;
            const float g1 = selG[vcu * 64 + i]; grow[pos] = k ? 1.0f - g1 : g1; }
        __syncthreads();
#pragma unroll 1
        for (int jb = 0; jb < 8; jb += 4) {
            u32x2 v[4][4]; float rq[4];
#pragma unroll
            for (int j = 0; j < 4; ++j) { const int row = vcu * 64 + wave * 8 + jb + j; rq[j] = rr4[row]; const GAS u32x2* hr = (const GAS u32x2*)(HBB + (size_t)row * DM) + lane;
#pragma unroll
                for (int q = 0; q < 4; ++q) v[j][q] = hr[64 * q]; }
#pragma unroll
            for (int j = 0; j < 4; ++j) { const int rl = wave * 8 + jb + j;
                GAS unsigned* d0 = (GAS unsigned*)((GAS unsigned char*)XG + (size_t)lpos[rl * 2] * DM) + lane; GAS unsigned* d1 = (GAS unsigned*)((GAS unsigned char*)XG + (size_t)lpos[rl * 2 + 1] * DM) + lane;
#pragma unroll
                for (int q = 0; q < 4; ++q) { const float r_ = rq[j]; int w = __builtin_amdgcn_cvt_pk_fp8_f32(bflo(v[j][q].x) * r_, bfhi(v[j][q].x) * r_, 0, false); w = __builtin_amdgcn_cvt_pk_fp8_f32(bflo(v[j][q].y) * r_, bfhi(v[j][q].y) * r_, w, true); d0[64 * q] = (unsigned)w; d1[64 * q] = (unsigned)w; } }
        }
        __syncthreads();
    }
    SEAM(11);

    if (IN(12)) { FRESH_IDS
        volatile LAS int* L = (volatile LAS int*)(lds + 65536);
        moe_prefix(cntwg, vcu, L, wave, lane);
        pg8::MoeOrder S; for (int e = 0; e <= NE; ++e) S.mtp[e] = L[e]; S.nN = 2 * FE / 256; S.brows = 2 * FE; S.G = G; S.c = bx;
        __syncthreads();
        pg8::Gemm g{XG, W_GUM, DM / 2};
        pg8::EpiSwiGLU E{ACTM, FE, pg8::RowScale{nullptr, 2}};
        pg8::gemm_phase_fp8(lds, g, S, E);
    }
    SEAM(12);

    if (IN(13)) { FRESH_IDS
        volatile LAS int* L = (volatile LAS int*)(lds + 65536);
        moe_prefix(cntwg, vcu, L, wave, lane);
        pg8::MoeOrder S; for (int e = 0; e <= NE; ++e) S.mtp[e] = L[e]; S.nN = DM / 256; S.brows = DM; S.G = G; S.c = bx;
        __syncthreads();
        pg8::Gemm g{ACTM, W_DM, FE};
        pg8::EpiMoeDown E{YB, grow};
        pg8::gemm_phase(lds, g, S, E);
        {
          const int nwg = S.mtp[NE] * (DM / 256), full = (nwg / G) * G, busy = nwg - full, idle = G - busy;
          pg8::StaticOrder S2; if (idle > 0 && busy > 0) S2.init(MT, DM, idle, bx >= busy ? bx - busy : (1 << 28)); else S2.init(MT, DM, G, bx);
          pg8::Gemm g2{PB + (size_t)MT * DP, W_PP + (size_t)DM * DP, DP}; pg8::EpiBf16 E2{PP + (size_t)MT * DM, DM};
          pg8::gemm_phase(lds, g2, S2, E2); }
    }
    SEAM(13);

    if (IN(14)) { FRESH_IDS
        {
            const int* tp_ = tokpos;
            int pc0 = 0, pc1 = 0, pn0 = 0, pn1 = 0;
            if (gw < MT) { pc0 = tp_[2 * gw]; pc1 = tp_[2 * gw + 1]; }
            if (gw + NGW < MT) { pn0 = tp_[2 * (gw + NGW)]; pn1 = tp_[2 * (gw + NGW) + 1]; }
            u32x2 hv[4], ya[4], yb[4];
            if (gw < MT) { const GAS u32x2* hr = (const GAS u32x2*)(HBB + (size_t)gw * DM) + lane; const GAS u32x2* y0 = (const GAS u32x2*)(YB + (size_t)pc0 * DM) + lane; const GAS u32x2* y1 = (const GAS u32x2*)(YB + (size_t)pc1 * DM) + lane;
#pragma unroll
                for (int q = 0; q < 4; ++q) { hv[q] = hr[64 * q]; ya[q] = y0[64 * q]; yb[q] = y1[64 * q]; } }
            for (int m = gw; m < MT; m += NGW) {
                u32x2 v[4], a[4], b[4];
#pragma unroll
                for (int q = 0; q < 4; ++q) { v[q] = hv[q]; a[q] = ya[q]; b[q] = yb[q]; }
                const int mn = m + NGW, mnn = m + 2 * NGW;
                if (mn < MT) { const GAS u32x2* hr = (const GAS u32x2*)(HBB + (size_t)mn * DM) + lane; const GAS u32x2* y0 = (const GAS u32x2*)(YB + (size_t)pn0 * DM) + lane; const GAS u32x2* y1 = (const GAS u32x2*)(YB + (size_t)pn1 * DM) + lane;
#pragma unroll
                    for (int q = 0; q < 4; ++q) { hv[q] = hr[64 * q]; ya[q] = y0[64 * q]; yb[q] = y1[64 * q]; } }
                if (mnn < MT) { pn0 = tp_[2 * mnn]; pn1 = tp_[2 * mnn + 1]; }
                GAS u32x2* hb = (GAS u32x2*)(HBA + (size_t)m * DM) + lane;
#pragma unroll
                for (int q = 0; q < 4; ++q) { u32x2 w;
                    w.x = pk2(bflo(v[q].x) + (bflo(a[q].x) + bflo(b[q].x)), bfhi(v[q].x) + (bfhi(a[q].x) + bfhi(b[q].x)));
                    w.y = pk2(bflo(v[q].y) + (bflo(a[q].y) + bflo(b[q].y)), bfhi(v[q].y) + (bfhi(a[q].y) + bfhi(b[q].y))); hb[64 * q] = w; }
            }
        }
    }
    SEAM(14);

    if (IN(15)) { FRESH_IDS
        pg8::Gemm g{HBA, W_PG + (size_t)DM * DM, DM}; pg8::StaticOrder S; S.init(MT, DM, G, bx);
        pg8::EpiPLE E{HBA, PP + (size_t)MT * DM, nullptr, hres, slab6};
        pg8::gemm_phase(lds, g, S, E);
    }
    SEAM(15);

    if (IN(16)) { FRESH_IDS
        f32x4 gn[4];
        { const float* fnm_ = final_norm;
#pragma unroll
        for (int q = 0; q < 4; ++q) gn[q] = ((const GAS f32x4*)fnm_)[lane + 64 * q]; }
        {
            f32x4 vn[4], sqn;
            if (gw < MT) { const GAS f32x4* hr = (const GAS f32x4*)(hres + (size_t)gw * DM) + lane; sqn = *(const GAS f32x4*)(slab6 + 4 * (size_t)gw);
#pragma unroll
                for (int q = 0; q < 4; ++q) vn[q] = hr[64 * q]; }
            for (int m = gw; m < MT; m += NGW) {
                f32x4 v[4]; const f32x4 sq = sqn;
#pragma unroll
                for (int q = 0; q < 4; ++q) v[q] = vn[q];
                if (m + NGW < MT) { const GAS f32x4* hr = (const GAS f32x4*)(hres + (size_t)(m + NGW) * DM) + lane; sqn = *(const GAS f32x4*)(slab6 + 4 * (size_t)(m + NGW));
#pragma unroll
                    for (int q = 0; q < 4; ++q) vn[q] = hr[64 * q]; }
                const float r = __builtin_amdgcn_rsqf(((sq[0] + sq[1]) + (sq[2] + sq[3])) * (1.0f / DM) + RMS_EPS);
                GAS f32x4* ho = (GAS f32x4*)(hres + (size_t)m * DM) + lane;
#pragma unroll
                for (int q = 0; q < 4; ++q) ho[64 * q] = v[q] * r * gn[q];
            }
        }
    }
#undef IN
#undef SEAM
}

extern "C" void kernel_launch(void* const* d_in, const int* in_sizes, int n_in, void* d_out, int out_size, void* d_ws, size_t ws_size, hipStream_t stream) {
    static int grid = 0;
    if (grid == 0) {
        if (n_in != 20 || in_sizes[0] != MT * DM || out_size != MT * DM || ws_size < WS_END) { fprintf(stderr, "kernel_launch: unexpected shapes (n_in %d, in0 %d, out %d, ws %zu < %zu)\n", n_in, n_in > 0 ? in_sizes[0] : -1, out_size, ws_size, (size_t)WS_END); grid = -1; return; }
        int dev = 0, cus = 0, per_cu = 0;
        if (hipGetDevice(&dev) != hipSuccess || hipDeviceGetAttribute(&cus, hipDeviceAttributeMultiprocessorCount, dev) != hipSuccess) { grid = -1; return; }
        if (hipFuncSetAttribute((const void*)fwd_kernel, hipFuncAttributeMaxDynamicSharedMemorySize, LDS_BYTES) != hipSuccess) { fprintf(stderr, "kernel_launch: hipFuncSetAttribute failed\n"); grid = -1; return; }
        if (hipOccupancyMaxActiveBlocksPerMultiprocessor(&per_cu, (const void*)fwd_kernel, NW * 64, LDS_BYTES) != hipSuccess || per_cu < 1) { fprintf(stderr, "kernel_launch: occupancy query says %d blocks per CU\n", per_cu); per_cu = 1; }
        (void)hipGetLastError();
        grid = cus;
        if (grid != 256) fprintf(stderr, "kernel_launch: %d CUs; this kernel is written for 256\n", grid);
    }
    if (grid < 0) return;
    if (hipMemsetAsync((char*)d_ws + WS_CTL, 0, CTL_ZERO_BYTES, stream) != hipSuccess) return;
    Args a{};
    for (int i = 0; i < 20; ++i) a.in[i] = (const float*)d_in[i];
    a.out = (float*)d_out; a.ws = (unsigned char*)d_ws; a.pad = 3;
#if defined(PROBE_REP_LO)
    a.ph_lo = 0; a.ph_hi = PROBE_REP_HI + 1; a.li = 0; hipLaunchKernelGGL(fwd_kernel, dim3(grid), dim3(NW * 64), LDS_BYTES, stream, a);
#if defined(PROBE_P0PARTS)
    a.pad = PROBE_P0PARTS;
#endif
    a.ph_lo = PROBE_REP_LO; a.ph_hi = NPH; a.li = 1; hipLaunchKernelGGL(fwd_kernel, dim3(grid), dim3(NW * 64), LDS_BYTES, stream, a);
#else
    for (int li = 0; li < N_LAUNCHES; ++li) {
        a.ph_lo = (N_LAUNCHES == NPH) ? li : 0; a.ph_hi = (N_LAUNCHES == NPH) ? li + 1 : NPH; a.li = (N_LAUNCHES == NPH) ? 0 : li;
        hipLaunchKernelGGL(fwd_kernel, dim3(grid), dim3(NW * 64), LDS_BYTES, stream, a);
    }
#endif
}
```

```cpp
#include <hip/hip_runtime.h>
#include <hip/hip_bf16.h>
#include <cstdio>
#include <cstdint>

#define LAS __attribute__((address_space(3)))
#define GAS __attribute__((address_space(1)))
typedef unsigned short bf16_t;
typedef short bf16x8 __attribute__((ext_vector_type(8)));
typedef float f32x4 __attribute__((ext_vector_type(4)));
typedef float f32x2 __attribute__((ext_vector_type(2)));
typedef unsigned u32x4 __attribute__((ext_vector_type(4)));
typedef unsigned u32x2 __attribute__((ext_vector_type(2)));

#ifndef MK_N_LAUNCHES
#define MK_N_LAUNCHES 1
#endif
constexpr int NPH = 17;
constexpr int N_LAUNCHES = MK_N_LAUNCHES;

constexpr int NB = 8, SEQ = 2048, DM = 1024, NH = 16, HD = 64, MT = NB * SEQ, FD = 2816, FE = 3584, NE = 8, DP = 256;
constexpr int NW = 8;
constexpr float RMS_EPS = 1e-6f, LOG2E = 1.4426950408889634f, C2 = 0.125f * 1.4426950408889634f;
constexpr int MOE_ROWS = 2 * MT + NE * 256;

constexpr size_t MiB = 1u << 20, KiB = 1u << 10;
constexpr size_t WS_CTL = 0, CTL_ZERO_BYTES = 1 * MiB;
constexpr size_t WS_SMALL = 1 * MiB;
constexpr size_t WS_RS0 = WS_SMALL, WS_SLAB1 = WS_SMALL + 64 * KiB, WS_SLAB3 = WS_SMALL + 320 * KiB, WS_SLAB6 = WS_SMALL + 576 * KiB;
constexpr size_t WS_LOGF = WS_SMALL + 1024 * KiB, WS_CS = WS_SMALL + 2048 * KiB, WS_CNTWG = WS_SMALL + 3072 * KiB;
constexpr size_t WS_SELE = WS_SMALL + 3136 * KiB, WS_SELG = WS_SMALL + 3200 * KiB, WS_RR4 = WS_SMALL + 3264 * KiB, WS_TOKPOS = WS_SMALL + 3328 * KiB, WS_GROW = WS_SMALL + 3456 * KiB;
constexpr size_t WS_W_IN = 8 * MiB, WS_W_OA = 14 * MiB, WS_W_KVQ = 16 * MiB, WS_W_OB = 22 * MiB, WS_W_GUD = 24 * MiB, WS_W_DD = 35 * MiB, WS_W_PP = 41 * MiB, WS_W_PG = 42 * MiB;
constexpr size_t WS_W_GUM = 46 * MiB, WS_W_DM = 158 * MiB;
constexpr size_t WS_HBA = 214 * MiB, WS_HBB = 246 * MiB, WS_PB = 278 * MiB, WS_PP = 294 * MiB, WS_XGY = 358 * MiB;
constexpr size_t WS_ARENA = 426 * MiB, WS_Q = 426 * MiB, WS_K = 458 * MiB, WS_V = 490 * MiB, WS_O = 522 * MiB, WS_ACTD = 554 * MiB, WS_ACTM = WS_ARENA;
constexpr size_t WS_END = 664 * MiB;
static_assert(WS_ACTM + (size_t)MOE_ROWS * FE * 2 <= WS_END && WS_ACTD + (size_t)MT * FD * 2 <= WS_END && WS_XGY + (size_t)MOE_ROWS * DM * 2 <= WS_ARENA, "ws map");
static_assert(WS_W_GUM + (size_t)NE * 2 * FE * DM * 2 <= WS_W_DM && WS_W_DM + (size_t)NE * DM * FE * 2 <= WS_HBA && WS_GROW + (size_t)MOE_ROWS * 4 <= WS_W_IN, "ws map 2");
constexpr int CW_BAR = 4096;
static_assert(WS_V - WS_K == WS_K - WS_Q, "Q|K|V equally spaced");

constexpr int RING_BYTES = 133120;
constexpr int LDSCTL_OFF = RING_BYTES, MISC_OFF = LDSCTL_OFF + 320;
constexpr int LDS_BYTES = 147456;
static_assert(MISC_OFF + 1024 <= LDS_BYTES, "lds map");

typedef GAS unsigned gu32;
#define RLX_AGENT __ATOMIC_RELAXED, __HIP_MEMORY_SCOPE_AGENT
#define LDS_WAIT() asm volatile("s_waitcnt lgkmcnt(0)" ::: "memory")
#define VM_WAIT() asm volatile("s_waitcnt vmcnt(0)" ::: "memory")
__device__ __forceinline__ unsigned f2bf(float f) { unsigned u = __builtin_bit_cast(unsigned, f); return (u + 0x7fffu + ((u >> 16) & 1u)) >> 16; }
typedef __bf16 bf16x2_t __attribute__((ext_vector_type(2)));
__device__ __forceinline__ unsigned pk2(float lo, float hi) { const f32x2 v = {lo, hi}; return __builtin_bit_cast(unsigned, __builtin_convertvector(v, bf16x2_t)); }
__device__ __forceinline__ float bflo(unsigned w) { return __builtin_bit_cast(float, w << 16); }
__device__ __forceinline__ float bfhi(unsigned w) { return __builtin_bit_cast(float, w & 0xffff0000u); }
__device__ __forceinline__ float wave_sum(float v) {
    v += __builtin_bit_cast(float, __builtin_amdgcn_update_dpp(0, __builtin_bit_cast(int, v), 0xB1, 0xf, 0xf, true));
    v += __builtin_bit_cast(float, __builtin_amdgcn_update_dpp(0, __builtin_bit_cast(int, v), 0x4E, 0xf, 0xf, true));
    v += __builtin_bit_cast(float, __builtin_amdgcn_update_dpp(0, __builtin_bit_cast(int, v), 0x141, 0xf, 0xf, true));
    v += __builtin_bit_cast(float, __builtin_amdgcn_update_dpp(0, __builtin_bit_cast(int, v), 0x140, 0xf, 0xf, true));
    v += __builtin_bit_cast(float, __builtin_amdgcn_update_dpp(0, __builtin_bit_cast(int, v), 0x142, 0xa, 0xf, false));
    v += __builtin_bit_cast(float, __builtin_amdgcn_update_dpp(0, __builtin_bit_cast(int, v), 0x143, 0xc, 0xf, false));
    return __builtin_bit_cast(float, __builtin_amdgcn_readlane(__builtin_bit_cast(int, v), 63));
}
__device__ __forceinline__ int opaque_zero() { int z; asm volatile("v_mov_b32 %0, 0" : "=v"(z)); return z; }

#define XB_TMO      128
#define XB_XCNT(j)  (256  + 64 * (j))
#define XB_XSUB(j)  (1280 + 64 * (j))
#define XB_XGEN(j)  (2304 + 64 * (j))
#define XB_TOP      3328
#define XB_TOPGEN   3392
#define XCD_BAR_WORDS 3456
#define XB_SPIN_CAP (1u << 20)
__device__ __forceinline__ unsigned xb_ld(unsigned* p)              { return __hip_atomic_load(p, __ATOMIC_RELAXED, __HIP_MEMORY_SCOPE_AGENT); }
__device__ __forceinline__ unsigned xb_add(unsigned* p, unsigned v) { return __hip_atomic_fetch_add(p, v, __ATOMIC_RELAXED, __HIP_MEMORY_SCOPE_AGENT); }
__device__ __forceinline__ unsigned xb_xcc_id() { return (unsigned)__builtin_amdgcn_s_getreg((3 << 11) | 20) & 0xFu; }
#define XB_SPIN(cond, bar) do { unsigned _sp = 0; while (cond) { __builtin_amdgcn_s_sleep(1); \
    if ((++_sp & 255u) == 0u) { if (xb_ld(&(bar)[XB_TMO])) break; if (_sp > XB_SPIN_CAP) { atomicAdd(&(bar)[XB_TMO], 1u); break; } } } } while (0)
struct XcdBarrier { unsigned* bar; unsigned x; volatile LAS unsigned* st; };
__device__ __forceinline__ XcdBarrier xcd_barrier_post(unsigned* bar, volatile LAS unsigned* st) {
    XcdBarrier b; b.bar = bar; b.x = xb_xcc_id(); b.st = st;
    if (threadIdx.x == 0) (void)xb_add(&bar[XB_XCNT(b.x)], 1u);
    return b;
}
__device__ __forceinline__ void xcd_barrier_complete(unsigned* bar, unsigned x, unsigned& nloc, unsigned& nx) {
    const unsigned G = gridDim.x * gridDim.y * gridDim.z;
    unsigned sum, cnt, mine, sp = 0u;
    for (;;) {
        sum = 0u; cnt = 0u; mine = 0u;
#pragma unroll
        for (unsigned j = 0; j < 16; ++j) { const unsigned c = xb_ld(&bar[XB_XCNT(j)]); sum += c; cnt += (c > 0u) ? 1u : 0u; mine = (j == x) ? c : mine; }
        if (sum == G) break;
        __builtin_amdgcn_s_sleep(1);
        if ((++sp & 255u) == 0u) { if (xb_ld(&bar[XB_TMO])) break; if (sp > XB_SPIN_CAP) { atomicAdd(&bar[XB_TMO], 1u); break; } }
    }
    nloc = mine > 0u ? mine : 1u; nx = cnt > 0u ? cnt : 1u;
}
__device__ __forceinline__ void xcd_barrier(const XcdBarrier& b) {
    asm volatile("s_waitcnt vmcnt(0)" ::: "memory");
    __syncthreads();
    if (threadIdx.x == 0) {
        unsigned* bar = b.bar;
        __builtin_amdgcn_s_waitcnt(0);
        unsigned nloc = b.st[0], nx = b.st[1];
        if (nloc == 0u) { xcd_barrier_complete(bar, b.x, nloc, nx); b.st[0] = nloc; b.st[1] = nx; }
        const unsigned old = xb_add(&bar[XB_XSUB(b.x)], 1u);
        const unsigned gen = old / nloc;
        if (old + 1u == (gen + 1u) * nloc) {
            __builtin_amdgcn_fence(__ATOMIC_RELEASE, "agent");
            asm volatile("s_waitcnt vmcnt(0)" ::: "memory");
            const unsigned og = xb_add(&bar[XB_TOP], 1u);
            const unsigned tg = og / nx;
            if (og + 1u == (tg + 1u) * nx) xb_add(&bar[XB_TOPGEN], 1u);
            else XB_SPIN(xb_ld(&bar[XB_TOPGEN]) == tg, bar);
            __builtin_amdgcn_fence(__ATOMIC_ACQUIRE, "agent");
            xb_add(&bar[XB_XGEN(b.x)], 1u);
            asm volatile("s_waitcnt vmcnt(0)" ::: "memory");
        } else {
            XB_SPIN(xb_ld(&bar[XB_XGEN(b.x)]) == gen, bar);
            __builtin_amdgcn_fence(__ATOMIC_ACQUIRE, "agent");
            asm volatile("s_waitcnt vmcnt(0)" ::: "memory");
        }
    }
    __syncthreads();
}

namespace pg8 {
constexpr int BM = 256, BK = 64, HALF = 128, NXCD = 8, WGM = 8;
__host__ __device__ __forceinline__ int perm32(int rho) { const int n = rho >> 4, i = rho & 15; return 8 * (i >> 2) + 4 * n + (i & 3); }
struct Unit { int arow, brow, orow, ocol; };
struct Gemm { const bf16_t* A; const bf16_t* Bt; int K; int sclW = 0x7F7F7F7F, sclX = 0x7F7F7F7F; };

__device__ __forceinline__ bool order_map(long L, int nM, int nN, int& pm, int& pn) {
    const int nwg = nM * nN; if (L >= nwg) return false;
    int wgid = (int)L; { const int q = nwg / NXCD, r = nwg % NXCD, xcd = wgid % NXCD, off = wgid / NXCD; wgid = (xcd < r ? xcd * (q + 1) : r * (q + 1) + (xcd - r) * q) + off; }
    const int nig = WGM * nN, gid = wgid / nig, fm = gid * WGM, gsz = (nM - fm) < WGM ? (nM - fm) : WGM;
    pm = fm + ((wgid % nig) % gsz); pn = (wgid % nig) / gsz; return true;
}
struct StaticOrder {
    int nM, nN, G, c;
    __device__ void init(int M, int N, int G_, int c_) { nM = M / BM; nN = N / BM; G = G_; c = c_; }
    __device__ __forceinline__ bool next(int i, Unit& u) const {
        int pm, pn; if (!order_map((long)i * G + c, nM, nN, pm, pn)) return false;
        u.arow = pm * BM; u.brow = pn * BM; u.orow = pm * BM; u.ocol = pn; return true;
    }
};
struct MoeOrder {
    int mtp[NE + 1]; int nN, brows, G, c;
    __device__ __forceinline__ bool next(int i, Unit& u) const {
        int pm, pn; if (!order_map((long)i * G + c, mtp[NE], nN, pm, pn)) return false;
        int e = 0;
#pragma unroll
        for (int j = 1; j < NE; ++j) e += (pm >= mtp[j]) ? 1 : 0;
        u.arow = pm * BM; u.orow = pm * BM; u.brow = e * brows + pn * BM; u.ocol = pn; return true;
    }
};

struct RowScale {
    const float* p; int mode;
    __device__ __forceinline__ float get(int row) const {
        if (mode == 0) return p[row];
        if (mode == 1) { const f32x4 q = *(const f32x4*)(p + 4 * (size_t)row); return __builtin_amdgcn_rsqf(((q[0] + q[1]) + (q[2] + q[3])) * (1.0f / DM) + RMS_EPS); }
        return 1.0f;
    }
};
struct EpiQKV {
    static constexpr bool PERM = true, AFTER_DRAIN = false;
    bf16_t* base; size_t stride; int rot; RowScale R;
    __device__ __forceinline__ void operator()(const f32x4 (&acc)[2][4][2], int ai, const Unit& u, int wr, int wc, int fr, int fq) const {
        int d = (u.ocol >> 2) + rot; d = d >= 3 ? d - 3 : d; bf16_t* ob = base + (size_t)d * stride; const float sc = d == 0 ? C2 : 1.0f;
        const int col0 = (u.ocol & 3) * BM + wc * 32 + 8 * fq;
#pragma unroll
            for (int m = 0; m < 4; ++m) { const int row = u.orow + ai * HALF + wr * 64 + m * 16 + fr; const float rr = R.get(row) * sc; bf16_t* rowp = ob + (size_t)row * DM + col0;
#pragma unroll
                for (int bj = 0; bj < 2; ++bj) { const f32x4 v0 = acc[bj][m][0] * rr, v1 = acc[bj][m][1] * rr;
                    u32x4 w; w.x = pk2(v0[0], v0[1]); w.y = pk2(v0[2], v0[3]); w.z = pk2(v1[0], v1[1]); w.w = pk2(v1[2], v1[3]);
                    *(u32x4*)(rowp + bj * HALF) = w; } }
    }
};
struct EpiBf16 {
    static constexpr bool PERM = true, AFTER_DRAIN = false;
    bf16_t* O; int ldo;
    __device__ __forceinline__ void operator()(const f32x4 (&acc)[2][4][2], int ai, const Unit& u, int wr, int wc, int fr, int fq) const {
        const int col0 = u.ocol * BM + wc * 32 + 8 * fq;
#pragma unroll
            for (int m = 0; m < 4; ++m) { const int row = u.orow + ai * HALF + wr * 64 + m * 16 + fr; bf16_t* rowp = O + (size_t)row * ldo + col0;
#pragma unroll
                for (int bj = 0; bj < 2; ++bj) { const f32x4 v0 = acc[bj][m][0], v1 = acc[bj][m][1];
                    u32x4 w; w.x = pk2(v0[0], v0[1]); w.y = pk2(v0[2], v0[3]); w.z = pk2(v1[0], v1[1]); w.w = pk2(v1[2], v1[3]);
                    *(u32x4*)(rowp + bj * HALF) = w; } }
    }
};
struct EpiSwiGLU {
    static constexpr bool PERM = true, AFTER_DRAIN = false;
    bf16_t* O; int ldo; RowScale R;
    __device__ __forceinline__ void operator()(const f32x4 (&acc)[2][4][2], int ai, const Unit& u, int wr, int wc, int fr, int fq) const {
        const int col0 = u.ocol * HALF + wc * 32 + 8 * fq;
#pragma unroll
            for (int m = 0; m < 4; ++m) { const int row = u.orow + ai * HALF + wr * 64 + m * 16 + fr; const float rr = R.get(row); float o[8];
#pragma unroll
                for (int n = 0; n < 2; ++n)
#pragma unroll
                    for (int j = 0; j < 4; ++j) { const float g = acc[0][m][n][j] * rr, uu = acc[1][m][n][j] * rr;
                        o[n * 4 + j] = g * __builtin_amdgcn_rcpf(1.0f + __builtin_amdgcn_exp2f(-g * LOG2E)) * uu; }
                u32x4 w; w.x = pk2(o[0], o[1]); w.y = pk2(o[2], o[3]); w.z = pk2(o[4], o[5]); w.w = pk2(o[6], o[7]);
                *(u32x4*)(O + (size_t)row * ldo + col0) = w; asm volatile("" ::: "memory"); }
    }
};
struct EpiSwiGLU8 {
    static constexpr bool PERM = true, AFTER_DRAIN = false;
    unsigned char* O; int ldo;
    __device__ __forceinline__ void operator()(const f32x4 (&acc)[2][4][2], int ai, const Unit& u, int wr, int wc, int fr, int fq) const {
        const int col0 = u.ocol * HALF + wc * 32 + 8 * fq;
#pragma unroll
        for (int m = 0; m < 4; ++m) { const int row = u.orow + ai * HALF + wr * 64 + m * 16 + fr; float o[8];
#pragma unroll
            for (int n = 0; n < 2; ++n)
#pragma unroll
                for (int j = 0; j < 4; ++j) { const float g = acc[0][m][n][j], uu = acc[1][m][n][j];
                    o[n * 4 + j] = g * __builtin_amdgcn_rcpf(1.0f + __builtin_amdgcn_exp2f(-g * LOG2E)) * uu * 8.0f; }
            u32x2 w; int t_;
            t_ = __builtin_amdgcn_cvt_pk_fp8_f32(o[0], o[1], 0, false); t_ = __builtin_amdgcn_cvt_pk_fp8_f32(o[2], o[3], t_, true); w.x = (unsigned)t_;
            t_ = __builtin_amdgcn_cvt_pk_fp8_f32(o[4], o[5], 0, false); t_ = __builtin_amdgcn_cvt_pk_fp8_f32(o[6], o[7], t_, true); w.y = (unsigned)t_;
            *(u32x2*)(O + (size_t)row * ldo + col0) = w; asm volatile("" ::: "memory"); }
    }
};
struct EpiMoeDown {
    static constexpr bool PERM = true, AFTER_DRAIN = false;
    bf16_t* O; const float* gate;
    __device__ __forceinline__ void operator()(const f32x4 (&acc)[2][4][2], int ai, const Unit& u, int wr, int wc, int fr, int fq) const {
        const int col0 = u.ocol * BM + wc * 32 + 8 * fq;
#pragma unroll
            for (int m = 0; m < 4; ++m) { const int row = u.orow + ai * HALF + wr * 64 + m * 16 + fr; const float gt = gate[row]; bf16_t* rowp = O + (size_t)row * DM + col0;
#pragma unroll
                for (int bj = 0; bj < 2; ++bj) { const f32x4 v0 = acc[bj][m][0] * gt, v1 = acc[bj][m][1] * gt;
                    u32x4 w; w.x = pk2(v0[0], v0[1]); w.y = pk2(v0[2], v0[3]); w.z = pk2(v1[0], v1[1]); w.w = pk2(v1[2], v1[3]);
                    *(u32x4*)(rowp + bj * HALF) = w; } }
    }
};
__device__ __forceinline__ void row_sumsq_to_slab(const f32x4 (&v)[2][4][2], int ai, const Unit& u, int wr, int wc, int fr, int fq, LAS unsigned char* lds, float* slab) {
    LAS float* P = (LAS float*)lds;
#pragma unroll
    for (int m = 0; m < 4; ++m) { float s = 0.f;
#pragma unroll
        for (int bj = 0; bj < 2; ++bj)
#pragma unroll
            for (int n = 0; n < 2; ++n) { const f32x4 x = v[bj][m][n]; s += (x[0] * x[0] + x[1] * x[1]) + (x[2] * x[2] + x[3] * x[3]); }
        s += __shfl_xor(s, 16); s += __shfl_xor(s, 32);
        if (fq == 0) P[(wr * 64 + m * 16 + fr) * 4 + wc] = s; }
    __syncthreads();
    const int t = threadIdx.x;
    if (t < HALF) slab[(size_t)(u.orow + ai * HALF + t) * 4 + u.ocol] = (P[t * 4 + 0] + P[t * 4 + 1]) + (P[t * 4 + 2] + P[t * 4 + 3]);
    __syncthreads();
}
__device__ __forceinline__ void unpack8(const u32x4 w, f32x4& lo, f32x4& hi) { lo = (f32x4){bflo(w.x), bfhi(w.x), bflo(w.y), bfhi(w.y)}; hi = (f32x4){bflo(w.z), bfhi(w.z), bflo(w.w), bfhi(w.w)}; }
__device__ __forceinline__ u32x4 pack8(const f32x4 lo, const f32x4 hi) { u32x4 w; w.x = pk2(lo[0], lo[1]); w.y = pk2(lo[2], lo[3]); w.z = pk2(hi[0], hi[1]); w.w = pk2(hi[2], hi[3]); return w; }
struct EpiResid {
    static constexpr bool PERM = true, AFTER_DRAIN = true;
    bf16_t* hb; float* slab;
    __device__ __forceinline__ void fused(f32x4 (&acc)[2][4][2], int ai, const Unit& u, int wr, int wc, int fr, int fq, LAS unsigned char* lds) const {
        const int col0 = u.ocol * BM + wc * 32 + 8 * fq;
#pragma unroll
        for (int m = 0; m < 4; ++m) { bf16_t* rowp = hb + (size_t)(u.orow + ai * HALF + wr * 64 + m * 16 + fr) * DM + col0;
#pragma unroll
            for (int bj = 0; bj < 2; ++bj) { f32x4 lo, hi; unpack8(*(const u32x4*)(rowp + bj * HALF), lo, hi); lo += acc[bj][m][0]; hi += acc[bj][m][1];
                acc[bj][m][0] = lo; acc[bj][m][1] = hi; *(u32x4*)(rowp + bj * HALF) = pack8(lo, hi); }
            if (m & 1) asm volatile("" ::: "memory"); }
        if (slab) row_sumsq_to_slab(acc, ai, u, wr, wc, fr, fq, lds, slab);
    }
};
struct EpiPLE {
    static constexpr bool PERM = true, AFTER_DRAIN = true;
    const bf16_t* hin; const bf16_t* pp; bf16_t* hout; float* out32; float* slab;
    __device__ __forceinline__ void fused(f32x4 (&acc)[2][4][2], int ai, const Unit& u, int wr, int wc, int fr, int fq, LAS unsigned char* lds) const {
        const int col0 = u.ocol * BM + wc * 32 + 8 * fq;
#pragma unroll
        for (int m = 0; m < 4; ++m) { const size_t off = (size_t)(u.orow + ai * HALF + wr * 64 + m * 16 + fr) * DM + col0;
#pragma unroll
            for (int bj = 0; bj < 2; ++bj) { const size_t o2 = off + bj * HALF; f32x4 hl, hh, pl, ph; unpack8(*(const u32x4*)(hin + o2), hl, hh); unpack8(*(const u32x4*)(pp + o2), pl, ph);
                const f32x4 a0 = acc[bj][m][0], a1 = acc[bj][m][1];
#pragma unroll
                for (int j = 0; j < 4; ++j) { hl[j] += pl[j] * __builtin_amdgcn_rcpf(1.0f + __builtin_amdgcn_exp2f(-a0[j] * LOG2E)); hh[j] += ph[j] * __builtin_amdgcn_rcpf(1.0f + __builtin_amdgcn_exp2f(-a1[j] * LOG2E)); }
                acc[bj][m][0] = hl; acc[bj][m][1] = hh;
                if (out32) { *(f32x4*)(out32 + o2) = hl; *(f32x4*)(out32 + o2 + 4) = hh; } else *(u32x4*)(hout + o2) = pack8(hl, hh); }
            if (m & 1) asm volatile("" ::: "memory"); }
        if (slab) row_sumsq_to_slab(acc, ai, u, wr, wc, fr, fq, lds, slab);
    }
};

template <class Epi, class Sched>
__device__ __forceinline__ void gemm_simple(LAS unsigned char* lds, const Gemm g, const Sched& S, const Epi& E) {
    const int tid = threadIdx.x, wid = __builtin_amdgcn_readfirstlane(tid >> 6), lane = tid & 63, wr = wid >> 2, wc = wid & 3, fr = lane & 15, fq = lane >> 4;
    const int K = g.K, nt = K / BK;
    Unit u;
    for (int i = 0; S.next(i, u); ++i) {
        const int br0 = Epi::PERM ? perm32(fr) : fr, br1 = Epi::PERM ? perm32(16 + fr) : 16 + fr;
        const bf16_t* Bb = g.Bt + (size_t)(u.brow + wc * 32) * K + fq * 8;
#pragma unroll 1
        for (int ai = 0; ai < 2; ++ai) {
            f32x4 acc[2][4][2];
#pragma unroll
            for (int b = 0; b < 2; ++b)
#pragma unroll
                for (int m = 0; m < 4; ++m)
#pragma unroll
                    for (int n = 0; n < 2; ++n) acc[b][m][n] = (f32x4){0.f, 0.f, 0.f, 0.f};
            const bf16_t* Ab = g.A + (size_t)(u.arow + ai * HALF + wr * 64 + fr) * K + fq * 8;
#pragma unroll 1
            for (int t = 0; t < nt; ++t) {
                bf16x8 Af[4][2];
#pragma unroll
                for (int m = 0; m < 4; ++m)
#pragma unroll
                    for (int k = 0; k < 2; ++k) Af[m][k] = *(const bf16x8*)(Ab + (size_t)(m * 16) * K + t * BK + k * 32);
#pragma unroll
                for (int bj = 0; bj < 2; ++bj) {
                    bf16x8 Bf[2][2];
#pragma unroll
                    for (int k = 0; k < 2; ++k) { Bf[0][k] = *(const bf16x8*)(Bb + (size_t)(bj * HALF + br0) * K + t * BK + k * 32); Bf[1][k] = *(const bf16x8*)(Bb + (size_t)(bj * HALF + br1) * K + t * BK + k * 32); }
#pragma unroll
                    for (int m = 0; m < 4; ++m)
#pragma unroll
                        for (int n = 0; n < 2; ++n)
#pragma unroll
                            for (int k = 0; k < 2; ++k) acc[bj][m][n] = __builtin_amdgcn_mfma_f32_16x16x32_bf16(Bf[n][k], Af[m][k], acc[bj][m][n], 0, 0, 0);
                }
            }
            if constexpr (Epi::AFTER_DRAIN) { __syncthreads(); E.fused(acc, ai, u, wr, wc, fr, fq, lds); }
            else E(acc, ai, u, wr, wc, fr, fq);
        }
    }
}

constexpr int HTB = HALF * BK * 2  , STAGE_BYTES = 8 * HTB;
__host__ __device__ __forceinline__ int lds_byte(int r, int c) { const int st = (r >> 4) * 2 + (c >> 5), rr = r & 15, cc = c & 31, ob = rr * 64 + cc * 2; return st * 1024 + (ob ^ (((ob >> 9) & 1) << 5)); }
__host__ __device__ __forceinline__ void stage_rc(int b, int& R, int& C) { const int st = b / 1024, sb = b % 1024, swz = sb ^ (((sb >> 9) & 1) << 5); R = (st >> 1) * 16 + swz / 64; C = (st & 1) * 32 + (swz % 64) / 2; }
typedef int v8i32 __attribute__((ext_vector_type(8)));
template <class Epi, class Sched, bool ALIGN_EPI, bool FP8 = false>
__device__ __forceinline__ void gemm_fast(LAS unsigned char* lds, const Gemm g, const Sched& S, const Epi& E) {
    const int tid = threadIdx.x, wid = __builtin_amdgcn_readfirstlane(tid >> 6), lane = tid & 63, wr = wid >> 2, wc = wid & 3, fr = lane & 15, fq = lane >> 4;
    int K_ = g.K; asm volatile("" : "+s"(K_));
    const int K = K_, nt = K / BK;
    unsigned voffA[2], voffB[2];
#pragma unroll
    for (int i = 0; i < 2; ++i) { int R, C; stage_rc(tid * 16 + i * 8192, R, C); const int Rb = Epi::PERM ? ((R & ~31) + perm32(R & 31)) : R;
        voffA[i] = (unsigned)(R * K + C) * 2u; voffB[i] = (unsigned)(Rb * K + C) * 2u; }
    const size_t kstep = (size_t)(BK * 2);
    const size_t hstep = (size_t)HALF * K * 2;
    const size_t rstep = (size_t)K * 2;
    const unsigned ldsw = (unsigned)wid * 1024u;
    const int aoff = FP8 ? lds_byte(wr * 64 + fr, fq * 16) : lds_byte(wr * 64 + fr, fq * 8), boff = FP8 ? lds_byte(wc * 32 + fr, fq * 16) : lds_byte(wc * 32 + fr, fq * 8);

#define PG8_SA(b, h) (((b) * 2 + (h)) * HTB)
#define PG8_SB(b, h) ((4 + (b) * 2 + (h)) * HTB)
#define PG8_STAGE(bufoff, gbase, voff) do { _Pragma("unroll") for (int _i = 0; _i < 2; ++_i) \
        __builtin_amdgcn_global_load_lds((const unsigned*)((const char*)(gbase) + (voff)[_i]), (LAS unsigned*)(lds + (bufoff) + ldsw + _i * 8192), 16, 0, 0); } while (0)
#define PG8_LD8(addr) __builtin_bit_cast(v8i32, __builtin_shufflevector(*(const LAS u32x4*)(addr), *(const LAS u32x4*)((addr) + 16), 0, 1, 2, 3, 4, 5, 6, 7))
#define PG8_LDA(dst, b, h) do { if constexpr (FP8) { _Pragma("unroll") for (int m = 0; m < 4; ++m) dst##8[m] = PG8_LD8(lds + PG8_SA(b, h) + aoff + m * 2048); } \
        else { _Pragma("unroll") for (int m = 0; m < 4; ++m) _Pragma("unroll") for (int k = 0; k < 2; ++k) dst[FP8 ? 0 : m][k] = *(const LAS bf16x8*)(lds + PG8_SA(b, h) + aoff + m * 2048 + k * 1024); } } while (0)
#define PG8_LDB(dst, b, h) do { if constexpr (FP8) { _Pragma("unroll") for (int n = 0; n < 2; ++n) dst##8[n] = PG8_LD8(lds + PG8_SB(b, h) + boff + n * 2048); } \
        else { _Pragma("unroll") for (int n = 0; n < 2; ++n) _Pragma("unroll") for (int k = 0; k < 2; ++k) dst[FP8 ? 0 : n][k] = *(const LAS bf16x8*)(lds + PG8_SB(b, h) + boff + n * 2048 + k * 1024); } } while (0)
#define PG8_MMA(ai, bj, At, Bt) do { __builtin_amdgcn_s_setprio(1); _Pragma("unroll") for (int m = 0; m < 4; ++m) _Pragma("unroll") for (int n = 0; n < 2; ++n) { \
        if constexpr (FP8) asm volatile("v_mfma_scale_f32_16x16x128_f8f6f4 %0, %1, %2, %0, %3, %4 op_sel_hi:[0,0,0]" : "+v"(acc[ai][bj][m][n]) : "v"(Bt##8[n]), "v"(At##8[m]), "v"(sclW), "v"(sclX));   \
        else { _Pragma("unroll") for (int k = 0; k < 2; ++k) acc[ai][bj][m][n] = __builtin_amdgcn_mfma_f32_16x16x32_bf16(Bt[FP8 ? 0 : n][k], At[FP8 ? 0 : m][k], acc[ai][bj][m][n], 0, 0, 0); } } __builtin_amdgcn_s_setprio(0); } while (0)
#define PG8_WAIT_V(n) asm volatile("s_waitcnt vmcnt(" #n ")" ::: "memory")
#define PG8_WAIT_L(n) asm volatile("s_waitcnt lgkmcnt(" #n ")" ::: "memory")
#define PG8_BAR __builtin_amdgcn_s_barrier()
#define PG8_SCHED __builtin_amdgcn_sched_barrier(0)
    Unit cur, nxt; int ui = 0;
    if (!S.next(0, cur)) return;
    f32x4 acc[2][2][4][2];
#pragma unroll
    for (int a = 0; a < 2; ++a)
#pragma unroll
        for (int b = 0; b < 2; ++b)
#pragma unroll
            for (int m = 0; m < 4; ++m)
#pragma unroll
                for (int n = 0; n < 2; ++n) acc[a][b][m][n] = (f32x4){0.f, 0.f, 0.f, 0.f};
    int sclW = g.sclW, sclX = g.sclX; if constexpr (FP8) asm volatile("" : "+v"(sclW), "+v"(sclX));
    bf16x8 At[FP8 ? 1 : 4][2], B0[FP8 ? 1 : 2][2], B1[FP8 ? 1 : 2][2];
    v8i32 At8[FP8 ? 4 : 1], B08[FP8 ? 2 : 1], B18[FP8 ? 2 : 1];
    const char* cA = (const char*)g.A + (size_t)cur.arow * rstep; const char* cB = (const char*)g.Bt + (size_t)cur.brow * rstep;
    PG8_STAGE(PG8_SB(0, 0), cB, voffB); PG8_STAGE(PG8_SB(0, 1), cB + hstep, voffB); PG8_STAGE(PG8_SA(0, 0), cA, voffA); PG8_STAGE(PG8_SA(0, 1), cA + hstep, voffA);
    if (wr == 1) PG8_BAR;
    PG8_WAIT_V(2); PG8_BAR;
    PG8_STAGE(PG8_SB(1, 0), cB + kstep, voffB); PG8_STAGE(PG8_SA(1, 0), cA + kstep, voffA); PG8_STAGE(PG8_SB(1, 1), cB + hstep + kstep, voffB);
    PG8_WAIT_V(6); PG8_BAR;
    for (;;) {
        const bool has_next = S.next(ui + 1, nxt);
        const char* nA = has_next ? (const char*)g.A + (size_t)nxt.arow * rstep : cA; const char* nB = has_next ? (const char*)g.Bt + (size_t)nxt.brow * rstep : cB;
        for (int t = 0; t < nt; t += 2) {
            const bool last = (t == nt - 2);
            const char* a1 = cA + (size_t)(t + 1) * kstep;
            const char* a2 = last ? nA : cA + (size_t)(t + 2) * kstep; const char* b2 = last ? nB : cB + (size_t)(t + 2) * kstep;
            const char* a3 = a2 + kstep; const char* b3 = b2 + kstep;
            PG8_LDB(B0, 0, 0); PG8_LDB(B1, 0, 1); PG8_SCHED; PG8_LDA(At, 0, 0); PG8_STAGE(PG8_SA(1, 1), a1 + hstep, voffA);
            PG8_WAIT_V(8); PG8_WAIT_L(0); PG8_BAR; PG8_MMA(0, 0, At, B0); PG8_MMA(0, 1, At, B1); PG8_BAR; PG8_SCHED;
            PG8_LDA(At, 0, 1); PG8_STAGE(PG8_SB(0, 0), b2, voffB); PG8_STAGE(PG8_SB(0, 1), b2 + hstep, voffB); PG8_STAGE(PG8_SA(0, 0), a2, voffA);
            PG8_WAIT_V(8); PG8_WAIT_L(0); PG8_BAR; PG8_MMA(1, 0, At, B0); PG8_MMA(1, 1, At, B1); PG8_BAR; PG8_SCHED;
            PG8_LDB(B0, 1, 0); PG8_LDB(B1, 1, 1); PG8_SCHED; PG8_LDA(At, 1, 0); PG8_STAGE(PG8_SA(0, 1), a2 + hstep, voffA);
            PG8_WAIT_V(8); PG8_WAIT_L(0); PG8_BAR; PG8_MMA(0, 0, At, B0); PG8_MMA(0, 1, At, B1); PG8_BAR; PG8_SCHED;
            PG8_LDA(At, 1, 1); PG8_STAGE(PG8_SB(1, 0), b3, voffB); PG8_STAGE(PG8_SB(1, 1), b3 + hstep, voffB); PG8_STAGE(PG8_SA(1, 0), a3, voffA);
            PG8_WAIT_V(8); PG8_WAIT_L(0); PG8_BAR; PG8_MMA(1, 0, At, B0); PG8_MMA(1, 1, At, B1); PG8_BAR; PG8_SCHED;
        }
        if constexpr (ALIGN_EPI) { if (wr == 0) PG8_BAR; }
        if constexpr (FP8) asm volatile("s_nop 15\n\ts_nop 15" ::: "memory");
        if constexpr (!Epi::AFTER_DRAIN) { E(acc[0], 0, cur, wr, wc, fr, fq); E(acc[1], 1, cur, wr, wc, fr, fq); }
        if (!has_next) break;
#pragma unroll
        for (int a = 0; a < 2; ++a)
#pragma unroll
            for (int b = 0; b < 2; ++b)
#pragma unroll
                for (int m = 0; m < 4; ++m)
#pragma unroll
                    for (int n = 0; n < 2; ++n) acc[a][b][m][n] = (f32x4){0.f, 0.f, 0.f, 0.f};
        cur = nxt; cA = nA; cB = nB; ++ui;
        if constexpr (ALIGN_EPI) { if (wr == 1) PG8_BAR; }
    }
    PG8_WAIT_V(0);
    if constexpr (!ALIGN_EPI) { if (wr == 0) PG8_BAR; }
    PG8_BAR;
    if constexpr (Epi::AFTER_DRAIN) { E.fused(acc[0], 0, cur, wr, wc, fr, fq, lds); E.fused(acc[1], 1, cur, wr, wc, fr, fq, lds); }
#undef PG8_SA
#undef PG8_SB
#undef PG8_STAGE
#undef PG8_LDA
#undef PG8_LDB
#undef PG8_MMA
#undef PG8_LD8
#undef PG8_WAIT_V
#undef PG8_WAIT_L
#undef PG8_BAR
#undef PG8_SCHED
}
template <class Epi, class Sched>
__device__ __forceinline__ void gemm_phase(LAS unsigned char* lds, const Gemm g, const Sched& S, const Epi& E) {
#if defined(SIMPLE_GEMM)
    gemm_simple(lds, g, S, E);
#else
    gemm_fast<Epi, Sched, !Epi::AFTER_DRAIN>(lds, g, S, E);
    __syncthreads();
#endif
}
template <class Epi, class Sched>
__device__ __forceinline__ void gemm_phase_fp8(LAS unsigned char* lds, const Gemm g, const Sched& S, const Epi& E) {
    gemm_fast<Epi, Sched, !Epi::AFTER_DRAIN, true>(lds, g, S, E);
    __syncthreads();
}
}

namespace fox_body {
using bf16=__hip_bfloat16;
using bf16x8=__attribute__((ext_vector_type(8)))short;
using s16x4=__attribute__((ext_vector_type(4)))short;
using f32x16=__attribute__((ext_vector_type(16)))float;
using u32x4=__attribute__((ext_vector_type(4)))unsigned;
using f32x4v=__attribute__((ext_vector_type(4)))float;
constexpr int BATCH=8,NHEAD=16,SEQ=2048,D=64,DM=NHEAD*D;
constexpr int NW=8,QBLK=32,QB=QBLK*NW,KVBLK=64,NQB=SEQ/QB;
constexpr int ATTN_PITCH=DM, ATTN_UNIT_ROWS=QB;
__device__ __forceinline__ int crow(int r,int hi){return (r&3)+8*(r>>2)+4*hi;}
#define SBAR() __builtin_amdgcn_sched_barrier(0)
__device__ __forceinline__ void cmask(f32x16&p0,f32x16&p1,int jb,int qrel,int hi){
  const float NEG=-INFINITY; int kb=64*jb+4*hi;
  #pragma unroll
  for(int r=0;r<16;++r){int kv=kb+(r&3)+8*(r>>2); if(kv>qrel)p0[r]=NEG; if(kv+32>qrel)p1[r]=NEG;}
}

constexpr int NSLOT=3, SLOTB=8192;
constexpr int LDS_K=0, LDS_V=NSLOT*SLOTB, LDS_WS=2*NSLOT*SLOTB, LDS_OST=LDS_WS+NW*64*4, LDS_CS=LDS_OST+NW*4096, LDS_BYTES=LDS_CS+SEQ*4;
constexpr float C2=0.125f*1.4426950408889634f;
__device__ __forceinline__ void glds16(const void*gsrc,unsigned lds_dst){unsigned keep;
  asm volatile("s_mov_b32 %0, m0\n\ts_mov_b32 m0, %2\n\ts_nop 0\n\tglobal_load_lds_dwordx4 %1, off\n\ts_mov_b32 m0, %0":"=&s"(keep):"v"(gsrc),"s"(lds_dst):"memory");}
__device__ __forceinline__ float max3f(float a,float b,float c){float r;asm("v_max3_f32 %0, %1, %2, %3":"=v"(r):"v"(a),"v"(b),"v"(c));return r;}
__device__ __forceinline__ float max2f(float a,float b){float r;asm("v_max_f32_e32 %0, %1, %2":"=v"(r):"v"(a),"v"(b));return r;}
__device__ __forceinline__ float fadd_s(float a,float b){float r;asm("v_add_f32_e32 %0, %1, %2":"=v"(r):"v"(a),"v"(b));return r;}
__device__ __forceinline__ float fsub_s(float a,float b){float r;asm("v_sub_f32_e32 %0, %1, %2":"=v"(r):"v"(a),"v"(b));return r;}
typedef float f32x2_t __attribute__((ext_vector_type(2))); typedef __bf16 bf16x2_t __attribute__((ext_vector_type(2)));
__device__ __forceinline__ unsigned cvtpk_s(float lo,float hi){f32x2_t v={lo,hi};bf16x2_t b=__builtin_convertvector(v,bf16x2_t);return __builtin_bit_cast(unsigned,b);}
#define WAIT_BAR(N) asm volatile("s_waitcnt vmcnt(" #N ") lgkmcnt(0)\n\ts_barrier":::"memory")

__device__ __forceinline__ void qkt(f32x16&p0,f32x16&p1,const char*Kslot,const bf16x8*qr,const f32x16&negm,int r32,int hi){
  const char*kb=Kslot+hi*1024+r32*16;
  #pragma unroll
  for(int d0=0;d0<4;++d0){
    const bf16x8 b0=*reinterpret_cast<const bf16x8*>(kb+d0*2048);
    const bf16x8 b1=*reinterpret_cast<const bf16x8*>(kb+d0*2048+512);
    if(d0==0){p0=__builtin_amdgcn_mfma_f32_32x32x16_bf16(b0,qr[0],negm,0,0,0);p1=__builtin_amdgcn_mfma_f32_32x32x16_bf16(b1,qr[0],negm,0,0,0);}
    else{p0=__builtin_amdgcn_mfma_f32_32x32x16_bf16(b0,qr[d0],p0,0,0,0);p1=__builtin_amdgcn_mfma_f32_32x32x16_bf16(b1,qr[d0],p1,0,0,0);}}
}
typedef __attribute__((address_space(3))) const char* lds_cptr;
typedef short v4i16_t __attribute__((ext_vector_type(4)));
__device__ __forceinline__ void kload8(bf16x8*kf,lds_cptr kp){
  kf[0]=*(const __attribute__((address_space(3))) bf16x8*)(kp);      kf[1]=*(const __attribute__((address_space(3))) bf16x8*)(kp+512);
  kf[2]=*(const __attribute__((address_space(3))) bf16x8*)(kp+2048); kf[3]=*(const __attribute__((address_space(3))) bf16x8*)(kp+2560);
  kf[4]=*(const __attribute__((address_space(3))) bf16x8*)(kp+4096); kf[5]=*(const __attribute__((address_space(3))) bf16x8*)(kp+4608);
  kf[6]=*(const __attribute__((address_space(3))) bf16x8*)(kp+6144); kf[7]=*(const __attribute__((address_space(3))) bf16x8*)(kp+6656);
}
__device__ __forceinline__ void kload2(bf16x8*kf,lds_cptr kp,int j){ kf[2*j]=*(const __attribute__((address_space(3))) bf16x8*)(kp+j*2048); kf[2*j+1]=*(const __attribute__((address_space(3))) bf16x8*)(kp+j*2048+512); }
__device__ __forceinline__ s16x4 vtr(lds_cptr p){ return __builtin_bit_cast(s16x4,__builtin_amdgcn_ds_read_tr16_b64_v4i16((__attribute__((address_space(3))) v4i16_t*)p)); }
__device__ __forceinline__ float rowmax(const f32x16&p0,const f32x16&p1){
  float a=max3f(p0[0],p0[1],p1[0]),b=max3f(p0[2],p0[3],p1[1]);a=max3f(a,p1[2],p1[3]);
  #pragma unroll
  for(int r=4;r<16;r+=4){a=max3f(a,p0[r],p0[r+1]);b=max3f(b,p0[r+2],p0[r+3]);a=max3f(a,p1[r],p1[r+1]);b=max3f(b,p1[r+2],p1[r+3]);}
  const float m=max2f(a,b);
  auto rr=__builtin_amdgcn_permlane32_swap(__float_as_uint(m),__float_as_uint(m),false,false);
  return max2f(__uint_as_float(rr[0]),__uint_as_float(rr[1]));
}
__device__ __forceinline__ void pv(f32x16*o,int vb,bf16x8 pa0,bf16x8 pa1,bf16x8 pa2,bf16x8 pa3){
  #pragma unroll
  for(int d0=0;d0<2;++d0){s16x4 lo[4],hi[4];
    #pragma unroll
    for(int ks=0;ks<4;++ks){
      asm volatile("ds_read_b64_tr_b16 %0,%1 offset:%c2":"=&v"(lo[ks]):"v"(vb),"i"(d0*4096+ks*1024):"memory");
      asm volatile("ds_read_b64_tr_b16 %0,%1 offset:%c2":"=&v"(hi[ks]):"v"(vb),"i"(d0*4096+ks*1024+512):"memory");}
    asm volatile("s_waitcnt lgkmcnt(0)":::"memory");SBAR();
    #define PK(k) (bf16x8){lo[k][0],lo[k][1],lo[k][2],lo[k][3],hi[k][0],hi[k][1],hi[k][2],hi[k][3]}
    o[d0]=__builtin_amdgcn_mfma_f32_32x32x16_bf16(pa0,PK(0),o[d0],0,0,0);
    o[d0]=__builtin_amdgcn_mfma_f32_32x32x16_bf16(pa1,PK(1),o[d0],0,0,0);
    o[d0]=__builtin_amdgcn_mfma_f32_32x32x16_bf16(pa2,PK(2),o[d0],0,0,0);
    o[d0]=__builtin_amdgcn_mfma_f32_32x32x16_bf16(pa3,PK(3),o[d0],0,0,0);
    #undef PK
  }
}

#ifndef ATTN_STORE16
#define ATTN_STORE16(p,v) (*(u32x4*)(p)=(v))
#endif
template<int THRL> __device__ __forceinline__ void attn_unit(int b,int h,int qb,const bf16*Q,const bf16*__restrict__ K,const bf16*__restrict__ V,bf16*O,char*shm){
  const int tid=threadIdx.x,lane=tid&63,r32=lane&31,hi=lane>>5; const int wid=__builtin_amdgcn_readfirstlane(tid>>6);
  const long rowbase=(long)b*SEQ; const int q0=qb*QB;
  const bf16*Qw=Q+(rowbase+q0+wid*QBLK)*DM+h*D;
  const bf16*Kh=K+rowbase*DM+h*D,*Vh=V+rowbase*DM+h*D;
  const unsigned lds0=(unsigned)(uintptr_t)shm;
  float*wsf=(float*)(shm+LDS_WS)+wid*64;
  const bf16*ksrc=Kh+(long)lane*DM+wid*8;
  const bf16*vsrc=Vh+(long)(16*(wid&3)+(lane>>2))*DM+(wid>>2)*32+(lane&3)*8;
  const unsigned kdst=lds0+LDS_K+wid*1024, vdst=lds0+LDS_V+wid*1024;
  #define DMA_K(t,slot) glds16(ksrc+(long)(t)*KVBLK*DM,(unsigned)__builtin_amdgcn_readfirstlane(kdst+(slot)))
  #define DMA_V(t,slot) glds16(vsrc+(long)(t)*KVBLK*DM,(unsigned)__builtin_amdgcn_readfirstlane(vdst+(slot)))
  const int vb0=(int)(lds0+LDS_V)+((lane>>4)&1)*32+(lane&3)*8+(4*hi+((lane&15)>>2))*64;
  const char*Kbase=shm+LDS_K; bf16x8 kf[8];
  const lds_cptr shm3=(lds_cptr)shm; const lds_cptr kp0=shm3+LDS_K+hi*1024+r32*16; const lds_cptr vp0=shm3+LDS_V+((lane>>4)&1)*32+(lane&3)*8+(4*hi+((lane&15)>>2))*64;
  const int NT=(q0+QB)/KVBLK;
  DMA_K(0,0);DMA_V(0,0);DMA_K(1,SLOTB);
  __attribute__((address_space(3))) float*csl=(__attribute__((address_space(3))) float*)(uintptr_t)(unsigned)(uintptr_t)(shm+LDS_CS);
  const float ctq=csl[q0+wid*QBLK+r32];
  bf16x8 qr[4];
  #pragma unroll
  for(int d0=0;d0<4;++d0)qr[d0]=*reinterpret_cast<const bf16x8*>(&Qw[(long)r32*DM+d0*16+hi*8]);
  float mhat=-ctq,l_reg=0.f;f32x16 o[2];o[0]=f32x16{};o[1]=f32x16{};f32x16 negm;
  #pragma unroll
  for(int r=0;r<16;++r)negm[r]=ctq;
  asm volatile("":"+v"(negm));
  const int qrel=wid*QBLK+r32;
  #define CMASK(P0,P1,t) do{int jb_=(t)-(NT-4); if(jb_>=0)cmask(P0,P1,jb_,qrel,hi);}while(0)
  #define CSUB(P0,P1,t) do{ const __attribute__((address_space(3))) float*cp_=csl+(t)*KVBLK+4*hi; _Pragma("unroll") for(int g_=0;g_<4;g_+=2){ const f32x4v a_=*(const __attribute__((address_space(3))) f32x4v*)(cp_+8*g_), c_=*(const __attribute__((address_space(3))) f32x4v*)(cp_+8*g_+8); \
      _Pragma("unroll") for(int j_=0;j_<4;++j_){P0[4*g_+j_]-=a_[j_];P0[4*g_+4+j_]-=c_[j_];} SBAR(); } \
    _Pragma("unroll") for(int g_=0;g_<4;g_+=2){ const f32x4v b_=*(const __attribute__((address_space(3))) f32x4v*)(cp_+32+8*g_), d_=*(const __attribute__((address_space(3))) f32x4v*)(cp_+40+8*g_); \
      _Pragma("unroll") for(int j_=0;j_<4;++j_){P1[4*g_+j_]-=b_[j_];P1[4*g_+4+j_]-=d_[j_];} SBAR(); } }while(0)
  bool resc=false;
  #define START(P0,P1) do{ const float rm=rowmax(P0,P1); resc=false; \
    { const float dl=rm; mhat=fadd_s(mhat,dl); \
      _Pragma("unroll") for(int r=0;r<16;++r){P0[r]=fsub_s(P0[r],dl);P1[r]=fsub_s(P1[r],dl);} \
      _Pragma("unroll") for(int r=0;r<16;++r)negm[r]=-mhat; asm volatile("":"+v"(negm)); } \
    _Pragma("unroll") for(int r=0;r<16;++r)P0[r]=__builtin_amdgcn_exp2f(P0[r]); }while(0)
  #define RESC() do{ if(resc){ asm volatile("s_waitcnt lgkmcnt(0)":::"memory"); \
      _Pragma("unroll") for(int d_=0;d_<2;++d_) _Pragma("unroll") for(int r=0;r<16;++r)o[d_][r]*=wsf[crow(r,hi)]; } }while(0)
  f32x16 pA0,pA1,pB0,pB1;
  int sl_prev=0,sl_cur=0,sl_next=SLOTB;
  #define ROT() do{sl_prev=sl_cur;sl_cur=sl_next;sl_next=(sl_next==(NSLOT-1)*SLOTB)?0:sl_next+SLOTB;}while(0)
  DMA_K(2,2*SLOTB);
  WAIT_BAR(3);
  qkt(pA0,pA1,Kbase,qr,negm,r32,hi);asm volatile("s_nop 15\n\ts_nop 7":"+v"(pA0),"+v"(pA1));CSUB(pA0,pA1,0);CMASK(pA0,pA1,0);
  START(pA0,pA1);
  _Pragma("unroll") for(int r=0;r<16;++r)pA1[r]=__builtin_amdgcn_exp2f(pA1[r]);
  WAIT_BAR(0);
  DMA_K(3,0);DMA_V(1,SLOTB);
  ROT();
  kload8(kf,kp0+sl_cur);
  WAIT_BAR(2);
  s16x4 vlo[8],vhi[8]; u32x4 pw0,pw1,pw2,pw3;
  #define PKW(P,B) cvtpk_s(P[B],P[B+1])
  #define PAF(k) __builtin_bit_cast(bf16x8,pw##k)
  #define VFR(i) (bf16x8){vlo[i][0],vlo[i][1],vlo[i][2],vlo[i][3],vhi[i][0],vhi[i][1],vhi[i][2],vhi[i][3]}
  #define PIN(x) asm volatile("":"+v"(x))
  #define MX3(a,b,c) __builtin_fmaxf(__builtin_fmaxf((a),(b)),(c))
  #define GAPA(MF,A0,A1,A2,A3,W0,W1,PW) do{ MF; sacc+=A0; sacc+=A1; sacc+=A2; sacc+=A3; PIN(sacc); W0; W1; PIN(PW); SBAR(); }while(0)
  #define EX(v) __builtin_amdgcn_exp2f(v)
  #define GAPB(MF,X,B) do{ MF; X[B]=EX(X[B]); X[B+1]=EX(X[B+1]); X[B+2]=EX(X[B+2]); X[B+3]=EX(X[B+3]); PIN(X); SBAR(); }while(0)
  #define VRD(i) do{ vlo[i]=vtr(vp_+(((i)>>2)*4096+((i)&3)*1024)); vhi[i]=vtr(vp_+(((i)>>2)*4096+((i)&3)*1024+512)); }while(0)
  #define KRD(G,j) do{ if(G){ kload2(kf,kp0+sl_next,j); SBAR(); } }while(0)
  #define STEP(C0,C1,P0,P1,t,GK,GV,GL) do{ SBAR(); \
    const lds_cptr vp_=vp0+sl_prev; \
    VRD(0); SBAR(); float sacc=(P0[0]+P0[1]); \
    GAPA(C0=__builtin_amdgcn_mfma_f32_32x32x16_bf16(kf[0],qr[0],negm,0,0,0), P0[2],P0[3],P0[4],P0[5],     pw0[0]=PKW(P0,0), pw0[1]=PKW(P0,2), pw0); \
    VRD(4); SBAR(); GAPA(C1=__builtin_amdgcn_mfma_f32_32x32x16_bf16(kf[1],qr[0],negm,0,0,0), P0[6],P0[7],P0[8],P0[9],     pw0[2]=PKW(P0,4), pw0[3]=PKW(P0,6), pw0); \
    VRD(1); SBAR(); GAPA(C0=__builtin_amdgcn_mfma_f32_32x32x16_bf16(kf[2],qr[1],C0,0,0,0),   P0[10],P0[11],P0[12],P0[13], pw1[0]=PKW(P0,8), pw1[1]=PKW(P0,10), pw1); \
    VRD(5); SBAR(); GAPA(C1=__builtin_amdgcn_mfma_f32_32x32x16_bf16(kf[3],qr[1],C1,0,0,0),   P0[14],P0[15],P1[0],P1[1],   pw1[2]=PKW(P0,12),pw1[3]=PKW(P0,14), pw1); \
    VRD(2); SBAR(); GAPA(C0=__builtin_amdgcn_mfma_f32_32x32x16_bf16(kf[4],qr[2],C0,0,0,0),   P1[2],P1[3],P1[4],P1[5],     pw2[0]=PKW(P1,0), pw2[1]=PKW(P1,2), pw2); \
    VRD(6); SBAR(); GAPA(C1=__builtin_amdgcn_mfma_f32_32x32x16_bf16(kf[5],qr[2],C1,0,0,0),   P1[6],P1[7],P1[8],P1[9],     pw2[2]=PKW(P1,4), pw2[3]=PKW(P1,6), pw2); \
    VRD(3); SBAR(); GAPA(C0=__builtin_amdgcn_mfma_f32_32x32x16_bf16(kf[6],qr[3],C0,0,0,0),   P1[10],P1[11],P1[12],P1[13], pw3[0]=PKW(P1,8), pw3[1]=PKW(P1,10), pw3); \
    VRD(7); SBAR(); GAPA(C1=__builtin_amdgcn_mfma_f32_32x32x16_bf16(kf[7],qr[3],C1,0,0,0),   P1[14],P1[15],0.f,0.f,       pw3[2]=PKW(P1,12),pw3[3]=PKW(P1,14), pw3); \
    l_reg+=sacc; \
    if(GK){DMA_K((t)+3,sl_cur);} if(GV){DMA_V((t)+1,sl_next);} \
    SBAR(); CSUB(C0,C1,t); CMASK(C0,C1,t); \
    { float a=MX3(C0[0],C0[1],C1[0]),b=MX3(C0[2],C0[3],C1[1]); a=MX3(a,C1[2],C1[3]); \
      _Pragma("unroll") for(int r=4;r<16;r+=4){a=MX3(a,C0[r],C0[r+1]);b=MX3(b,C0[r+2],C0[r+3]);a=MX3(a,C1[r],C1[r+1]);b=MX3(b,C1[r+2],C1[r+3]);} \
      float rm=__builtin_fmaxf(a,b); { auto rr=__builtin_amdgcn_permlane32_swap(__float_as_uint(rm),__float_as_uint(rm),false,false); rm=__builtin_fmaxf(__uint_as_float(rr[0]),__uint_as_float(rr[1])); } \
      resc=false; \
      if(__builtin_expect(__any(rm>(float)THRL),0)){ const float dl=__builtin_fmaxf(rm,0.f); mhat+=dl; \
        _Pragma("unroll") for(int r=0;r<16;++r){C0[r]-=dl;C1[r]-=dl;} \
        _Pragma("unroll") for(int r=0;r<16;++r)negm[r]=-mhat; asm volatile("":"+v"(negm)); \
        const float f=__builtin_amdgcn_exp2f(-dl); l_reg*=f; if(hi==0)wsf[r32]=f; resc=true; } } \
    SBAR(); \
    GAPB(o[0]=__builtin_amdgcn_mfma_f32_32x32x16_bf16(PAF(0),VFR(0),o[0],0,0,0), C0,0); \
    GAPB(o[1]=__builtin_amdgcn_mfma_f32_32x32x16_bf16(PAF(0),VFR(4),o[1],0,0,0), C0,4); \
    KRD(GL,0); GAPB(o[0]=__builtin_amdgcn_mfma_f32_32x32x16_bf16(PAF(1),VFR(1),o[0],0,0,0), C0,8); \
    KRD(GL,1); GAPB(o[1]=__builtin_amdgcn_mfma_f32_32x32x16_bf16(PAF(1),VFR(5),o[1],0,0,0), C0,12); \
    KRD(GL,2); GAPB(o[0]=__builtin_amdgcn_mfma_f32_32x32x16_bf16(PAF(2),VFR(2),o[0],0,0,0), C1,0); \
    KRD(GL,3); GAPB(o[1]=__builtin_amdgcn_mfma_f32_32x32x16_bf16(PAF(2),VFR(6),o[1],0,0,0), C1,4); \
    GAPB(o[0]=__builtin_amdgcn_mfma_f32_32x32x16_bf16(PAF(3),VFR(3),o[0],0,0,0), C1,8); \
    GAPB(o[1]=__builtin_amdgcn_mfma_f32_32x32x16_bf16(PAF(3),VFR(7),o[1],0,0,0), C1,12); \
    }while(0)
  int t=1;
  #undef CMASK
  #define CMASK(P0,P1,t) do{}while(0)
  for(;t+5<NT;t+=2){
    STEP(pB0,pB1,pA0,pA1,t,true,true,true);     WAIT_BAR(2); RESC(); ROT();
    STEP(pA0,pA1,pB0,pB1,t+1,true,true,true);   WAIT_BAR(2); RESC(); ROT();
  }
  #undef CMASK
  #define CMASK(P0,P1,t) do{int jb_=(t)-(NT-4); if(jb_>=0)cmask(P0,P1,jb_,qrel,hi);}while(0)
  #define ENDW(tt) do{ if((tt)+3<NT){WAIT_BAR(2);} else if((tt)+2<NT){WAIT_BAR(1);} else {WAIT_BAR(0);} }while(0)
  for(;t+1<NT;t+=2){
    STEP(pB0,pB1,pA0,pA1,t,(t+3<NT),(t+1<NT),(t+1<NT));       ENDW(t);   RESC(); ROT();
    STEP(pA0,pA1,pB0,pB1,t+1,(t+4<NT),(t+2<NT),(t+2<NT));     ENDW(t+1); RESC(); ROT();
  }
  STEP(pB0,pB1,pA0,pA1,NT-1,false,false,false); RESC();
  { float sacc=pB0[0]+pB0[1]; _Pragma("unroll") for(int r=2;r<16;++r)sacc+=pB0[r]; _Pragma("unroll") for(int r=0;r<16;++r)sacc+=pB1[r]; l_reg+=sacc;
    pw0=(u32x4){PKW(pB0,0),PKW(pB0,2),PKW(pB0,4),PKW(pB0,6)};pw1=(u32x4){PKW(pB0,8),PKW(pB0,10),PKW(pB0,12),PKW(pB0,14)};pw2=(u32x4){PKW(pB1,0),PKW(pB1,2),PKW(pB1,4),PKW(pB1,6)};pw3=(u32x4){PKW(pB1,8),PKW(pB1,10),PKW(pB1,12),PKW(pB1,14)};
    SBAR(); pv(o,vb0+sl_cur,PAF(0),PAF(1),PAF(2),PAF(3)); }
  #undef PKW
  #undef PAF
  #undef VFR
  #undef PIN
  #undef MX3
  #undef GAPA
  #undef GAPB
  #undef EX
  #undef VRD
  #undef KRD
  #undef STEP
  #undef ENDW
  {auto rr=__builtin_amdgcn_permlane32_swap(__float_as_uint(l_reg),__float_as_uint(l_reg),false,false);l_reg=__uint_as_float(rr[0])+__uint_as_float(rr[1]);}
  if(hi==0)wsf[32+r32]=l_reg;asm volatile("s_waitcnt lgkmcnt(0)":::"memory");
  float rli[16];
  #pragma unroll
  for(int r=0;r<16;++r)rli[r]=__builtin_amdgcn_rcpf(wsf[32+crow(r,hi)]);
  bf16*Ow=O+(rowbase+q0+wid*QBLK)*DM+h*D;
  { bf16*stg=(bf16*)(shm+LDS_OST)+wid*2048;
    #pragma unroll
    for(int r=0;r<16;++r){const int orow=crow(r,hi);
      #pragma unroll
      for(int d0=0;d0<2;++d0)stg[orow*64+d0*32+r32]=__float2bfloat16(o[d0][r]*rli[r]);}
    asm volatile("s_waitcnt lgkmcnt(0)":::"memory");
    #pragma unroll
    for(int i=0;i<4;++i){const int row=i*8+(lane>>3),ch=lane&7; const u32x4 v=*(const u32x4*)(stg+row*64+ch*8); ATTN_STORE16(Ow+(long)row*DM+ch*8,v);} }
  asm volatile("s_waitcnt lgkmcnt(0)\n\ts_barrier":::"memory");
  #undef DMA_K
  #undef DMA_V
  #undef CMASK
  #undef CSUB
  #undef START
  #undef RESC
  #undef ROT
}
constexpr int ATTN_LDS_BYTES=LDS_BYTES;
struct AttnTensors { const bf16* Q; const bf16* K; const bf16* V; bf16* O; const float* CS; };
struct AttnUnit { int bh; int qb; };
struct StaticOrder {
  int vcu;
  __device__ __forceinline__ explicit StaticOrder(int grid,int block):vcu((block%8)*(grid/8)+block/8){}
  __device__ __forceinline__ bool next(int i,AttnUnit&u)const{ if(i>=4)return false; const int s=vcu&1; u.bh=vcu>>1; u.qb=(i==0)?s:(i==1)?7-s:(i==2)?3-s:4+s; return true; }
};
template<class Sched,int THRL=8> __device__ __forceinline__ void attn_phase(char*lds,const AttnTensors&T,const Sched&S){
  AttnUnit u;
  {
    const int tid=threadIdx.x, bh=S.vcu>>1, b=bh/NHEAD, h=bh%NHEAD;
    __attribute__((address_space(3))) float*csl=(__attribute__((address_space(3))) float*)(uintptr_t)(unsigned)(uintptr_t)(lds+LDS_CS);
    __attribute__((address_space(3))) float*sc=(__attribute__((address_space(3))) float*)(uintptr_t)(unsigned)(uintptr_t)(lds+LDS_WS);
    float v[4],run=0.f;
    #pragma unroll
    for(int i=0;i<4;++i){run+=T.CS[(long)(b*SEQ+4*tid+i)*NHEAD+h];v[i]=run;}
    sc[tid]=run;__syncthreads();
    for(int o=1;o<NW*64;o<<=1){const float a=(tid>=o)?sc[tid-o]:0.f;__syncthreads();sc[tid]+=a;__syncthreads();}
    const float excl=sc[tid]-run;
    #pragma unroll
    for(int i=0;i<4;++i)csl[4*tid+i]=(excl+v[i])*1.4426950408889634f;
    __syncthreads(); }
  for(int i=0;S.next(i,u);++i){ attn_unit<THRL>(u.bh/NHEAD,u.bh%NHEAD,u.qb,T.Q,T.K,T.V,T.O,lds); }
}

constexpr int SB_K=0, SB_V=2*SLOTB, SB_FLAG=4*SLOTB, SB_OST=SB_FLAG+256, SB_BYTES=SB_OST+NW*4096;
__device__ __forceinline__ void sb_unit(int b,int h,int qb,const bf16*Q,const bf16*__restrict__ K,const bf16*__restrict__ V,bf16*O,char*shm){
  const int tid=threadIdx.x,lane=tid&63,r32=lane&31,hi=lane>>5; const int wid=__builtin_amdgcn_readfirstlane(tid>>6);
  const long rowbase=(long)b*SEQ; const int q0=qb*QB;
  const bf16*Qw=Q+(rowbase+q0+wid*QBLK)*DM+h*D;
  const bf16*Kh=K+rowbase*DM+h*D,*Vh=V+rowbase*DM+h*D;
  const unsigned lds0=(unsigned)(uintptr_t)shm;
  const bf16*ksrc=Kh+(long)lane*DM+wid*8;
  const bf16*vsrc=Vh+(long)(16*(wid&3)+(lane>>2))*DM+(wid>>2)*32+(lane&3)*8;
  const unsigned kdst=lds0+SB_K+wid*1024, vdst=lds0+SB_V+wid*1024;
  #define DMA_K(t,slot) glds16(ksrc+(long)(t)*KVBLK*DM,(unsigned)__builtin_amdgcn_readfirstlane(kdst+(slot)))
  #define DMA_V(t,slot) glds16(vsrc+(long)(t)*KVBLK*DM,(unsigned)__builtin_amdgcn_readfirstlane(vdst+(slot)))
  const int vb0=(int)(lds0+SB_V)+((lane>>4)&1)*32+(lane&3)*8+(4*hi+((lane&15)>>2))*64;
  typedef __attribute__((address_space(3))) unsigned lds_u32;
  lds_u32* flag=(lds_u32*)(uintptr_t)(lds0+SB_FLAG);
  const int NT=(q0+QB)/KVBLK;
  DMA_K(NT-1,0);DMA_V(NT-1,0);
  bf16x8 qr[4];
  #pragma unroll
  for(int d0=0;d0<4;++d0)qr[d0]=*reinterpret_cast<const bf16x8*>(&Qw[(long)r32*DM+d0*16+hi*8]);
  f32x16 o[2];o[0]=f32x16{};o[1]=f32x16{};
  float rinv=1.0f; const int qrel=wid*QBLK+r32;
  for(int i=0;i<NT;++i){
    const int t=NT-1-i, slot=(i&1)*SLOTB;
    asm volatile("s_waitcnt vmcnt(0) lgkmcnt(0)\n\ts_barrier":::"memory");
    if(i>0){ const u32x4 f0=*(const __attribute__((address_space(3))) u32x4*)(flag+((i-1)&1)*8), f1=*(const __attribute__((address_space(3))) u32x4*)(flag+((i-1)&1)*8+4);
      if((f0.x&f0.y&f0.z&f0.w&f1.x&f1.y&f1.z&f1.w)!=0u)break; }
    if(i+1<NT){DMA_K(t-1,SLOTB-slot);DMA_V(t-1,SLOTB-slot);}
    f32x16 p0,p1; { f32x16 zc=f32x16{}; qkt(p0,p1,shm+SB_K+slot,qr,zc,r32,hi); }
    f32x16 c0,c1;
    #pragma unroll
    for(int r=0;r<16;++r){p0[r]=__builtin_amdgcn_exp2f(p0[r]);p1[r]=__builtin_amdgcn_exp2f(p1[r]);}
    { const int jb=t-(NT-4); if(jb>=0){ const int kb=64*jb+4*hi;
      #pragma unroll
      for(int r=0;r<16;++r){const int kv=kb+(r&3)+8*(r>>2); if(kv>=qrel)p0[r]=0.f; if(kv+32>=qrel)p1[r]=0.f;} } }
    #pragma unroll
    for(int r=0;r<16;++r){c0[r]=__builtin_amdgcn_rcpf(1.0f+p0[r]);c1[r]=__builtin_amdgcn_rcpf(1.0f+p1[r]);}
    #pragma unroll
    for(int g=0;g<4;++g){ c0[4*g+2]*=c0[4*g+3];c0[4*g+1]*=c0[4*g+2];c0[4*g]*=c0[4*g+1]; c1[4*g+2]*=c1[4*g+3];c1[4*g+1]*=c1[4*g+2];c1[4*g]*=c1[4*g+1]; }
    float tl[8],th[8],X[8];
    #pragma unroll
    for(int g=0;g<8;++g){ const float T=(g<4)?c0[4*g]:c1[4*(g-4)]; auto rr=__builtin_amdgcn_permlane32_swap(__float_as_uint(T),__float_as_uint(T),false,false); tl[g]=__uint_as_float(rr[0]); th[g]=__uint_as_float(rr[1]); }
    X[7]=1.0f;
    #pragma unroll
    for(int g=6;g>=0;--g)X[g]=X[g+1]*(tl[g+1]*th[g+1]);
    #pragma unroll
    for(int g=0;g<8;++g){ const float F=rinv*X[g]*(hi?1.0f:th[g]);
      #pragma unroll
      for(int j=0;j<4;++j){ if(g<4)p0[4*g+j]=p0[4*g+j]*c0[4*g+j]*F; else p1[4*(g-4)+j]=p1[4*(g-4)+j]*c1[4*(g-4)+j]*F; } }
    rinv=rinv*X[0]*(tl[0]*th[0]);
    { const bool dn=__all(rinv<8.6736174e-19f); if(lane==0)flag[(i&1)*8+wid]=dn?1u:0u; }
    u32x4 pw0,pw1,pw2,pw3;
    pw0=(u32x4){cvtpk_s(p0[0],p0[1]),cvtpk_s(p0[2],p0[3]),cvtpk_s(p0[4],p0[5]),cvtpk_s(p0[6],p0[7])};
    pw1=(u32x4){cvtpk_s(p0[8],p0[9]),cvtpk_s(p0[10],p0[11]),cvtpk_s(p0[12],p0[13]),cvtpk_s(p0[14],p0[15])};
    pw2=(u32x4){cvtpk_s(p1[0],p1[1]),cvtpk_s(p1[2],p1[3]),cvtpk_s(p1[4],p1[5]),cvtpk_s(p1[6],p1[7])};
    pw3=(u32x4){cvtpk_s(p1[8],p1[9]),cvtpk_s(p1[10],p1[11]),cvtpk_s(p1[12],p1[13]),cvtpk_s(p1[14],p1[15])};
    SBAR(); pv(o,vb0+slot,__builtin_bit_cast(bf16x8,pw0),__builtin_bit_cast(bf16x8,pw1),__builtin_bit_cast(bf16x8,pw2),__builtin_bit_cast(bf16x8,pw3));
  }
  bf16*Ow=O+(rowbase+q0+wid*QBLK)*DM+h*D;
  { bf16*stg=(bf16*)(shm+SB_OST)+wid*2048;
    #pragma unroll
    for(int r=0;r<16;++r){const int orow=crow(r,hi);
      #pragma unroll
      for(int d0=0;d0<2;++d0)stg[orow*64+d0*32+r32]=__float2bfloat16(o[d0][r]);}
    asm volatile("s_waitcnt lgkmcnt(0)":::"memory");
    #pragma unroll
    for(int i=0;i<4;++i){const int row=i*8+(lane>>3),ch=lane&7; const u32x4 v=*(const u32x4*)(stg+row*64+ch*8); *(u32x4*)(Ow+(long)row*DM+ch*8)=v;} }
  asm volatile("s_waitcnt vmcnt(0) lgkmcnt(0)\n\ts_barrier":::"memory");
  #undef DMA_K
  #undef DMA_V
}
template<class Sched> __device__ __forceinline__ void sb_phase(char*lds,const AttnTensors&T,const Sched&S){
  AttnUnit u;
  for(int i=0;S.next(i,u);++i){ sb_unit(u.bh/NHEAD,u.bh%NHEAD,u.qb,T.Q,T.K,T.V,T.O,lds); }
}
#undef SBAR
#undef WAIT_BAR
}
struct Args { const float* in[20]; float* out; unsigned char* ws; int ph_lo, ph_hi, li, pad; };

struct ConvDesc { const float* src; const float* gain; bf16_t* dst; int ldn, K, fp8; float wsc; };
__device__ __forceinline__ void conv_load(const ConvDesc& d, f32x4 (&v)[16], f32x4 (&g)[2], int lane) {
#pragma unroll
    for (int i = 0; i < 16; ++i) v[i] = *(const GAS f32x4*)(d.src + (size_t)(4 * i + (lane >> 4)) * d.ldn + (lane & 15) * 4);
    if (d.gain) { g[0] = *(const GAS f32x4*)(d.gain + 8 * (lane & 7)); g[1] = *(const GAS f32x4*)(d.gain + 8 * (lane & 7) + 4); }
    else { g[0] = (f32x4){1.f, 1.f, 1.f, 1.f}; g[1] = g[0]; }
}
__device__ __forceinline__ void conv_store(const ConvDesc& d, const f32x4 (&v)[16], const f32x4 (&g)[2], LAS float* scr, int lane) {
#pragma unroll
    for (int i = 0; i < 16; ++i) { LAS float* s = scr + (4 * i + (lane >> 4)) * 65 + (lane & 15) * 4; s[0] = v[i][0]; s[1] = v[i][1]; s[2] = v[i][2]; s[3] = v[i][3]; }
    const int c = lane & 7;
    LDS_WAIT(); asm volatile("" ::: "memory");
#pragma unroll
    for (int j = 0; j < 8; ++j) { const int n = (lane >> 3) + 8 * j; const LAS float* s = scr + (8 * c) * 65 + n;
        u32x4 o; o.x = pk2(s[0 * 65] * g[0][0], s[1 * 65] * g[0][1]); o.y = pk2(s[2 * 65] * g[0][2], s[3 * 65] * g[0][3]); o.z = pk2(s[4 * 65] * g[1][0], s[5 * 65] * g[1][1]); o.w = pk2(s[6 * 65] * g[1][2], s[7 * 65] * g[1][3]);
        if (!d.fp8) *(GAS u32x4*)(d.dst + (size_t)n * d.K + 8 * c) = o;
        else { u32x2 o8; int w;
            w = __builtin_amdgcn_cvt_pk_fp8_f32(s[0 * 65] * g[0][0] * d.wsc, s[1 * 65] * g[0][1] * d.wsc, 0, false); w = __builtin_amdgcn_cvt_pk_fp8_f32(s[2 * 65] * g[0][2] * d.wsc, s[3 * 65] * g[0][3] * d.wsc, w, true); o8.x = (unsigned)w;
            w = __builtin_amdgcn_cvt_pk_fp8_f32(s[4 * 65] * g[1][0] * d.wsc, s[5 * 65] * g[1][1] * d.wsc, 0, false); w = __builtin_amdgcn_cvt_pk_fp8_f32(s[6 * 65] * g[1][2] * d.wsc, s[7 * 65] * g[1][3] * d.wsc, w, true); o8.y = (unsigned)w;
            *(GAS u32x2*)((GAS unsigned char*)d.dst + (size_t)n * d.K + 8 * c) = o8; } }
    LDS_WAIT(); asm volatile("" ::: "memory");
}
__device__ __forceinline__ int gu_dest(int n0, int FH) { const int up = n0 >= FH ? 1 : 0, j = n0 - up * FH; return 256 * (j >> 7) + 128 * up + (j & 127); }

__device__ __forceinline__ void moe_prefix(const int* cntwg, int wg, volatile LAS int* L, int wave, int lane) {
    __syncthreads();
    { int tot = 0, pre = 0;
      for (int w = lane; w < 256; w += 64) { const int c = __hip_atomic_load(cntwg + w * 8 + wave, RLX_AGENT); tot += c; if (w < wg) pre += c; }
#pragma unroll
      for (int o = 1; o < 64; o <<= 1) { tot += __shfl_xor(tot, o); pre += __shfl_xor(pre, o); }
      if (lane == 0) { L[16 + wave] = tot; L[32 + wave] = pre; } }
    __syncthreads();
    if (threadIdx.x == 0) { int a = 0; L[0] = 0; for (int e = 0; e < NE; ++e) { a += (L[16 + e] + 255) >> 8; L[e + 1] = a; } }
    __syncthreads();
}

__device__ __forceinline__ const float* inp_ptr(int i) {
    typedef __attribute__((address_space(4))) const unsigned long long* kap_t;
    kap_t p = (kap_t)__builtin_amdgcn_kernarg_segment_ptr();
    asm volatile("" : "+s"(p));
    return (const float*)(const GAS float*)(uintptr_t)p[i];
}
constexpr int CI_IN = 16 * 48, CI_SQ = 16 * 16, CI_KV = 16 * 32, CI_GUD = 16 * 88, CI_DD = 44 * 16, CI_GUM1 = 16 * 112, CI_DM1 = 56 * 16, CI_PP1 = 4 * 16;
constexpr int CONV_NITEMS = CI_IN + CI_SQ + CI_KV + CI_SQ + CI_SQ + CI_GUD + CI_DD + NE * CI_GUM1 + NE * CI_DM1 + 2 * CI_PP1 + 2 * CI_SQ;
__device__ __forceinline__ ConvDesc conv_mk(const float* W, int ldn, int K, const float* gain, bf16_t* WT, int k0, int n0, int nd0) {
    ConvDesc d; d.src = W + (size_t)k0 * ldn + n0; d.gain = gain ? gain + k0 : nullptr; d.dst = WT + (size_t)nd0 * K + k0; d.ldn = ldn; d.K = K; d.fp8 = 0; d.wsc = 1.f; return d;
}
__device__ __forceinline__ ConvDesc conv_decode(int it, unsigned char* ws) {
    int r = it;
    if (r < CI_IN) return conv_mk(inp_ptr(4), 3 * DM + NH, DM, inp_ptr(2), (bf16_t*)(ws + WS_W_IN), 64 * (r / 48), 64 * (r % 48), 64 * (r % 48)); r -= CI_IN;
    if (r < CI_SQ) return conv_mk(inp_ptr(6), DM, DM, nullptr, (bf16_t*)(ws + WS_W_OA), 64 * (r / 16), 64 * (r % 16), 64 * (r % 16)); r -= CI_SQ;
    if (r < CI_KV) return conv_mk(inp_ptr(8), 2 * DM, DM, inp_ptr(7), (bf16_t*)(ws + WS_W_KVQ), 64 * (r / 32), 64 * (r % 32), 64 * (r % 32)); r -= CI_KV;
    if (r < CI_SQ) return conv_mk(inp_ptr(9), DM, DM, inp_ptr(2) + DM, (bf16_t*)(ws + WS_W_KVQ), 64 * (r / 16), 64 * (r % 16), 2 * DM + 64 * (r % 16)); r -= CI_SQ;
    if (r < CI_SQ) return conv_mk(inp_ptr(10), DM, DM, nullptr, (bf16_t*)(ws + WS_W_OB), 64 * (r / 16), 64 * (r % 16), 64 * (r % 16)); r -= CI_SQ;
    if (r < CI_GUD) { const int n0 = 64 * (r % 88); return conv_mk(inp_ptr(11), 2 * FD, DM, inp_ptr(3), (bf16_t*)(ws + WS_W_GUD), 64 * (r / 88), n0, gu_dest(n0, FD)); } r -= CI_GUD;
    if (r < CI_DD) return conv_mk(inp_ptr(12), DM, FD, nullptr, (bf16_t*)(ws + WS_W_DD), 64 * (r / 16), 64 * (r % 16), 64 * (r % 16)); r -= CI_DD;
    if (r < NE * CI_GUM1) { const int e = r / CI_GUM1, q = r % CI_GUM1, n0 = 64 * (q % 112);
        ConvDesc d = conv_mk(inp_ptr(15) + (size_t)e * DM * 2 * FE, 2 * FE, DM, inp_ptr(3) + DM, nullptr, 64 * (q / 112), n0, 0);
        d.dst = (bf16_t*)(ws + WS_W_GUM + ((size_t)e * 2 * FE + gu_dest(n0, FE)) * DM + 64 * (q / 112)); d.fp8 = 1; d.wsc = 32.f; return d; } r -= NE * CI_GUM1;
    if (r < NE * CI_DM1) { const int e = r / CI_DM1, q = r % CI_DM1;
        ConvDesc d = conv_mk(inp_ptr(16) + (size_t)e * FE * DM, DM, FE, nullptr, nullptr, 64 * (q / 16), 64 * (q % 16), 0);
        d.dst = (bf16_t*)(ws + WS_W_DM + ((size_t)e * DM + 64 * (q % 16)) * FE + 64 * (q / 16)); d.fp8 = 1; d.wsc = 64.f; return d; } r -= NE * CI_DM1;
    if (r < 2 * CI_PP1) { const int e = r / CI_PP1, q = r % CI_PP1;
        return conv_mk(inp_ptr(17) + (size_t)e * DP * DM, DM, DP, nullptr, (bf16_t*)(ws + WS_W_PP) + (size_t)e * DM * DP, 64 * (q / 16), 64 * (q % 16), 64 * (q % 16)); } r -= 2 * CI_PP1;
    { const int e = r / CI_SQ, q = r % CI_SQ;
        return conv_mk(inp_ptr(18) + (size_t)e * DM * DM, DM, DM, nullptr, (bf16_t*)(ws + WS_W_PG) + (size_t)e * DM * DM, 64 * (q / 16), 64 * (q % 16), 64 * (q % 16)); }
}
__global__ void __launch_bounds__(NW * 64, 2) fwd_kernel(Args args) {
    extern __shared__ __attribute__((aligned(16))) unsigned char lds_raw[];
    LAS unsigned char* lds = (LAS unsigned char*)lds_raw;
    volatile LAS unsigned* MISC = (volatile LAS unsigned*)(lds + MISC_OFF);
    const int tid0 = threadIdx.x, wave = __builtin_amdgcn_readfirstlane(tid0 >> 6);
#define FRESH_IDS int tid = threadIdx.x; asm volatile("" : "+v"(tid)); const int lane = tid & 63;
    const int G = gridDim.x, bx = blockIdx.x;
    const int vcu = (G % 8 == 0) ? (bx % 8) * (G / 8) + bx / 8 : bx;
    const int gw = vcu * NW + wave, NGW = G * NW;
    unsigned char* ws = args.ws;
    gu32* ctl = (gu32*)(ws + WS_CTL);
    float* const hres = args.out;
#define INP(i) inp_ptr(i)
#define in_x INP(0)
#define p_in INP(1)
#define attn_norm INP(2)
#define ffn_norm INP(3)
#define w_in_a INP(4)
#define b_f INP(5)
#define w_o_a INP(6)
#define kv_norm INP(7)
#define w_kv INP(8)
#define w_q_b INP(9)
#define w_o_b INP(10)
#define w_gu_dense INP(11)
#define w_down_dense INP(12)
#define router_w INP(13)
#define router_b INP(14)
#define w_gu_moe INP(15)
#define w_down_moe INP(16)
#define w_ple_proj INP(17)
#define w_ple_gate INP(18)
#define final_norm INP(19)
#define rs0 ((float*)(ws + WS_RS0))
#define slab1 ((float*)(ws + WS_SLAB1))
#define slab3 ((float*)(ws + WS_SLAB3))
#define slab6 ((float*)(ws + WS_SLAB6))
#define logf_ ((float*)(ws + WS_LOGF))
#define cs ((float*)(ws + WS_CS))
#define cntwg ((int*)(ws + WS_CNTWG))
#define selE ((int*)(ws + WS_SELE))
#define selG ((float*)(ws + WS_SELG))
#define rr4 ((float*)(ws + WS_RR4))
#define tokpos ((int*)(ws + WS_TOKPOS))
#define grow ((float*)(ws + WS_GROW))
#define W_IN ((bf16_t*)(ws + WS_W_IN))
#define W_OA ((bf16_t*)(ws + WS_W_OA))
#define W_KVQ ((bf16_t*)(ws + WS_W_KVQ))
#define W_OB ((bf16_t*)(ws + WS_W_OB))
#define W_GUD ((bf16_t*)(ws + WS_W_GUD))
#define W_DD ((bf16_t*)(ws + WS_W_DD))
#define W_PP ((bf16_t*)(ws + WS_W_PP))
#define W_PG ((bf16_t*)(ws + WS_W_PG))
#define W_GUM ((bf16_t*)(ws + WS_W_GUM))
#define W_DM ((bf16_t*)(ws + WS_W_DM))
#define HBA ((bf16_t*)(ws + WS_HBA))
#define HBB ((bf16_t*)(ws + WS_HBB))
#define PB ((bf16_t*)(ws + WS_PB))
#define PP ((bf16_t*)(ws + WS_PP))
#define XG ((bf16_t*)(ws + WS_XGY))
#define YB ((bf16_t*)(ws + WS_XGY))
#define QB ((bf16_t*)(ws + WS_Q))
#define KB ((bf16_t*)(ws + WS_K))
#define VB ((bf16_t*)(ws + WS_V))
#define OB ((bf16_t*)(ws + WS_O))
#define ACTD ((bf16_t*)(ws + WS_ACTD))
#define ACTM ((bf16_t*)(ws + WS_ACTM))

    for (int u = tid0; u < (LDS_BYTES - LDSCTL_OFF) / 4; u += NW * 64) ((LAS unsigned*)(lds + LDSCTL_OFF))[u] = 0u;
    __syncthreads();
    XcdBarrier bar; bar.bar = (unsigned*)(ctl + CW_BAR) + args.li * XCD_BAR_WORDS; bar.x = 0; bar.st = nullptr;
    if (N_LAUNCHES != NPH) bar = xcd_barrier_post((unsigned*)(ctl + CW_BAR) + args.li * XCD_BAR_WORDS, MISC + 8);
    const int lo = args.ph_lo, hi = args.ph_hi;
#ifndef PHASE_MASK
#define PHASE_MASK 0x1ffff
#endif
#define IN(k) ((((PHASE_MASK) >> (k)) & 1) && lo <= (k) && (k) < hi)
#define SEAM(k) do { if (IN(k) && IN((k) + 1)) xcd_barrier(bar); } while (0)

    if (IN(0)) { FRESH_IDS
        const int p0parts = args.pad;
        if (p0parts & 1) {
            LAS float* wfg = (LAS float*)lds;
            { const float* an_ = attn_norm; const float* wi_ = w_in_a;
              float tmp[32];
#pragma unroll
              for (int u = 0; u < 32; ++u) { const int i = tid + u * (NW * 64), k = i >> 4, h = i & 15; tmp[u] = an_[k] * wi_[(size_t)k * (3 * DM + NH) + 3 * DM + h]; }
#pragma unroll
              for (int u = 0; u < 32; ++u) { const int i = tid + u * (NW * 64), k = i >> 4, h = i & 15;
                wfg[((((((k >> 8) * 4 + (k & 3)) * 4 + (h >> 2)) * 64) + ((k & 255) >> 2)) << 2) + (h & 3)] = tmp[u]; } }
            const float* xin_ = in_x; const float* bf_ = b_f;
            __syncthreads();
            f32x4 vn[4];
            if (gw < MT) { const GAS f32x4* xr = (const GAS f32x4*)(xin_ + (size_t)gw * DM) + lane;
#pragma unroll
                for (int j = 0; j < 4; ++j) vn[j] = xr[64 * j]; }
            for (int m = gw; m < MT; m += NGW) {
                f32x4 v[4]; float s = 0.f;
#pragma unroll
                for (int j = 0; j < 4; ++j) v[j] = vn[j];
                if (m + NGW < MT) { const GAS f32x4* xr = (const GAS f32x4*)(xin_ + (size_t)(m + NGW) * DM) + lane;
#pragma unroll
                    for (int j = 0; j < 4; ++j) vn[j] = xr[64 * j]; }
#pragma unroll
                for (int j = 0; j < 4; ++j) s += (v[j][0] * v[j][0] + v[j][1] * v[j][1]) + (v[j][2] * v[j][2] + v[j][3] * v[j][3]);
                const float r = 1.0f / sqrtf(wave_sum(s) * (1.0f / DM) + RMS_EPS);
                GAS unsigned long long* o8 = (GAS unsigned long long*)(HBA + (size_t)m * DM) + lane;
#pragma unroll
                for (int j = 0; j < 4; ++j) o8[64 * j] = (unsigned long long)pk2(v[j][0], v[j][1]) | ((unsigned long long)pk2(v[j][2], v[j][3]) << 32);
                float fa[16];
#pragma unroll
                for (int h = 0; h < 16; ++h) fa[h] = 0.f;
#pragma unroll
                for (int j = 0; j < 4; ++j) {
#pragma unroll
                    for (int i = 0; i < 4; ++i) { const LAS f32x4* wp = (const LAS f32x4*)wfg + ((j * 4 + i) * 4) * 64 + lane; const float xv = v[j][i];
#pragma unroll
                        for (int q = 0; q < 4; ++q) { const f32x4 w4 = wp[q * 64]; fa[4 * q + 0] += xv * w4[0]; fa[4 * q + 1] += xv * w4[1]; fa[4 * q + 2] += xv * w4[2]; fa[4 * q + 3] += xv * w4[3]; } }
                    asm volatile("" ::: "memory"); }
#pragma unroll
                for (int h = 0; h < 16; ++h) fa[h] = wave_sum(fa[h]);
                if (lane == 0) rs0[m] = r;
                if (lane < 16) { float fv = 0.f;
#pragma unroll
                    for (int h = 0; h < 16; ++h) fv = (lane == h) ? fa[h] : fv;
                    const float z = fv * r + bf_[lane];
                    logf_[(size_t)m * NH + lane] = fminf(z, 0.f) - log1pf(expf(-fabsf(z))); }
            }
            __syncthreads();
        }
        const float* pin_ = p_in;
        if (p0parts & 1) {
            const size_t nth = (size_t)NGW * 64, i0 = (size_t)gw * 64 + lane, tot = (size_t)2 * MT * DP / 4;
            for (size_t ib = i0; ib < tot; ib += 8 * nth) { f32x4 v[8];
#pragma unroll
                for (int u = 0; u < 8; ++u) if (ib + u * nth < tot) v[u] = ((const GAS f32x4*)pin_)[ib + u * nth];
#pragma unroll
                for (int u = 0; u < 8; ++u) if (ib + u * nth < tot) { u32x2 w; w.x = pk2(v[u][0], v[u][1]); w.y = pk2(v[u][2], v[u][3]); ((GAS u32x2*)PB)[ib + u * nth] = w; } }
        }
        LAS float* scr = (LAS float*)(lds + wave * 16640);
        if (p0parts & 2) {
            ConvDesc dA, dB; f32x4 vA[16], vB[16], gA[2], gB[2];
            int it = gw;
            if (it < CONV_NITEMS) { dA = conv_decode(it, ws); conv_load(dA, vA, gA, lane); }
            while (it < CONV_NITEMS) {
                const bool hb = it + NGW < CONV_NITEMS;
                if (hb) { dB = conv_decode(it + NGW, ws); conv_load(dB, vB, gB, lane); }
                conv_store(dA, vA, gA, scr, lane);
                if (!hb) break;
                const bool ha = it + 2 * NGW < CONV_NITEMS;
                if (ha) { dA = conv_decode(it + 2 * NGW, ws); conv_load(dA, vA, gA, lane); }
                conv_store(dB, vB, gB, scr, lane);
                it += 2 * NGW;
                if (!ha) break;
            }
        }
    }
    SEAM(0);

    if (IN(1)) { FRESH_IDS
        pg8::Gemm g{HBA, W_IN, DM}; pg8::StaticOrder S; S.init(MT, 3 * DM, G, bx);
        pg8::EpiQKV E{QB, (size_t)(WS_K - WS_Q) / 2, 0, pg8::RowScale{rs0, 0}};
        pg8::gemm_phase(lds, g, S, E);
    }
    SEAM(1);

    if (IN(2)) { FRESH_IDS
#if !defined(NAIVE_FOX)
        static_assert(fox_body::LDS_BYTES <= RING_BYTES, "attention scratch vs LDS ring");
        const fox_body::AttnTensors AT{(const fox_body::bf16*)QB, (const fox_body::bf16*)KB, (const fox_body::bf16*)VB, (fox_body::bf16*)OB, logf_};
        const fox_body::StaticOrder S(G, bx);
        fox_body::attn_phase<fox_body::StaticOrder>((char*)lds_raw, AT, S);
        __syncthreads();
    }
#else
        const int zero = opaque_zero();
        for (int j = 0; j < 2; ++j) {
            const int it = gw + j * NGW; if (it >= NB * NH * 32) break;
            const int bh = it & 127, qq = it >> 7, qb = (j == 0) ? qq : 31 - (qq - 16);
            const int b = bh >> 4, h = bh & 15, t = qb * 64 + lane; const size_t row = (size_t)b * SEQ + t;
            float q[64], o[64];
            { const u32x4* qp = (const u32x4*)(QB + row * DM + h * HD);
#pragma unroll
              for (int c = 0; c < 8; ++c) { const u32x4 w = qp[c]; q[8 * c + 0] = bflo(w.x); q[8 * c + 1] = bfhi(w.x); q[8 * c + 2] = bflo(w.y); q[8 * c + 3] = bfhi(w.y); q[8 * c + 4] = bflo(w.z); q[8 * c + 5] = bfhi(w.z); q[8 * c + 6] = bflo(w.w); q[8 * c + 7] = bfhi(w.w); } }
#pragma unroll
            for (int d = 0; d < 64; ++d) o[d] = 0.f;
            const float* csb = cs + (size_t)bh * SEQ; const float ct = csb[t];
            float mx = -1e30f, l = 0.f;
            const int smax = qb * 64 + 63;
            for (int s = 0; s <= smax; ++s) {
                const size_t kro = ((size_t)b * SEQ + s) * DM + h * HD + zero;
                const u32x4* kp = (const u32x4*)(KB + kro); float dot = 0.f;
#pragma unroll
                for (int c = 0; c < 8; ++c) { const u32x4 w = kp[c]; dot += q[8 * c + 0] * bflo(w.x) + q[8 * c + 1] * bfhi(w.x) + q[8 * c + 2] * bflo(w.y) + q[8 * c + 3] * bfhi(w.y) + q[8 * c + 4] * bflo(w.z) + q[8 * c + 5] * bfhi(w.z) + q[8 * c + 6] * bflo(w.w) + q[8 * c + 7] * bfhi(w.w); }
                const float scv = dot + ct - csb[s + zero];
                if (s <= t) {
                    const float mn = fmaxf(mx, scv), a = __builtin_amdgcn_exp2f(mx - mn), pw = __builtin_amdgcn_exp2f(scv - mn);
                    l = l * a + pw; mx = mn;
                    const u32x4* vp = (const u32x4*)(VB + kro);
#pragma unroll
                    for (int c = 0; c < 8; ++c) { const u32x4 w = vp[c];
                        o[8 * c + 0] = o[8 * c + 0] * a + pw * bflo(w.x); o[8 * c + 1] = o[8 * c + 1] * a + pw * bfhi(w.x); o[8 * c + 2] = o[8 * c + 2] * a + pw * bflo(w.y); o[8 * c + 3] = o[8 * c + 3] * a + pw * bfhi(w.y);
                        o[8 * c + 4] = o[8 * c + 4] * a + pw * bflo(w.z); o[8 * c + 5] = o[8 * c + 5] * a + pw * bfhi(w.z); o[8 * c + 6] = o[8 * c + 6] * a + pw * bflo(w.w); o[8 * c + 7] = o[8 * c + 7] * a + pw * bfhi(w.w); }
                }
            }
            const float il = 1.0f / l; u32x4* op = (u32x4*)(OB + row * DM + h * HD);
#pragma unroll
            for (int c = 0; c < 8; ++c) { u32x4 w; w.x = pk2(o[8 * c + 0] * il, o[8 * c + 1] * il); w.y = pk2(o[8 * c + 2] * il, o[8 * c + 3] * il); w.z = pk2(o[8 * c + 4] * il, o[8 * c + 5] * il); w.w = pk2(o[8 * c + 6] * il, o[8 * c + 7] * il); op[c] = w; }
        }
    }
#endif
    SEAM(2);

    if (IN(3)) { FRESH_IDS
        pg8::Gemm g{OB, W_OA, DM}; pg8::StaticOrder S; S.init(MT, DM, G, bx);
        pg8::EpiResid E{HBA, slab1};
        pg8::gemm_phase(lds, g, S, E);
    }
    SEAM(3);

    if (IN(4)) { FRESH_IDS
        { pg8::Gemm g{HBA, W_GUD, DM}; pg8::StaticOrder S; S.init(MT, 2 * FD, G, bx);
          pg8::EpiSwiGLU E{ACTD, FD, pg8::RowScale{slab1, 1}};
          pg8::gemm_phase(lds, g, S, E); }
        {
          pg8::StaticOrder S; S.init(MT, DM, G / 2, bx >= G / 2 ? bx - G / 2 : (1 << 28));
          pg8::Gemm g{PB, W_PP, DP}; pg8::EpiBf16 E{PP, DM};
          pg8::gemm_phase(lds, g, S, E); }
    }
    SEAM(4);

    if (IN(5)) { FRESH_IDS
        pg8::Gemm g{ACTD, W_DD, FD}; pg8::StaticOrder S; S.init(MT, DM, G, bx);
        pg8::EpiResid E{HBA, nullptr};
        pg8::gemm_phase(lds, g, S, E);
    }
    SEAM(5);

    if (IN(6)) { FRESH_IDS
        pg8::Gemm g{HBA, W_PG, DM}; pg8::StaticOrder S; S.init(MT, DM, G, bx);
        pg8::EpiPLE E{HBA, PP, HBB, nullptr, slab3};
        pg8::gemm_phase(lds, g, S, E);
    }
    SEAM(6);

    if (IN(7)) { FRESH_IDS
        pg8::Gemm g{HBB, W_KVQ, DM}; pg8::StaticOrder S; S.init(MT, 3 * DM, G, bx);
        pg8::EpiQKV E{QB, (size_t)(WS_K - WS_Q) / 2, 1, pg8::RowScale{slab3, 1}};
        pg8::gemm_phase(lds, g, S, E);
    }
    SEAM(7);

    if (IN(8)) { FRESH_IDS
#if !defined(NAIVE_SB)
        static_assert(fox_body::SB_BYTES <= RING_BYTES, "attention scratch vs LDS ring");
        const fox_body::AttnTensors AT{(const fox_body::bf16*)QB, (const fox_body::bf16*)KB, (const fox_body::bf16*)VB, (fox_body::bf16*)OB, nullptr};
        const fox_body::StaticOrder S(G, bx);
        fox_body::sb_phase<fox_body::StaticOrder>((char*)lds_raw, AT, S);
        __syncthreads();
    }
#else
        const int zero = opaque_zero();
        for (int j = 0; j < 2; ++j) {
            const int it = gw + j * NGW; if (it >= NB * NH * 32) break;
            const int bh = it & 127, qq = it >> 7, qb = (j == 0) ? qq : 31 - (qq - 16);
            const int b = bh >> 4, h = bh & 15, t = qb * 64 + lane; const size_t row = (size_t)b * SEQ + t;
            float q[64], o[64];
            { const u32x4* qp = (const u32x4*)(QB + row * DM + h * HD);
#pragma unroll
              for (int c = 0; c < 8; ++c) { const u32x4 w = qp[c]; q[8 * c + 0] = bflo(w.x); q[8 * c + 1] = bfhi(w.x); q[8 * c + 2] = bflo(w.y); q[8 * c + 3] = bfhi(w.y); q[8 * c + 4] = bflo(w.z); q[8 * c + 5] = bfhi(w.z); q[8 * c + 6] = bflo(w.w); q[8 * c + 7] = bfhi(w.w); } }
#pragma unroll
            for (int d = 0; d < 64; ++d) o[d] = 0.f;
            float rem = 1.0f;
            for (int s = qb * 64 + 62; s >= 0; --s) {
                const size_t kro = ((size_t)b * SEQ + s) * DM + h * HD + zero;
                const u32x4* kp = (const u32x4*)(KB + kro); float dot = 0.f;
#pragma unroll
                for (int c = 0; c < 8; ++c) { const u32x4 w = kp[c]; dot += q[8 * c + 0] * bflo(w.x) + q[8 * c + 1] * bfhi(w.x) + q[8 * c + 2] * bflo(w.y) + q[8 * c + 3] * bfhi(w.y) + q[8 * c + 4] * bflo(w.z) + q[8 * c + 5] * bfhi(w.z) + q[8 * c + 6] * bflo(w.w) + q[8 * c + 7] * bfhi(w.w); }
                if (s < t) {
                    const float uu = __builtin_amdgcn_exp2f(dot), inv = 1.0f / (1.0f + uu), a = uu * inv * rem; rem *= inv;
                    const u32x4* vp = (const u32x4*)(VB + kro);
#pragma unroll
                    for (int c = 0; c < 8; ++c) { const u32x4 w = vp[c];
                        o[8 * c + 0] += a * bflo(w.x); o[8 * c + 1] += a * bfhi(w.x); o[8 * c + 2] += a * bflo(w.y); o[8 * c + 3] += a * bfhi(w.y);
                        o[8 * c + 4] += a * bflo(w.z); o[8 * c + 5] += a * bfhi(w.z); o[8 * c + 6] += a * bflo(w.w); o[8 * c + 7] += a * bfhi(w.w); }
                }
            }
            u32x4* op = (u32x4*)(OB + row * DM + h * HD);
#pragma unroll
            for (int c = 0; c < 8; ++c) { u32x4 w; w.x = pk2(o[8 * c + 0], o[8 * c + 1]); w.y = pk2(o[8 * c + 2], o[8 * c + 3]); w.z = pk2(o[8 * c + 4], o[8 * c + 5]); w.w = pk2(o[8 * c + 6], o[8 * c + 7]); op[c] = w; }
        }
    }
#endif
    SEAM(8);

    if (IN(9)) { FRESH_IDS
        pg8::Gemm g{OB, W_OB, DM}; pg8::StaticOrder S; S.init(MT, DM, G, bx);
        pg8::EpiResid E{HBB, nullptr};
        pg8::gemm_phase(lds, g, S, E);
    }
    SEAM(9);

    if (IN(10)) { FRESH_IDS
        LAS float* wrg = (LAS float*)lds;
        LAS int* lsel = (LAS int*)(lds + 32768);
        { const float* fn_ = ffn_norm; const float* rw_ = router_w;
          float tmp[16];
#pragma unroll
          for (int u = 0; u < 16; ++u) { const int i = tid + u * (NW * 64); tmp[u] = fn_[DM + (i >> 3)] * rw_[i]; }
#pragma unroll
          for (int u = 0; u < 16; ++u) { const int i = tid + u * (NW * 64), k = i >> 3, e = i & 7;
              wrg[((((((k >> 8) * 4 + (k & 3)) * 2 + (e >> 2)) * 64) + ((k & 255) >> 2)) << 2) + (e & 3)] = tmp[u]; } }
        const float* rb_ = router_b;
        __syncthreads();
        u32x2 vn[4];
        { const GAS u32x2* hr = (const GAS u32x2*)(HBB + (size_t)(vcu * 64 + wave * 8) * DM) + lane;
#pragma unroll
          for (int q = 0; q < 4; ++q) vn[q] = hr[64 * q]; }
        for (int j = 0; j < 8; ++j) {
            const int rl = wave * 8 + j, row = vcu * 64 + rl;
            f32x4 v[4]; float s = 0.f;
#pragma unroll
            for (int q = 0; q < 4; ++q) v[q] = (f32x4){bflo(vn[q].x), bfhi(vn[q].x), bflo(vn[q].y), bfhi(vn[q].y)};
            if (j < 7) { const GAS u32x2* hr = (const GAS u32x2*)(HBB + (size_t)(row + 1) * DM) + lane;
#pragma unroll
                for (int q = 0; q < 4; ++q) vn[q] = hr[64 * q]; }
#pragma unroll
            for (int q = 0; q < 4; ++q) s += (v[q][0] * v[q][0] + v[q][1] * v[q][1]) + (v[q][2] * v[q][2] + v[q][3] * v[q][3]);
            const float r = 1.0f / sqrtf(wave_sum(s) * (1.0f / DM) + RMS_EPS);
            float la[8];
#pragma unroll
            for (int e = 0; e < 8; ++e) la[e] = 0.f;
#pragma unroll
            for (int q = 0; q < 4; ++q)
#pragma unroll
                for (int i = 0; i < 4; ++i) { const LAS f32x4* wp = (const LAS f32x4*)wrg + ((q * 4 + i) * 2) * 64 + lane; const float xv = v[q][i]; const f32x4 w0 = wp[0], w1 = wp[64];
                    la[0] += xv * w0[0]; la[1] += xv * w0[1]; la[2] += xv * w0[2]; la[3] += xv * w0[3]; la[4] += xv * w1[0]; la[5] += xv * w1[1]; la[6] += xv * w1[2]; la[7] += xv * w1[3]; }
#pragma unroll
            for (int e = 0; e < 8; ++e) la[e] = wave_sum(la[e]) * r + rb_[e];
            int e1 = 0; float v1 = la[0];
#pragma unroll
            for (int e = 1; e < 8; ++e) if (la[e] > v1) { v1 = la[e]; e1 = e; }
            int e2 = -1; float v2 = -3.0e38f;
#pragma unroll
            for (int e = 0; e < 8; ++e) if (e != e1 && la[e] > v2) { v2 = la[e]; e2 = e; }
            if (lane == 0) { const float g1 = 1.0f / (1.0f + expf(v2 - v1)); lsel[rl] = e1 | (e2 << 8); selE[row] = e1 | (e2 << 8); selG[row] = g1; rr4[row] = r; }
        }
        __syncthreads();
        if (tid < NE) { int c = 0; for (int i = 0; i < 64; ++i) { const int se = lsel[i]; c += ((se & 255) == tid) + ((se >> 8) == tid); } __hip_atomic_store(cntwg + vcu * 8 + tid, c, RLX_AGENT); }
        __syncthreads();
    }
    SEAM(10);

    if (IN(11)) { FRESH_IDS
        volatile LAS int* L = (volatile LAS int*)(lds + 65536);
        LAS int* lsel = (LAS int*)(lds + 32768); LAS int* lpos = (LAS int*)(lds + 33024);
        moe_prefix(cntwg, vcu, L, wave, lane);
        if (tid < 64) lsel[tid] = selE[vcu * 64 + tid];
        __syncthreads();
        if (tid < 128) { const int i = tid >> 1, k = tid & 1; const int se = lsel[i]; const int e = k ? (se >> 8) : (se & 255); int rank = 0;
            for (int i2 = 0; i2 <= i; ++i2) { const int s2 = lsel[i2]; if ((s2 & 255) == e && (i2 < i || k == 1)) ++rank; if ((s2 >> 8) == e && i2 < i) ++rank; }
            const int pos = 256 * L[e] + L[32 + e] + rank; lpos[tid] = pos; tokpos[(vcu * 64 + i) * 2 + k] = pos;
            const float g1 = selG[vcu * 64 + i]; grow[pos] = k ? 1.0f - g1 : g1; }
        __syncthreads();
#pragma unroll 1
        for (int jb = 0; jb < 8; jb += 4) {
            u32x2 v[4][4]; float rq[4];
#pragma unroll
            for (int j = 0; j < 4; ++j) { const int row = vcu * 64 + wave * 8 + jb + j; rq[j] = rr4[row]; const GAS u32x2* hr = (const GAS u32x2*)(HBB + (size_t)row * DM) + lane;
#pragma unroll
                for (int q = 0; q < 4; ++q) v[j][q] = hr[64 * q]; }
#pragma unroll
            for (int j = 0; j < 4; ++j) { const int rl = wave * 8 + jb + j;
                GAS unsigned* d0 = (GAS unsigned*)((GAS unsigned char*)XG + (size_t)lpos[rl * 2] * DM) + lane; GAS unsigned* d1 = (GAS unsigned*)((GAS unsigned char*)XG + (size_t)lpos[rl * 2 + 1] * DM) + lane;
#pragma unroll
                for (int q = 0; q < 4; ++q) { const float r_ = rq[j]; int w = __builtin_amdgcn_cvt_pk_fp8_f32(bflo(v[j][q].x) * r_, bfhi(v[j][q].x) * r_, 0, false); w = __builtin_amdgcn_cvt_pk_fp8_f32(bflo(v[j][q].y) * r_, bfhi(v[j][q].y) * r_, w, true); d0[64 * q] = (unsigned)w; d1[64 * q] = (unsigned)w; } }
        }
        __syncthreads();
    }
    SEAM(11);

    if (IN(12)) { FRESH_IDS
        volatile LAS int* L = (volatile LAS int*)(lds + 65536);
        moe_prefix(cntwg, vcu, L, wave, lane);
        pg8::MoeOrder S; for (int e = 0; e <= NE; ++e) S.mtp[e] = L[e]; S.nN = 2 * FE / 256; S.brows = 2 * FE; S.G = G; S.c = bx;
        __syncthreads();
        pg8::Gemm g{XG, W_GUM, DM / 2, 0x7A7A7A7A, 0x7F7F7F7F};
        pg8::EpiSwiGLU8 E{(unsigned char*)ACTM, FE};
        pg8::gemm_phase_fp8(lds, g, S, E);
    }
    SEAM(12);

    if (IN(13)) { FRESH_IDS
        volatile LAS int* L = (volatile LAS int*)(lds + 65536);
        moe_prefix(cntwg, vcu, L, wave, lane);
        pg8::MoeOrder S; for (int e = 0; e <= NE; ++e) S.mtp[e] = L[e]; S.nN = DM / 256; S.brows = DM; S.G = G; S.c = bx;
        __syncthreads();
        pg8::Gemm g{ACTM, W_DM, FE / 2, 0x79797979, 0x7C7C7C7C};
        pg8::EpiMoeDown E{YB, grow};
        pg8::gemm_phase_fp8(lds, g, S, E);
        {
          const int nwg = S.mtp[NE] * (DM / 256), full = (nwg / G) * G, busy = nwg - full, idle = G - busy;
          pg8::StaticOrder S2; if (idle > 0 && busy > 0) S2.init(MT, DM, idle, bx >= busy ? bx - busy : (1 << 28)); else S2.init(MT, DM, G, bx);
          pg8::Gemm g2{PB + (size_t)MT * DP, W_PP + (size_t)DM * DP, DP}; pg8::EpiBf16 E2{PP + (size_t)MT * DM, DM};
          pg8::gemm_phase(lds, g2, S2, E2); }
    }
    SEAM(13);

    if (IN(14)) { FRESH_IDS
        {
            const int* tp_ = tokpos;
            int pc0 = 0, pc1 = 0, pn0 = 0, pn1 = 0;
            if (gw < MT) { pc0 = tp_[2 * gw]; pc1 = tp_[2 * gw + 1]; }
            if (gw + NGW < MT) { pn0 = tp_[2 * (gw + NGW)]; pn1 = tp_[2 * (gw + NGW) + 1]; }
            u32x2 hv[4], ya[4], yb[4];
            if (gw < MT) { const GAS u32x2* hr = (const GAS u32x2*)(HBB + (size_t)gw * DM) + lane; const GAS u32x2* y0 = (const GAS u32x2*)(YB + (size_t)pc0 * DM) + lane; const GAS u32x2* y1 = (const GAS u32x2*)(YB + (size_t)pc1 * DM) + lane;
#pragma unroll
                for (int q = 0; q < 4; ++q) { hv[q] = hr[64 * q]; ya[q] = y0[64 * q]; yb[q] = y1[64 * q]; } }
            for (int m = gw; m < MT; m += NGW) {
                u32x2 v[4], a[4], b[4];
#pragma unroll
                for (int q = 0; q < 4; ++q) { v[q] = hv[q]; a[q] = ya[q]; b[q] = yb[q]; }
                const int mn = m + NGW, mnn = m + 2 * NGW;
                if (mn < MT) { const GAS u32x2* hr = (const GAS u32x2*)(HBB + (size_t)mn * DM) + lane; const GAS u32x2* y0 = (const GAS u32x2*)(YB + (size_t)pn0 * DM) + lane; const GAS u32x2* y1 = (const GAS u32x2*)(YB + (size_t)pn1 * DM) + lane;
#pragma unroll
                    for (int q = 0; q < 4; ++q) { hv[q] = hr[64 * q]; ya[q] = y0[64 * q]; yb[q] = y1[64 * q]; } }
                if (mnn < MT) { pn0 = tp_[2 * mnn]; pn1 = tp_[2 * mnn + 1]; }
                GAS u32x2* hb = (GAS u32x2*)(HBA + (size_t)m * DM) + lane;
#pragma unroll
                for (int q = 0; q < 4; ++q) { u32x2 w;
                    w.x = pk2(bflo(v[q].x) + (bflo(a[q].x) + bflo(b[q].x)), bfhi(v[q].x) + (bfhi(a[q].x) + bfhi(b[q].x)));
                    w.y = pk2(bflo(v[q].y) + (bflo(a[q].y) + bflo(b[q].y)), bfhi(v[q].y) + (bfhi(a[q].y) + bfhi(b[q].y))); hb[64 * q] = w; }
            }
        }
    }
    SEAM(14);

    if (IN(15)) { FRESH_IDS
        pg8::Gemm g{HBA, W_PG + (size_t)DM * DM, DM}; pg8::StaticOrder S; S.init(MT, DM, G, bx);
        pg8::EpiPLE E{HBA, PP + (size_t)MT * DM, nullptr, hres, slab6};
        pg8::gemm_phase(lds, g, S, E);
    }
    SEAM(15);

    if (IN(16)) { FRESH_IDS
        f32x4 gn[4];
        { const float* fnm_ = final_norm;
#pragma unroll
        for (int q = 0; q < 4; ++q) gn[q] = ((const GAS f32x4*)fnm_)[lane + 64 * q]; }
        {
            f32x4 vn[4], sqn;
            if (gw < MT) { const GAS f32x4* hr = (const GAS f32x4*)(hres + (size_t)gw * DM) + lane; sqn = *(const GAS f32x4*)(slab6 + 4 * (size_t)gw);
#pragma unroll
                for (int q = 0; q < 4; ++q) vn[q] = hr[64 * q]; }
            for (int m = gw; m < MT; m += NGW) {
                f32x4 v[4]; const f32x4 sq = sqn;
#pragma unroll
                for (int q = 0; q < 4; ++q) v[q] = vn[q];
                if (m + NGW < MT) { const GAS f32x4* hr = (const GAS f32x4*)(hres + (size_t)(m + NGW) * DM) + lane; sqn = *(const GAS f32x4*)(slab6 + 4 * (size_t)(m + NGW));
#pragma unroll
                    for (int q = 0; q < 4; ++q) vn[q] = hr[64 * q]; }
                const float r = __builtin_amdgcn_rsqf(((sq[0] + sq[1]) + (sq[2] + sq[3])) * (1.0f / DM) + RMS_EPS);
                GAS f32x4* ho = (GAS f32x4*)(hres + (size_t)m * DM) + lane;
#pragma unroll
                for (int q = 0; q < 4; ++q) ho[64 * q] = v[q] * r * gn[q];
            }
        }
    }
#undef IN
#undef SEAM
}

extern "C" void kernel_launch(void* const* d_in, const int* in_sizes, int n_in, void* d_out, int out_size, void* d_ws, size_t ws_size, hipStream_t stream) {
    static int grid = 0;
    if (grid == 0) {
        if (n_in != 20 || in_sizes[0] != MT * DM || out_size != MT * DM || ws_size < WS_END) { fprintf(stderr, "kernel_launch: unexpected shapes (n_in %d, in0 %d, out %d, ws %zu < %zu)\n", n_in, n_in > 0 ? in_sizes[0] : -1, out_size, ws_size, (size_t)WS_END); grid = -1; return; }
        int dev = 0, cus = 0, per_cu = 0;
        if (hipGetDevice(&dev) != hipSuccess || hipDeviceGetAttribute(&cus, hipDeviceAttributeMultiprocessorCount, dev) != hipSuccess) { grid = -1; return; }
        if (hipFuncSetAttribute((const void*)fwd_kernel, hipFuncAttributeMaxDynamicSharedMemorySize, LDS_BYTES) != hipSuccess) { fprintf(stderr, "kernel_launch: hipFuncSetAttribute failed\n"); grid = -1; return; }
        if (hipOccupancyMaxActiveBlocksPerMultiprocessor(&per_cu, (const void*)fwd_kernel, NW * 64, LDS_BYTES) != hipSuccess || per_cu < 1) { fprintf(stderr, "kernel_launch: occupancy query says %d blocks per CU\n", per_cu); per_cu = 1; }
        (void)hipGetLastError();
        grid = cus;
        if (grid != 256) fprintf(stderr, "kernel_launch: %d CUs; this kernel is written for 256\n", grid);
    }
    if (grid < 0) return;
    if (hipMemsetAsync((char*)d_ws + WS_CTL, 0, CTL_ZERO_BYTES, stream) != hipSuccess) return;
    Args a{};
    for (int i = 0; i < 20; ++i) a.in[i] = (const float*)d_in[i];
    a.out = (float*)d_out; a.ws = (unsigned char*)d_ws; a.pad = 3;
#if defined(PROBE_REP_LO)
    a.ph_lo = 0; a.ph_hi = PROBE_REP_HI + 1; a.li = 0; hipLaunchKernelGGL(fwd_kernel, dim3(grid), dim3(NW * 64), LDS_BYTES, stream, a);
#if defined(PROBE_P0PARTS)
    a.pad = PROBE_P0PARTS;
#endif
    a.ph_lo = PROBE_REP_LO; a.ph_hi = NPH; a.li = 1; hipLaunchKernelGGL(fwd_kernel, dim3(grid), dim3(NW * 64), LDS_BYTES, stream, a);
#else
    for (int li = 0; li < N_LAUNCHES; ++li) {
        a.ph_lo = (N_LAUNCHES == NPH) ? li : 0; a.ph_hi = (N_LAUNCHES == NPH) ? li + 1 : NPH; a.li = (N_LAUNCHES == NPH) ? 0 : li;
        hipLaunchKernelGGL(fwd_kernel, dim3(grid), dim3(NW * 64), LDS_BYTES, stream, a);
    }
#endif
}
```
